# Optimizing an MI355X kernel written in HIP

```python
import jax, jax.numpy as jnp
from jax import lax
import numpy as np

D_MODEL = 1024
BATCH = 16
SEQ = 2048
DEPTH = 2

GRID_W = 64
CTX_LEN = 256
HEAD_DIM = 64
ROPE_THETA = 10000.0
NORM_EPS = 1e-6
Q_BLOCK = 128

A_HEADS = 8
A_KV_HEADS = 2
A_Q_W = A_HEADS * HEAD_DIM
A_KV_W = A_KV_HEADS * HEAD_DIM
B_HEADS = 8
B_Q_LORA = 384
B_KV_LORA = 256
B_NOPE = 64
B_ROPE = 32
B_V = 64
C_HEADS = 8
C_W = C_HEADS * HEAD_DIM
C_DECAY_LORA = 64
C_AAA_LORA = 64
C_GATE_LORA = 128
C_GN_EPS = 64e-5
D_HEADS = 8
D_W = D_HEADS * HEAD_DIM
NA_ROWS = 8
NA_COLS = 16

N_BRANCH = 4
BRANCH_W = 512
D_FF = 4 * D_MODEL

A_IN = A_Q_W + 2 * A_KV_W
B_IN = B_Q_LORA + B_KV_LORA + B_ROPE
C_IN = 3 * C_W + 2 * C_DECAY_LORA + 2 * C_AAA_LORA + C_GATE_LORA
D_IN = 3 * D_W
GATE_IN = N_BRANCH * D_MODEL
N_IN = A_IN + B_IN + C_IN + D_IN + GATE_IN

kernel_name = 'hybrid_prefix_flow_block'


def _split(p, widths):
    cuts = [int(v) for v in np.cumsum(widths)[:-1]]
    return jnp.split(p, cuts, axis=-1)


def rms_norm(x, g):
    xf = x.astype(jnp.float32)
    y = xf * lax.rsqrt(jnp.mean(xf * xf, axis=-1, keepdims=True) + NORM_EPS)
    return (y * g.astype(jnp.float32)).astype(x.dtype)


def modulate(h, shift, scale):
    return h * (1 + scale) + shift


def _rope_1d(x, pos):
    half = x.shape[-1] // 2
    inv = ROPE_THETA ** (-jnp.arange(half, dtype=jnp.float32) / half)
    ang = pos.astype(jnp.float32)[:, None] * inv[None, :]
    cos = jnp.cos(ang)[None, :, None, :]
    sin = jnp.sin(ang)[None, :, None, :]
    xf = x.astype(jnp.float32)
    x1, x2 = xf[..., :half], xf[..., half:]
    return jnp.concatenate([x1 * cos - x2 * sin, x1 * sin + x2 * cos], -1).astype(x.dtype)


def rope_2d(x, rows, cols):
    h = x.shape[-1] // 2
    return jnp.concatenate([_rope_1d(x[..., :h], rows), _rope_1d(x[..., h:], cols)], -1)


def block_attention(q, k, v):
    b, tq, hk, g, d = q.shape
    nb = tq // Q_BLOCK
    kf = k.astype(jnp.float32)
    vf = v.astype(jnp.float32)
    qb = jnp.moveaxis(q.reshape(b, nb, Q_BLOCK, hk, g, d), 1, 0)
    scale = d ** -0.5

    def one_block(qi):
        s = jnp.einsum('bqkgd,bskd->bkgqs', qi.astype(jnp.float32), kf) * scale
        p = jax.nn.softmax(s, axis=-1)
        return jnp.einsum('bkgqs,bskd->bqkgd', p, vf)

    o = lax.map(one_block, qb)
    return jnp.moveaxis(o, 0, 1).reshape(b, tq, hk * g * v.shape[-1]).astype(q.dtype)


def _gqa_heads(p, q_gain, k_gain, rows, cols):
    b, t, _ = p.shape
    q, k, v = _split(p, (A_Q_W, A_KV_W, A_KV_W))
    q = rms_norm(q.reshape(b, t, A_HEADS, HEAD_DIM), q_gain)
    k = rms_norm(k.reshape(b, t, A_KV_HEADS, HEAD_DIM), k_gain)
    v = v.reshape(b, t, A_KV_HEADS, HEAD_DIM)
    if rows is not None:
        q = rope_2d(q, rows, cols)
        k = rope_2d(k, rows, cols)
    return q.reshape(b, t, A_KV_HEADS, A_HEADS // A_KV_HEADS, HEAD_DIM), k, v


def gqa_mixer(p_lat, p_ctx, q_gain, k_gain, rows, cols, with_ctx):
    ql, kl, vl = _gqa_heads(p_lat, q_gain, k_gain, rows, cols)
    qc, kc, vc = _gqa_heads(p_ctx, q_gain, k_gain, None, None)
    o_lat = block_attention(ql, jnp.concatenate([kc, kl], 1), jnp.concatenate([vc, vl], 1))
    o_ctx = block_attention(qc, kc, vc) if with_ctx else None
    return o_lat, o_ctx


def _mla_heads(p, q_gain, kv_gain, w_q_up, w_kv_up, rows, cols):
    b, t, _ = p.shape
    cq, ckv, kr = _split(p, (B_Q_LORA, B_KV_LORA, B_ROPE))
    q = (rms_norm(cq, q_gain) @ w_q_up).reshape(b, t, B_HEADS, B_NOPE + B_ROPE)
    kv = (rms_norm(ckv, kv_gain) @ w_kv_up).reshape(b, t, B_HEADS, B_NOPE + B_V)
    q_nope, q_rope = q[..., :B_NOPE], q[..., B_NOPE:]
    k_nope, v = kv[..., :B_NOPE], kv[..., B_NOPE:]
    k_rope = kr.reshape(b, t, 1, B_ROPE)
    if rows is not None:
        q_rope = rope_2d(q_rope, rows, cols)
        k_rope = rope_2d(k_rope, rows, cols)
    k = jnp.concatenate([k_nope, jnp.broadcast_to(k_rope, (b, t, B_HEADS, B_ROPE))], -1)
    q = jnp.concatenate([q_nope, q_rope], -1)
    return q[:, :, :, None, :], k, v


def mla_mixer(p_lat, p_ctx, q_gain, kv_gain, w_q_up, w_kv_up, rows, cols, with_ctx):
    ql, kl, vl = _mla_heads(p_lat, q_gain, kv_gain, w_q_up, w_kv_up, rows, cols)
    qc, kc, vc = _mla_heads(p_ctx, q_gain, kv_gain, w_q_up, w_kv_up, None, None)
    o_lat = block_attention(ql, jnp.concatenate([kc, kl], 1), jnp.concatenate([vc, vl], 1))
    o_ctx = block_attention(qc, kc, vc) if with_ctx else None
    return o_lat, o_ctx


def _rwkv_prepare(z, mu, w0, w_decay, a0, w_aaa, w_gate, k_k, k_a):
    f = lambda t: t.astype(jnp.float32)
    b, t, _ = z.shape
    zf = f(z)
    zp = jnp.pad(zf, ((0, 0), (1, 1), (0, 0)))
    zf = zf + (0.5 * (zp[:, :-2] + zp[:, 2:]) - zf) * f(mu)
    r, k, v, w_lo_f, w_lo_b, a_lo_f, a_lo_b, g_lo = _split(
        zf, (C_W, C_W, C_W, C_DECAY_LORA, C_DECAY_LORA, C_AAA_LORA, C_AAA_LORA, C_GATE_LORA))
    heads = lambda u: u.reshape(b, t, C_HEADS, HEAD_DIM)
    kk = heads(k * f(k_k))
    kk = kk / jnp.maximum(jnp.sqrt(jnp.sum(kk * kk, -1, keepdims=True)), 1e-12)
    decays, aas, ks = [], [], []
    for d, (w_lo, a_lo) in enumerate(((w_lo_f, a_lo_f), (w_lo_b, a_lo_b))):
        logw = -jax.nn.softplus(-(f(w0[d]) + jnp.tanh(w_lo) @ f(w_decay[d]))) - 0.5
        decays.append(heads(jnp.exp(-jnp.exp(logw))))
        a = jax.nn.sigmoid(f(a0[d]) + a_lo @ f(w_aaa[d]))
        aas.append(heads(a))
        ks.append(heads(k * (1 + (a - 1) * f(k_a))))
    g = jax.nn.sigmoid(g_lo) @ f(w_gate)
    return heads(r), heads(v), kk, ks, decays, aas, g


def _wkv_scan(r, w, k, v, kk, a, s0, reverse):
    def step(S, inp):
        r_t, w_t, k_t, v_t, kk_t, a_t = inp
        sa = jnp.einsum('bhvk,bhk->bhv', S, kk_t)
        S = (S * w_t[:, :, None, :] - sa[..., None] * (kk_t * a_t)[:, :, None, :]
             + v_t[..., None] * k_t[:, :, None, :])
        return S, jnp.einsum('bhvk,bhk->bhv', S, r_t)
    xs = tuple(jnp.moveaxis(u, 1, 0) for u in (r, w, k, v, kk, a))
    S, ys = lax.scan(step, s0, xs, reverse=reverse)
    return jnp.moveaxis(ys, 0, 1), S


def _rwkv_out(y, r, v, ks, g, r_k, gn_w, gn_b, dtype):
    b, t = y.shape[:2]
    mean = jnp.mean(y, -1, keepdims=True)
    var = jnp.mean(jnp.square(y - mean), -1, keepdims=True)
    yn = ((y - mean) * lax.rsqrt(var + C_GN_EPS)).reshape(b, t, C_W)
    yn = yn * gn_w.astype(jnp.float32) + gn_b.astype(jnp.float32)
    bonus = jnp.sum(r * (ks[0] + ks[1]) * r_k.astype(jnp.float32), -1, keepdims=True) * v
    return ((yn + bonus.reshape(b, t, C_W)) * g).astype(dtype)


def rwkv_mixer(z_lat, z_ctx, mu, w0, w_decay, a0, w_aaa, w_gate, k_k, k_a, r_k, gn_w, gn_b, with_ctx):
    rl, vl, kkl, ksl, wl, al, gl = _rwkv_prepare(z_lat, mu, w0, w_decay, a0, w_aaa, w_gate, k_k, k_a)
    rc, vc, kkc, ksc, wc, ac, gc = _rwkv_prepare(z_ctx, mu, w0, w_decay, a0, w_aaa, w_gate, k_k, k_a)
    s0 = jnp.zeros((z_lat.shape[0], C_HEADS, HEAD_DIM, HEAD_DIM), jnp.float32)
    y_lat, y_ctx = [], []
    for d in range(2):
        rev = d == 1
        yc, s_ctx = _wkv_scan(rc, wc[d], ksc[d], vc, kkc, ac[d], s0, rev)
        yl, _ = _wkv_scan(rl, wl[d], ksl[d], vl, kkl, al[d], s_ctx, rev)
        y_lat.append(yl)
        y_ctx.append(yc)
    o_lat = _rwkv_out(y_lat[0] + y_lat[1], rl, vl, ksl, gl, r_k, gn_w, gn_b, z_lat.dtype)
    o_ctx = _rwkv_out(y_ctx[0] + y_ctx[1], rc, vc, ksc, gc, r_k, gn_w, gn_b, z_ctx.dtype) if with_ctx else None
    return o_lat, o_ctx


def _heads(u, h):
    b, n, _ = u.shape
    return u.reshape(b, n, h, -1)


def nat_mixer(p_lat, p_ctx, rel_bias, with_ctx):
    ql, kl, vl = [_heads(u, D_HEADS) for u in _split(p_lat, (D_W, D_W, D_W))]
    qc, kc, vc = [_heads(u, D_HEADS) for u in _split(p_ctx, (D_W, D_W, D_W))]
    b, s, h, d = ql.shape
    n_rows = s // GRID_W
    kr = min(NA_ROWS, n_rows)
    n_nb = kr * NA_COLS
    scale = d ** -0.5
    kcf, vcf = kc.astype(jnp.float32), vc.astype(jnp.float32)
    qg = jnp.moveaxis(ql.reshape(b, n_rows, GRID_W, h, d), 1, 0)
    kg = kl.astype(jnp.float32).reshape(b, n_rows, GRID_W, h, d)
    vg = vl.astype(jnp.float32).reshape(b, n_rows, GRID_W, h, d)
    col = jnp.arange(GRID_W)
    col_idx = jnp.clip(col - NA_COLS // 2, 0, GRID_W - NA_COLS)[:, None] + jnp.arange(NA_COLS)[None, :]
    dcol = col_idx - col[:, None] + (NA_COLS - 1)

    def one_row(args):
        r, q_r = args
        q_r = q_r.astype(jnp.float32)
        r0 = jnp.clip(r - kr // 2, 0, n_rows - kr)
        k_nb = lax.dynamic_slice_in_dim(kg, r0, kr, axis=1)[:, :, col_idx]
        v_nb = lax.dynamic_slice_in_dim(vg, r0, kr, axis=1)[:, :, col_idx]
        drow = r0 + jnp.arange(kr) - r + (NA_ROWS - 1)
        bias = rel_bias[:, drow[None, :, None], dcol[:, None, :]].astype(jnp.float32)
        s_nb = (jnp.einsum('bqhd,brqjhd->bhqrj', q_r, k_nb) * scale + bias[None]).reshape(b, h, GRID_W, n_nb)
        s_cx = jnp.einsum('bqhd,bchd->bhqc', q_r, kcf) * scale
        pr = jax.nn.softmax(jnp.concatenate([s_nb, s_cx], -1), axis=-1)
        p_nb = pr[..., :n_nb].reshape(b, h, GRID_W, kr, NA_COLS)
        return (jnp.einsum('bhqrj,brqjhd->bqhd', p_nb, v_nb)
                + jnp.einsum('bhqc,bchd->bqhd', pr[..., n_nb:], vcf))

    o = lax.map(one_row, (jnp.arange(n_rows), qg))
    o_lat = jnp.moveaxis(o, 0, 1).reshape(b, s, h * d).astype(p_lat.dtype)
    o_ctx = block_attention(qc[:, :, :, None, :], kc, vc) if with_ctx else None
    return o_lat, o_ctx


def _merge(outs, gate_logits, w_branch, w_out):
    b, t, _ = gate_logits.shape
    gates = jax.nn.sigmoid(gate_logits).reshape(b, t, N_BRANCH, D_MODEL)
    y = gates[:, :, 0] * (outs[0] @ w_branch[0])
    for i in range(1, N_BRANCH):
        y = y + gates[:, :, i] * (outs[i] @ w_branch[i])
    return y @ w_out


def _mlp(h, w1, w2):
    return jnp.square(jax.nn.relu(h @ w1)) @ w2


def _layer(x, xc, rows, cols, mod_lat, mod_ctx, lp, last):
    sh1, sc1, gt1, sh2, sc2, gt2 = jnp.split(mod_lat, 6, axis=-1)
    csh1, csc1, cgt1, csh2, csc2, cgt2 = jnp.split(mod_ctx, 6, axis=-1)
    with_ctx = not last
    p_l = modulate(rms_norm(x, lp['g_norm1']), sh1, sc1) @ lp['w_in']
    p_c = modulate(rms_norm(xc, lp['g_norm1']), csh1, csc1) @ lp['w_in']
    a_l, b_l, c_l, d_l, g_l = _split(p_l, (A_IN, B_IN, C_IN, D_IN, GATE_IN))
    a_c, b_c, c_c, d_c, g_c = _split(p_c, (A_IN, B_IN, C_IN, D_IN, GATE_IN))
    oa = gqa_mixer(a_l, a_c, lp['a_q_gain'], lp['a_k_gain'], rows, cols, with_ctx)
    ob = mla_mixer(b_l, b_c, lp['b_q_gain'], lp['b_kv_gain'], lp['b_w_q_up'], lp['b_w_kv_up'], rows, cols, with_ctx)
    oc = rwkv_mixer(c_l, c_c, lp['c_mu'], lp['c_w0'], lp['c_w_decay'], lp['c_a0'], lp['c_w_aaa'], lp['c_w_gate'],
                    lp['c_k_k'], lp['c_k_a'], lp['c_r_k'], lp['c_gn_w'], lp['c_gn_b'], with_ctx)
    od = nat_mixer(d_l, d_c, lp['d_rel_bias'], with_ctx)
    x = x + gt1 * _merge((oa[0], ob[0], oc[0], od[0]), g_l, lp['w_branch'], lp['w_out'])
    x = x + gt2 * _mlp(modulate(rms_norm(x, lp['g_norm2']), sh2, sc2), lp['w_mlp1'], lp['w_mlp2'])
    if last:
        return x, None
    xc = xc + cgt1 * _merge((oa[1], ob[1], oc[1], od[1]), g_c, lp['w_branch'], lp['w_out'])
    xc = xc + cgt2 * _mlp(modulate(rms_norm(xc, lp['g_norm2']), csh2, csc2), lp['w_mlp1'], lp['w_mlp2'])
    return x, xc


def setup_inputs(seed: int = 0) -> dict:
    key = jax.random.key(seed)
    keys = iter(jax.random.split(key, 48))
    L, D = DEPTH, D_MODEL

    def nrm(shape, std):
        return std * jax.random.normal(next(keys), shape, jnp.float32)

    def gain(shape):
        return 1.0 + 0.05 * jax.random.normal(next(keys), shape, jnp.float32)

    return {
        'x': nrm((BATCH, SEQ, D), 1.0),
        'c': nrm((BATCH, D), 1.0),
        'ctx': nrm((BATCH, CTX_LEN, D), 1.0),
        'c_ctx': nrm((D,), 1.0),
        'w_ada': nrm((L, D, 6 * D), 0.5 * D ** -0.5),
        'b_ada': nrm((L, 6 * D), 0.02),
        'g_norm1': gain((L, D)),
        'g_norm2': gain((L, D)),
        'w_in': nrm((L, D, N_IN), D ** -0.5),
        'a_q_gain': gain((L, HEAD_DIM)),
        'a_k_gain': gain((L, HEAD_DIM)),
        'b_q_gain': gain((L, B_Q_LORA)),
        'b_kv_gain': gain((L, B_KV_LORA)),
        'b_w_q_up': nrm((L, B_Q_LORA, B_HEADS * (B_NOPE + B_ROPE)), B_Q_LORA ** -0.5),
        'b_w_kv_up': nrm((L, B_KV_LORA, B_HEADS * (B_NOPE + B_V)), B_KV_LORA ** -0.5),
        'c_mu': jax.random.uniform(next(keys), (L, C_IN), jnp.float32),
        'c_w0': jax.random.uniform(next(keys), (L, 2, C_W), jnp.float32, minval=-6.0, maxval=-1.0),
        'c_w_decay': nrm((L, 2, C_DECAY_LORA, C_W), 0.1),
        'c_a0': nrm((L, 2, C_W), 0.5),
        'c_w_aaa': nrm((L, 2, C_AAA_LORA, C_W), 0.5 * C_AAA_LORA ** -0.5),
        'c_w_gate': nrm((L, C_GATE_LORA, C_W), C_GATE_LORA ** -0.5),
        'c_k_k': 0.85 + nrm((L, C_W), 0.05),
        'c_k_a': gain((L, C_W)),
        'c_r_k': nrm((L, C_HEADS, HEAD_DIM), 0.1),
        'c_gn_w': gain((L, C_W)),
        'c_gn_b': nrm((L, C_W), 0.02),
        'd_rel_bias': nrm((L, D_HEADS, 2 * NA_ROWS - 1, 2 * NA_COLS - 1), 0.2),
        'w_branch': nrm((L, N_BRANCH, BRANCH_W, D), BRANCH_W ** -0.5),
        'w_out': nrm((L, D, D), D ** -0.5),
        'w_mlp1': nrm((L, D, D_FF), D ** -0.5),
        'w_mlp2': nrm((L, D_FF, D), D_FF ** -0.5),
        'g_final': gain((D,)),
    }


def reference(x, c, ctx, c_ctx, w_ada, b_ada, g_norm1, g_norm2, w_in, a_q_gain, a_k_gain, b_q_gain, b_kv_gain,
              b_w_q_up, b_w_kv_up, c_mu, c_w0, c_w_decay, c_a0, c_w_aaa, c_w_gate, c_k_k, c_k_a, c_r_k,
              c_gn_w, c_gn_b, d_rel_bias, w_branch, w_out, w_mlp1, w_mlp2, g_final):
    s = x.shape[1]
    t = jnp.arange(s)
    rows = t // GRID_W
    cols = t % GRID_W
    xc = ctx
    for l in range(DEPTH):
        mod_lat = (jax.nn.silu(c) @ w_ada[l] + b_ada[l])[:, None, :]
        mod_ctx = (jax.nn.silu(c_ctx) @ w_ada[l] + b_ada[l])[None, None, :]
        lp = dict(g_norm1=g_norm1[l], g_norm2=g_norm2[l], w_in=w_in[l],
                  a_q_gain=a_q_gain[l], a_k_gain=a_k_gain[l],
                  b_q_gain=b_q_gain[l], b_kv_gain=b_kv_gain[l], b_w_q_up=b_w_q_up[l], b_w_kv_up=b_w_kv_up[l],
                  c_mu=c_mu[l], c_w0=c_w0[l], c_w_decay=c_w_decay[l], c_a0=c_a0[l], c_w_aaa=c_w_aaa[l],
                  c_w_gate=c_w_gate[l], c_k_k=c_k_k[l], c_k_a=c_k_a[l], c_r_k=c_r_k[l],
                  c_gn_w=c_gn_w[l], c_gn_b=c_gn_b[l], d_rel_bias=d_rel_bias[l],
                  w_branch=w_branch[l], w_out=w_out[l], w_mlp1=w_mlp1[l], w_mlp2=w_mlp2[l])
        x, xc = _layer(x, xc, rows, cols, mod_lat, mod_ctx, lp, l == DEPTH - 1)
    return rms_norm(x, g_final)
```

```cpp
#include <hip/hip_runtime.h>
#include <hip/hip_cooperative_groups.h>
#include <stdint.h>
#include <cstdio>
namespace cg = cooperative_groups;

typedef unsigned short u16;
typedef __attribute__((ext_vector_type(8))) short bf16x8;
typedef __attribute__((ext_vector_type(4))) float f32x4;
#define DI __device__ __forceinline__

constexpr int DM = 1024, TL = 2304;
constexpr int BC = 8, NCHUNK = 2, TC = BC * TL;
constexpr int NP = 4992;
constexpr int PA_Q = 0, PA_K = 512, PA_V = 640, PB_CQ = 768, PB_CKV = 1152, PB_KR = 1408;
constexpr int PC_R = 1440, PC_K = 1952, PC_V = 2464, PC_WLO = 2976, PC_ALO = 3104, PC_GLO = 3232;
constexpr int PD_Q = 3360, PD_K = 3872, PD_V = 4384;
constexpr int O_A = 0, O_B = 768, O_C = 1440, O_D = 3360;

constexpr int W_IN = 0, W_G = 5111808, W_QUP = 9306112, W_KVUP = 9601024, W_GATE = 9863168, W_DEC = 9928704,
              W_AAA = 9994240, W_BR = 10059776, W_OUT = 12156928, W_1 = 13205504, W_2 = 17399808, W_TOTAL = 21594112;

constexpr size_t OFF_MOD = 0;
constexpr size_t OFF_CTR = 835584;
constexpr size_t OFF_ROPE = 1048576;
constexpr size_t OFF_W = 2097152;
constexpr size_t OFF_H = OFF_W + (size_t)2 * W_TOTAL * 2;
constexpr size_t OFF_P = OFF_H + (size_t)TC * 1024 * 2;
constexpr size_t OFF_KA = OFF_P + (size_t)TC * NP * 2;
constexpr size_t OFF_VTA = OFF_KA + (size_t)BC * 2 * TL * 64 * 2;
constexpr size_t OFF_QB = OFF_VTA + (size_t)BC * 2 * TL * 64 * 2;
constexpr size_t OFF_KB = OFF_QB + (size_t)TC * 768 * 2;
constexpr size_t OFF_VTB = OFF_KB + (size_t)TC * 768 * 2;
constexpr size_t OFF_VTD = OFF_VTB + (size_t)TC * 512 * 2;
constexpr size_t OFF_GL = OFF_VTD + (size_t)TC * 512 * 2;
constexpr size_t OFF_G = OFF_GL + (size_t)TC * 128 * 2;
constexpr size_t OFF_YF = OFF_G + (size_t)TC * 512 * 2;
constexpr size_t OFF_YB = OFF_YF + (size_t)TC * 512 * 2;
constexpr size_t OFF_BON = OFF_YB + (size_t)TC * 512 * 2;
constexpr size_t OFF_XC = OFF_BON + (size_t)TC * 16 * 4;
constexpr size_t OFF_END = OFF_XC + (size_t)BC * 256 * 1024 * 4;
constexpr size_t OFF_YM = OFF_QB;

struct Params {
  const float* in[32];
  float* out;
  unsigned char* ws;
};

DI u16 f2bf(float f) { uint32_t u = __float_as_uint(f); u += 0x7fffu + ((u >> 16) & 1u); return (u16)(u >> 16); }
DI float bf2f(u16 h) { return __uint_as_float(((uint32_t)h) << 16); }
DI uint32_t pack2(float a, float b) { return (uint32_t)f2bf(a) | ((uint32_t)f2bf(b) << 16); }
DI float lo2f(uint32_t u) { return __uint_as_float(u << 16); }
DI float hi2f(uint32_t u) { return __uint_as_float(u & 0xffff0000u); }
DI float wave_sum(float v) {
#pragma unroll
  for (int o = 32; o >= 1; o >>= 1) v += __shfl_xor(v, o);
  return v;
}
DI float quad_sum(float v) {
  v += __int_as_float(__builtin_amdgcn_update_dpp(0, __float_as_int(v), 0xB1, 0xF, 0xF, true));
  v += __int_as_float(__builtin_amdgcn_update_dpp(0, __float_as_int(v), 0x4E, 0xF, 0xF, true));
  return v;
}
DI int otid() { int t = threadIdx.x; asm volatile("" : "+v"(t)); return t; }
DI float sigmoidf_(float x) { return 1.f / (1.f + __expf(-x)); }

DI float* x1_row(const Params& p, int chunk, int row) {
  int bl = row / TL, j = row - bl * TL;
  if (j < 256) return (float*)(p.ws + OFF_XC) + ((size_t)(bl * 256 + j)) * DM;
  return p.out + ((size_t)((chunk * BC + bl) * 2048 + (j - 256))) * DM;
}
DI const float* xin_row(const Params& p, int chunk, int row) {
  int bl = row / TL, j = row - bl * TL;
  int b = chunk * BC + bl;
  if (j < 256) return p.in[2] + ((size_t)(b * 256 + j)) * DM;
  return p.in[0] + ((size_t)(b * 2048 + (j - 256))) * DM;
}
DI int mod_row(int chunk, int row) {
  int bl = row / TL, j = row - bl * TL;
  return (j < 256) ? 16 : (chunk * BC + bl);
}

__constant__ int CONVTAB[16][8] = {
  {8, 1024 * 8992, 0, 1024, 8992, 0, 4896, W_IN},
  {8, 1024 * 8992, 0, 1024, 8992, 4896, 4096, W_G},
  {13, 384 * 768, 0, 384, 768, 0, 768, W_QUP},
  {14, 256 * 1024, 0, 256, 1024, 0, 1024, W_KVUP},
  {20, 128 * 512, 0, 128, 512, 0, 512, W_GATE},
  {17, 2 * 64 * 512, 0, 64, 512, 0, 512, W_DEC},
  {17, 2 * 64 * 512, 64 * 512, 64, 512, 0, 512, W_DEC + 512 * 64},
  {19, 2 * 64 * 512, 0, 64, 512, 0, 512, W_AAA},
  {19, 2 * 64 * 512, 64 * 512, 64, 512, 0, 512, W_AAA + 512 * 64},
  {27, 4 * 512 * 1024, 0, 512, 1024, 0, 1024, W_BR},
  {27, 4 * 512 * 1024, 512 * 1024, 512, 1024, 0, 1024, W_BR + 1024 * 512},
  {27, 4 * 512 * 1024, 2 * 512 * 1024, 512, 1024, 0, 1024, W_BR + 2 * 1024 * 512},
  {27, 4 * 512 * 1024, 3 * 512 * 1024, 512, 1024, 0, 1024, W_BR + 3 * 1024 * 512},
  {28, 1024 * 1024, 0, 1024, 1024, 0, 1024, W_OUT},
  {29, 1024 * 4096, 0, 1024, 4096, 0, 4096, W_1},
  {30, 4096 * 1024, 0, 4096, 1024, 0, 1024, W_2},
};
constexpr int CONV_TILES_PER_LAYER = 1232 + 1024 + 72 + 64 + 16 + 8 + 8 + 8 + 8 + 128 * 4 + 256 + 1024 + 1024;

__device__ void conv_tile(const float* __restrict__ src, int ld, int k0, int n0, int ncols, u16* __restrict__ dst, int K,
                          float* tile, const int tid) {
  {
    const int c4 = (tid & 15) * 4;
#pragma unroll
    for (int i = 0; i < 4; ++i) {
      int r = (tid >> 4) + 16 * i;
      float4 v = make_float4(0.f, 0.f, 0.f, 0.f);
      if (n0 + c4 < ncols) v = *(const float4*)(src + (size_t)(k0 + r) * ld + n0 + c4);
      tile[r * 65 + c4 + 0] = v.x; tile[r * 65 + c4 + 1] = v.y; tile[r * 65 + c4 + 2] = v.z; tile[r * 65 + c4 + 3] = v.w;
    }
  }
  __syncthreads();
  {
    const int n = tid >> 2, kc = (tid & 3) * 16;
    if (n0 + n < ncols) {
      uint32_t w[8];
#pragma unroll
      for (int i = 0; i < 8; ++i) w[i] = pack2(tile[(kc + 2 * i) * 65 + n], tile[(kc + 2 * i + 1) * 65 + n]);
      uint4* d = (uint4*)(dst + (size_t)(n0 + n) * K + k0 + kc);
      d[0] = make_uint4(w[0], w[1], w[2], w[3]);
      d[1] = make_uint4(w[4], w[5], w[6], w[7]);
    }
  }
  __syncthreads();
}

__device__ void phase0(const Params& p, unsigned char* smem) {
  float* fsm = (float*)smem;
  const int tid = otid();
  const int n_conv = 2 * CONV_TILES_PER_LAYER;
  const int n_pad = 2 * 48;
  const int n_ada = 2 * 16 * 24;
  const int total = n_conv + n_pad + n_ada + 1;
  u16* wbase = (u16*)(p.ws + OFF_W);
  for (int it = blockIdx.x; it < total; it += gridDim.x) {
    if (it < n_conv) {
      int l = it / CONV_TILES_PER_LAYER, r = it - l * CONV_TILES_PER_LAYER;
      int job = 0;
      for (; job < 16; ++job) {
        int nt = (CONVTAB[job][3] >> 6) * ((CONVTAB[job][6] + 63) >> 6);
        if (r < nt) break;
        r -= nt;
      }
      const int K = CONVTAB[job][3], ld = CONVTAB[job][4], col0 = CONVTAB[job][5], ncols = CONVTAB[job][6];
      const int nkt = K >> 6;
      const int kt = r % nkt, ntile = r / nkt;
      const float* src = p.in[CONVTAB[job][0]] + (size_t)l * CONVTAB[job][1] + CONVTAB[job][2] + col0;
      u16* dst = wbase + (size_t)l * W_TOTAL + CONVTAB[job][7];
      conv_tile(src, ld, kt * 64, ntile * 64, ncols, dst, K, fsm, tid);
    } else if (it < n_conv + n_pad) {
      int r = it - n_conv;
      int l = r / 48, q = r - l * 48;
      u16* dst = wbase + (size_t)l * W_TOTAL + W_IN + (size_t)(4896 + q * 2) * 1024;
      *(uint4*)(dst + tid * 8) = make_uint4(0, 0, 0, 0);
    } else if (it < n_conv + n_pad + n_ada) {
      int r = it - n_conv - n_pad;
      int l = r / 384; r -= l * 384;
      int kc = r / 24, nb = r - kc * 24;
      for (int idx = tid; idx < 17 * 64; idx += 256) {
        int rr = idx >> 6, k = idx & 63;
        float cv = (rr < 16) ? p.in[1][rr * 1024 + kc * 64 + k] : p.in[3][kc * 64 + k];
        fsm[idx] = cv / (1.f + expf(-cv));
      }
      __syncthreads();
      const int n = nb * 256 + tid;
      float acc[17];
#pragma unroll
      for (int i = 0; i < 17; ++i) acc[i] = 0.f;
      const float* wp = p.in[4] + ((size_t)l * 1024 + kc * 64) * 6144 + n;
#pragma unroll 4
      for (int k = 0; k < 64; ++k) {
        float w = wp[(size_t)k * 6144];
#pragma unroll
        for (int i = 0; i < 17; ++i) acc[i] += fsm[i * 64 + k] * w;
      }
      float bias = (kc == 0) ? p.in[5][l * 6144 + n] : 0.f;
      float* mod = (float*)(p.ws + OFF_MOD);
#pragma unroll
      for (int i = 0; i < 17; ++i) atomicAdd(&mod[(size_t)(l * 17 + i) * 6144 + n], acc[i] + bias);
      __syncthreads();
    } else {
      float* ra = (float*)(p.ws + OFF_ROPE);
      float* rb = ra + 64 * 16 * 2;
      for (int idx = tid; idx < 64 * 16; idx += 256) {
        int pos = idx >> 4, i = idx & 15;
        float inv = powf(10000.f, -(float)i / 16.f);
        float ang = (float)pos * inv;
        ra[idx * 2] = cosf(ang); ra[idx * 2 + 1] = sinf(ang);
      }
      for (int idx = tid; idx < 64 * 8; idx += 256) {
        int pos = idx >> 3, i = idx & 7;
        float inv = powf(10000.f, -(float)i / 8.f);
        float ang = (float)pos * inv;
        rb[idx * 2] = cosf(ang); rb[idx * 2 + 1] = sinf(ang);
      }
    }
  }
}

__device__ void phase_norm(const Params& p, int chunk, int l, int which, bool latonly) {
  const int tid = otid();
  const int lane = tid & 63, wave = tid >> 6;
  const float* g = p.in[which == 0 ? 6 : 7] + l * 1024;
  const float* mod = (const float*)(p.ws + OFF_MOD) + (size_t)l * 17 * 6144;
  u16* H = (u16*)(p.ws + OFF_H);
  for (int row = blockIdx.x * 4 + wave; row < TC; row += gridDim.x * 4) {
    int j = row % TL;
    if (latonly && j < 256) continue;
    const float* src = (which == 0 && l == 0) ? xin_row(p, chunk, row) : (const float*)x1_row(p, chunk, row);
    const float* mr = mod + (size_t)mod_row(chunk, row) * 6144 + which * 3072;
    float4 v[4];
    float ss = 0.f;
#pragma unroll
    for (int i = 0; i < 4; ++i) {
      v[i] = *(const float4*)(src + i * 256 + lane * 4);
      ss += v[i].x * v[i].x + v[i].y * v[i].y + v[i].z * v[i].z + v[i].w * v[i].w;
    }
    ss = wave_sum(ss);
    float rs = rsqrtf(ss * (1.f / 1024.f) + 1e-6f);
#pragma unroll
    for (int i = 0; i < 4; ++i) {
      int c = i * 256 + lane * 4;
      float4 gg = *(const float4*)(g + c);
      float4 sh = *(const float4*)(mr + c);
      float4 sc = *(const float4*)(mr + 1024 + c);
      float a0 = v[i].x * rs * gg.x * (1.f + sc.x) + sh.x;
      float a1 = v[i].y * rs * gg.y * (1.f + sc.y) + sh.y;
      float a2 = v[i].z * rs * gg.z * (1.f + sc.z) + sh.z;
      float a3 = v[i].w * rs * gg.w * (1.f + sc.w) + sh.w;
      *(uint2*)(H + (size_t)row * 1024 + c) = make_uint2(pack2(a0, a1), pack2(a2, a3));
    }
  }
}

__device__ void phase_final(const Params& p, int chunk) {
  const int tid = otid();
  const int lane = tid & 63, wave = tid >> 6;
  const float* g = p.in[31];
  for (int r = blockIdx.x * 4 + wave; r < BC * 2048; r += gridDim.x * 4) {
    float* px = p.out + ((size_t)chunk * BC * 2048 + r) * DM;
    float4 v[4];
    float ss = 0.f;
#pragma unroll
    for (int i = 0; i < 4; ++i) {
      v[i] = *(const float4*)(px + i * 256 + lane * 4);
      ss += v[i].x * v[i].x + v[i].y * v[i].y + v[i].z * v[i].z + v[i].w * v[i].w;
    }
    ss = wave_sum(ss);
    float rs = rsqrtf(ss * (1.f / 1024.f) + 1e-6f);
#pragma unroll
    for (int i = 0; i < 4; ++i) {
      int c = i * 256 + lane * 4;
      float4 gg = *(const float4*)(g + c);
      *(float4*)(px + c) = make_float4(v[i].x * rs * gg.x, v[i].y * rs * gg.y, v[i].z * rs * gg.z, v[i].w * rs * gg.w);
    }
  }
}

constexpr int LROW = 72;
template <int NI>
DI void gemm_mainloop(const u16* __restrict__ A, int lda, const u16* __restrict__ Bt, int ldb, int K, f32x4 (&acc)[4][NI],
                      u16* sm, const int tid) {
  constexpr int BN = 32 * NI;
  constexpr int NBCH = BN / 32;
  u16* sA = sm;
  u16* sB = sm + 2 * 128 * LROW;
  const int lane = tid & 63, wave = tid >> 6, l15 = lane & 15, quad = lane >> 4;
  const int wm = wave >> 1, wn = wave & 1;
  const int lr = tid >> 3, lc = (tid & 7) * 8;
  const u16* Ap = A + (size_t)lr * lda + lc;
  const u16* Bp = Bt + (size_t)lr * ldb + lc;
  uint4 ra[4], rb[NBCH];
#pragma unroll
  for (int i = 0; i < 4; ++i) ra[i] = *(const uint4*)(Ap + (size_t)(32 * i) * lda);
#pragma unroll
  for (int i = 0; i < NBCH; ++i) rb[i] = *(const uint4*)(Bp + (size_t)(32 * i) * ldb);
#pragma unroll
  for (int i = 0; i < 4; ++i) *(uint4*)(sA + (lr + 32 * i) * LROW + lc) = ra[i];
#pragma unroll
  for (int i = 0; i < NBCH; ++i) *(uint4*)(sB + (lr + 32 * i) * LROW + lc) = rb[i];
  __syncthreads();
  const int nk = K >> 6;
  for (int kt = 0; kt < nk; ++kt) {
    const int cur = kt & 1;
    if (kt + 1 < nk) {
      const int ko = (kt + 1) * 64;
#pragma unroll
      for (int i = 0; i < 4; ++i) ra[i] = *(const uint4*)(Ap + (size_t)(32 * i) * lda + ko);
#pragma unroll
      for (int i = 0; i < NBCH; ++i) rb[i] = *(const uint4*)(Bp + (size_t)(32 * i) * ldb + ko);
    }
    const u16* a_s = sA + cur * 128 * LROW;
    const u16* b_s = sB + cur * BN * LROW;
#pragma unroll
    for (int ks = 0; ks < 2; ++ks) {
      bf16x8 af[4], bfr[NI];
#pragma unroll
      for (int mi = 0; mi < 4; ++mi) af[mi] = *(const bf16x8*)(a_s + (wm * 64 + mi * 16 + l15) * LROW + ks * 32 + quad * 8);
#pragma unroll
      for (int ni = 0; ni < NI; ++ni) bfr[ni] = *(const bf16x8*)(b_s + (wn * 16 * NI + ni * 16 + l15) * LROW + ks * 32 + quad * 8);
#pragma unroll
      for (int mi = 0; mi < 4; ++mi)
#pragma unroll
        for (int ni = 0; ni < NI; ++ni) acc[mi][ni] = __builtin_amdgcn_mfma_f32_16x16x32_bf16(af[mi], bfr[ni], acc[mi][ni], 0, 0, 0);
    }
    if (kt + 1 < nk) {
      u16* a_d = sA + (cur ^ 1) * 128 * LROW;
      u16* b_d = sB + (cur ^ 1) * BN * LROW;
#pragma unroll
      for (int i = 0; i < 4; ++i) *(uint4*)(a_d + (lr + 32 * i) * LROW + lc) = ra[i];
#pragma unroll
      for (int i = 0; i < NBCH; ++i) *(uint4*)(b_d + (lr + 32 * i) * LROW + lc) = rb[i];
    }
    __syncthreads();
  }
}

DI bool tile_map(int t, int nMg, int nNt, bool latonly, int& mt, int& nt) {
  int x = t & 7, rest = t >> 3;
  int ni = rest & 7, q = rest >> 3;
  int mg = q % nMg, ng = q / nMg;
  nt = ng * 8 + ni;
  if (nt >= nNt) return false;
  int mti = mg * 8 + x;
  mt = latonly ? ((mti >> 4) * 18 + 2 + (mti & 15)) : mti;
  return true;
}

template <class Epi>
__device__ void gemm_phase(const u16* A, int lda, const u16* Bt, int K, int nNt, bool latonly, Epi epi, u16* sm) {
  const int nMg = latonly ? 16 : 18;
  const int total = 64 * nMg * ((nNt + 7) >> 3);
  const int tid = otid();
  const int lane = tid & 63, wave = tid >> 6, l15 = lane & 15, quad = lane >> 4;
  const int wm = wave >> 1, wn = wave & 1;
  for (int t = blockIdx.x; t < total; t += gridDim.x) {
    int mt, nt;
    if (!tile_map(t, nMg, nNt, latonly, mt, nt)) continue;
    const int m0 = mt * 128, n0 = nt * 128;
    f32x4 acc[4][4];
#pragma unroll
    for (int mi = 0; mi < 4; ++mi)
#pragma unroll
      for (int ni = 0; ni < 4; ++ni) acc[mi][ni] = (f32x4){0.f, 0.f, 0.f, 0.f};
    gemm_mainloop<4>(A + (size_t)m0 * lda, lda, Bt + (size_t)n0 * K, K, K, acc, sm, tid);
#pragma unroll
    for (int mi = 0; mi < 4; ++mi)
#pragma unroll
      for (int ni = 0; ni < 4; ++ni) epi(m0 + wm * 64 + mi * 16 + quad * 4, n0 + wn * 64 + ni * 16 + l15, acc[mi][ni]);
  }
}

struct EpiStore {
  u16* C; int ldc;
  DI void operator()(int r0, int c, f32x4 v) const {
#pragma unroll
    for (int j = 0; j < 4; ++j) C[(size_t)(r0 + j) * ldc + c] = f2bf(v[j]);
  }
};
struct EpiKV {
  u16* KB; u16* VtB;
  DI void operator()(int r0, int c, f32x4 v) const {
    int bl = r0 / TL, j0 = r0 - bl * TL;
    int head = c >> 7, w = c & 127;
    if (w < 64) {
#pragma unroll
      for (int j = 0; j < 4; ++j) KB[((size_t)(bl * 8 + head) * TL + j0 + j) * 96 + w] = f2bf(v[j]);
    } else {
      *(uint2*)(VtB + ((size_t)(bl * 8 + head) * 64 + (w - 64)) * TL + j0) = make_uint2(pack2(v[0], v[1]), pack2(v[2], v[3]));
    }
  }
};
struct EpiRelu2 {
  u16* C;
  DI void operator()(int r0, int c, f32x4 v) const {
#pragma unroll
    for (int j = 0; j < 4; ++j) { float t = fmaxf(v[j], 0.f); C[(size_t)(r0 + j) * 4096 + c] = f2bf(t * t); }
  }
};
struct EpiResid {
  Params p; int chunk; const float* mod; int gofs; bool from_input;
  DI void operator()(int r0, int c, f32x4 v) const {
    const float gt = mod[(size_t)mod_row(chunk, r0) * 6144 + gofs + c];
#pragma unroll
    for (int j = 0; j < 4; ++j) {
      float* dst = x1_row(p, chunk, r0 + j) + c;
      float xin = from_input ? xin_row(p, chunk, r0 + j)[c] : *dst;
      *dst = xin + gt * v[j];
    }
  }
};

__device__ void phase_merge(const Params& p, int l, bool latonly, u16* sm) {
  const u16* H = (const u16*)(p.ws + OFF_H);
  const u16* P = (const u16*)(p.ws + OFF_P);
  const u16* W = (const u16*)(p.ws + OFF_W) + (size_t)l * W_TOTAL;
  u16* YM = (u16*)(p.ws + OFF_YM);
  const int nMg = latonly ? 16 : 18;
  const int nNt = 16;
  const int total = 64 * nMg * 2;
  const int tid = otid();
  const int lane = tid & 63, wave = tid >> 6, l15 = lane & 15, quad = lane >> 4;
  const int wm = wave >> 1, wn = wave & 1;
  for (int t = blockIdx.x; t < total; t += gridDim.x) {
    int mt, nt;
    if (!tile_map(t, nMg, nNt, latonly, mt, nt)) continue;
    const int m0 = mt * 128, n0 = nt * 64;
    f32x4 y[4][2];
#pragma unroll
    for (int mi = 0; mi < 4; ++mi)
#pragma unroll
      for (int ni = 0; ni < 2; ++ni) y[mi][ni] = (f32x4){0.f, 0.f, 0.f, 0.f};
    for (int i = 0; i < 4; ++i) {
      const int ocol = (i == 0) ? O_A : (i == 1) ? O_B : (i == 2) ? O_C : O_D;
      f32x4 g[4][2], b[4][2];
#pragma unroll
      for (int mi = 0; mi < 4; ++mi)
#pragma unroll
        for (int ni = 0; ni < 2; ++ni) { g[mi][ni] = (f32x4){0.f, 0.f, 0.f, 0.f}; b[mi][ni] = (f32x4){0.f, 0.f, 0.f, 0.f}; }
      gemm_mainloop<2>(H + (size_t)m0 * 1024, 1024, W + W_G + (size_t)(i * 1024 + n0) * 1024, 1024, 1024, g, sm, tid);
      gemm_mainloop<2>(P + (size_t)m0 * NP + ocol, NP, W + W_BR + (size_t)(i * 1024 + n0) * 512, 512, 512, b, sm, tid);
#pragma unroll
      for (int mi = 0; mi < 4; ++mi)
#pragma unroll
        for (int ni = 0; ni < 2; ++ni)
#pragma unroll
          for (int j = 0; j < 4; ++j) y[mi][ni][j] += sigmoidf_(g[mi][ni][j]) * b[mi][ni][j];
    }
#pragma unroll
    for (int mi = 0; mi < 4; ++mi)
#pragma unroll
      for (int ni = 0; ni < 2; ++ni)
#pragma unroll
        for (int j = 0; j < 4; ++j)
          YM[(size_t)(m0 + wm * 64 + mi * 16 + quad * 4 + j) * 1024 + n0 + wn * 32 + ni * 16 + l15] = f2bf(y[mi][ni][j]);
  }
}

__device__ void transpose64(const u16* __restrict__ src, int lds_, u16* __restrict__ dst, int ldd, u16* tile, const int tid) {
  {
    const int r = tid >> 2, c = (tid & 3) * 16;
    uint4 a = *(const uint4*)(src + (size_t)r * lds_ + c);
    uint4 b = *(const uint4*)(src + (size_t)r * lds_ + c + 8);
    uint32_t* t32 = (uint32_t*)(tile + r * 66 + c);
    t32[0] = a.x; t32[1] = a.y; t32[2] = a.z; t32[3] = a.w; t32[4] = b.x; t32[5] = b.y; t32[6] = b.z; t32[7] = b.w;
  }
  __syncthreads();
  {
    const int d = tid >> 2, tc = (tid & 3) * 16;
    uint32_t w[8];
#pragma unroll
    for (int i = 0; i < 8; ++i) w[i] = (uint32_t)tile[(tc + 2 * i) * 66 + d] | ((uint32_t)tile[(tc + 2 * i + 1) * 66 + d] << 16);
    uint4* o = (uint4*)(dst + (size_t)d * ldd + tc);
    o[0] = make_uint4(w[0], w[1], w[2], w[3]);
    o[1] = make_uint4(w[4], w[5], w[6], w[7]);
  }
  __syncthreads();
}

__device__ void phase_prep(const Params& p, int l, u16* sm) {
  const int tid = otid();
  const int lane = tid & 63, wave = tid >> 6;
  u16* P = (u16*)(p.ws + OFF_P);
  u16* KA = (u16*)(p.ws + OFF_KA);
  u16* VtA = (u16*)(p.ws + OFF_VTA);
  u16* KB = (u16*)(p.ws + OFF_KB);
  u16* VtD = (u16*)(p.ws + OFF_VTD);
  u16* GL = (u16*)(p.ws + OFF_GL);
  const float* ropeA = (const float*)(p.ws + OFF_ROPE);
  const float* ropeB = ropeA + 64 * 16 * 2;
  const float aqg = p.in[9][l * 64 + lane], akg = p.in[10][l * 64 + lane];
  const float* bqg = p.in[11] + l * 384;
  const float* bkvg = p.in[12] + l * 256;
  const float* mu = p.in[15] + l * 1920;
  for (int tok = blockIdx.x * 4 + wave; tok < TC; tok += gridDim.x * 4) {
    const int bl = tok / TL, j = tok - bl * TL;
    const bool islat = j >= 256;
    const int jj = j - 256;
    const int grow = (jj >> 6) & 31, gcol = jj & 63;
    u16* pr = P + (size_t)tok * NP;
    float ca = 1.f, sa = 0.f;
    if (islat) {
      int pos = (lane < 32) ? grow : gcol;
      ca = ropeA[(pos * 16 + (lane & 15)) * 2];
      sa = ropeA[(pos * 16 + (lane & 15)) * 2 + 1];
    }
    for (int h = 0; h < 10; ++h) {
      float x = bf2f(pr[h * 64 + lane]);
      float ss = wave_sum(x * x);
      float y = x * rsqrtf(ss * (1.f / 64.f) + 1e-6f) * (h < 8 ? aqg : akg);
      float yp = __shfl_xor(y, 16);
      float o = ((lane & 16) == 0) ? (y * ca - yp * sa) : (yp * sa + y * ca);
      if (h < 8) pr[h * 64 + lane] = f2bf(o);
      else KA[((size_t)(bl * 2 + (h - 8)) * TL + j) * 64 + lane] = f2bf(o);
    }
    {
      float x[6], ss = 0.f;
#pragma unroll
      for (int i = 0; i < 6; ++i) { x[i] = bf2f(pr[PB_CQ + lane + 64 * i]); ss += x[i] * x[i]; }
      ss = wave_sum(ss);
      float rs = rsqrtf(ss * (1.f / 384.f) + 1e-6f);
#pragma unroll
      for (int i = 0; i < 6; ++i) pr[PB_CQ + lane + 64 * i] = f2bf(x[i] * rs * bqg[lane + 64 * i]);
    }
    {
      float x[4], ss = 0.f;
#pragma unroll
      for (int i = 0; i < 4; ++i) { x[i] = bf2f(pr[PB_CKV + lane + 64 * i]); ss += x[i] * x[i]; }
      ss = wave_sum(ss);
      float rs = rsqrtf(ss * (1.f / 256.f) + 1e-6f);
#pragma unroll
      for (int i = 0; i < 4; ++i) pr[PB_CKV + lane + 64 * i] = f2bf(x[i] * rs * bkvg[lane + 64 * i]);
    }
    {
      float x = bf2f(pr[PB_KR + (lane & 31)]);
      float xp = __shfl_xor(x, 8);
      float o = x;
      if (islat) {
        int pos = ((lane & 31) < 16) ? grow : gcol;
        float c = ropeB[(pos * 8 + (lane & 7)) * 2], s = ropeB[(pos * 8 + (lane & 7)) * 2 + 1];
        o = ((lane & 8) == 0) ? (x * c - xp * s) : (xp * s + x * c);
      }
      if (lane < 32) {
        u16 ob = f2bf(o);
#pragma unroll
        for (int h = 0; h < 8; ++h) KB[((size_t)(bl * 8 + h) * TL + j) * 96 + 64 + lane] = ob;
      }
    }
    {
      const bool hasp = islat ? (jj > 0) : (j > 0);
      const bool hasn = islat ? (jj < 2047) : (j < 255);
#pragma unroll
      for (int i = 0; i < 2; ++i) {
        int c = lane + 64 * i;
        float cur = bf2f(pr[PC_GLO + c]);
        float pv = hasp ? bf2f(pr[PC_GLO + c - NP]) : 0.f;
        float nv = hasn ? bf2f(pr[PC_GLO + c + NP]) : 0.f;
        float z = cur + (0.5f * (pv + nv) - cur) * mu[1792 + c];
        GL[(size_t)tok * 128 + c] = f2bf(sigmoidf_(z));
      }
    }
  }
  for (int it = blockIdx.x; it < (TC / 64) * 10; it += gridDim.x) {
    int tg = it / 10, hh = it - tg * 10;
    int tok0 = tg * 64, bl = tok0 / TL, j0 = tok0 - bl * TL;
    if (hh < 2) transpose64(P + (size_t)tok0 * NP + PA_V + hh * 64, NP, VtA + ((size_t)(bl * 2 + hh) * 64) * TL + j0, TL, sm, tid);
    else transpose64(P + (size_t)tok0 * NP + PD_V + (hh - 2) * 64, NP, VtD + ((size_t)(bl * 8 + hh - 2) * 64) * TL + j0, TL, sm, tid);
  }
}

template <int DQK, int NQ, int MODE>
__device__ void flash_item(const u16* __restrict__ Qp, int ldq, const u16* __restrict__ Kp, int ldk, const u16* __restrict__ Vtp,
                           int ntiles, u16* __restrict__ Op, int ldo, float scale, bool ropeq, int qtok0,
                           const float* __restrict__ ropeB, int nat_r, const float* __restrict__ bias_g, u16* sm, const int tid) {
  constexpr int KS = DQK / 32;
  constexpr int KROW = DQK + 8;
  constexpr int KCH = (64 * DQK / 8) / 256;
  constexpr int DCH = DQK / 8;
  u16* sK = sm;
  u16* sV = sm + 2 * 64 * KROW;
  float* sBias = (float*)(sm + 2 * 64 * KROW + 2 * 64 * 72);
  const int lane = tid & 63, wave = tid >> 6, l15 = lane & 15, quad = lane >> 4;
  const float L2E = 1.4426950408889634f;
  int r0 = 0;
  if (MODE == 1) {
    r0 = min(max(nat_r - 4, 0), 24);
    for (int i = tid; i < 15 * 31; i += 256) sBias[i] = bias_g[i];
  }
  bf16x8 qf[NQ][KS];
#pragma unroll
  for (int qi = 0; qi < NQ; ++qi) {
    const int row = wave * 16 * NQ + qi * 16 + l15;
#pragma unroll
    for (int ks = 0; ks < KS; ++ks) qf[qi][ks] = *(const bf16x8*)(Qp + (size_t)row * ldq + ks * 32 + quad * 8);
    if (DQK == 96 && ropeq) {
      bf16x8 own = qf[qi][KS - 1];
      bf16x8 par = *(const bf16x8*)(Qp + (size_t)row * ldq + 64 + (quad ^ 1) * 8);
      const int qt = qtok0 + row;
      const int pos = (quad < 2) ? ((qt >> 6) & 31) : (qt & 63);
      bf16x8 res;
#pragma unroll
      for (int i = 0; i < 8; ++i) {
        float c = ropeB[(pos * 8 + i) * 2], s = ropeB[(pos * 8 + i) * 2 + 1];
        float xo = bf2f((u16)own[i]), xp = bf2f((u16)par[i]);
        float o = ((quad & 1) == 0) ? (xo * c - xp * s) : (xp * s + xo * c);
        res[i] = (short)f2bf(o);
      }
      qf[qi][KS - 1] = res;
    }
  }
  auto koff = [&](int t) -> int { return (MODE == 1) ? ((t < 8) ? (256 + (r0 + t) * 64) : ((t - 8) * 64)) : t * 64; };
  uint4 rk[KCH], rv[2];
  auto gload = [&](int t) {
    const int ko = koff(t);
#pragma unroll
    for (int i = 0; i < KCH; ++i) {
      int id = tid + 256 * i;
      int row = id / DCH, c = id - row * DCH;
      rk[i] = *(const uint4*)(Kp + (size_t)(ko + row) * ldk + c * 8);
    }
#pragma unroll
    for (int i = 0; i < 2; ++i) {
      int id = tid + 256 * i;
      int d = id >> 3, c = id & 7;
      rv[i] = *(const uint4*)(Vtp + (size_t)d * TL + ko + c * 8);
    }
  };
  auto sstore = [&](int buf) {
#pragma unroll
    for (int i = 0; i < KCH; ++i) {
      int id = tid + 256 * i;
      int row = id / DCH, c = id - row * DCH;
      *(uint4*)(sK + buf * 64 * KROW + row * KROW + c * 8) = rk[i];
    }
#pragma unroll
    for (int i = 0; i < 2; ++i) {
      int id = tid + 256 * i;
      int d = id >> 3, c = id & 7;
      *(uint4*)(sV + buf * 64 * 72 + d * 72 + c * 8) = rv[i];
    }
  };
  f32x4 o[4][NQ];
  float m[NQ], lsum[NQ];
#pragma unroll
  for (int qi = 0; qi < NQ; ++qi) {
    m[qi] = -INFINITY; lsum[qi] = 0.f;
#pragma unroll
    for (int dt = 0; dt < 4; ++dt) o[dt][qi] = (f32x4){0.f, 0.f, 0.f, 0.f};
  }
  gload(0);
  sstore(0);
  __syncthreads();
  const int qc = wave * 16 + l15;
  const int st = min(max(qc - 8, 0), 48);
  for (int t = 0; t < ntiles; ++t) {
    const int cur = t & 1;
    if (t + 1 < ntiles) gload(t + 1);
    const u16* k_s = sK + cur * 64 * KROW;
    const u16* v_s = sV + cur * 64 * 72;
    f32x4 s[4][NQ];
#pragma unroll
    for (int kt = 0; kt < 4; ++kt) {
#pragma unroll
      for (int qi = 0; qi < NQ; ++qi) s[kt][qi] = (f32x4){0.f, 0.f, 0.f, 0.f};
#pragma unroll
      for (int ks = 0; ks < KS; ++ks) {
        bf16x8 kf = *(const bf16x8*)(k_s + (kt * 16 + l15) * KROW + ks * 32 + quad * 8);
#pragma unroll
        for (int qi = 0; qi < NQ; ++qi) s[kt][qi] = __builtin_amdgcn_mfma_f32_16x16x32_bf16(kf, qf[qi][ks], s[kt][qi], 0, 0, 0);
      }
    }
    if (MODE == 1 && t < 8) {
      const int drow = r0 + t - nat_r + 7;
#pragma unroll
      for (int kt = 0; kt < 4; ++kt)
#pragma unroll
        for (int j = 0; j < 4; ++j) {
          int kc = kt * 16 + quad * 4 + j;
          bool valid = (kc >= st) && (kc < st + 16);
          int bi = drow * 31 + (kc - qc + 15);
          bi = valid ? bi : 0;
          float bv = sBias[bi];
          s[kt][0][j] = valid ? (s[kt][0][j] * scale + bv) : -INFINITY;
        }
    } else {
#pragma unroll
      for (int kt = 0; kt < 4; ++kt)
#pragma unroll
        for (int qi = 0; qi < NQ; ++qi)
#pragma unroll
          for (int j = 0; j < 4; ++j) s[kt][qi][j] *= scale;
    }
    bf16x8 pb[NQ][2];
#pragma unroll
    for (int qi = 0; qi < NQ; ++qi) {
      float mx = -INFINITY;
#pragma unroll
      for (int kt = 0; kt < 4; ++kt)
#pragma unroll
        for (int j = 0; j < 4; ++j) mx = fmaxf(mx, s[kt][qi][j]);
      mx = fmaxf(mx, __shfl_xor(mx, 16));
      mx = fmaxf(mx, __shfl_xor(mx, 32));
      const float mnew = fmaxf(m[qi], mx);
      const float alpha = __builtin_amdgcn_exp2f((m[qi] - mnew) * L2E);
      m[qi] = mnew;
      float ps = 0.f;
#pragma unroll
      for (int kt = 0; kt < 4; ++kt)
#pragma unroll
        for (int j = 0; j < 4; ++j) {
          float pv = __builtin_amdgcn_exp2f((s[kt][qi][j] - mnew) * L2E);
          s[kt][qi][j] = pv;
          ps += pv;
        }
      lsum[qi] = lsum[qi] * alpha + ps;
#pragma unroll
      for (int dt = 0; dt < 4; ++dt)
#pragma unroll
        for (int j = 0; j < 4; ++j) o[dt][qi][j] *= alpha;
#pragma unroll
      for (int kk = 0; kk < 2; ++kk) {
        bf16x8 b;
#pragma unroll
        for (int j = 0; j < 4; ++j) {
          b[j] = (short)f2bf(s[2 * kk][qi][j]);
          b[4 + j] = (short)f2bf(s[2 * kk + 1][qi][j]);
        }
        pb[qi][kk] = b;
      }
    }
#pragma unroll
    for (int kk = 0; kk < 2; ++kk)
#pragma unroll
      for (int dt = 0; dt < 4; ++dt) {
        uint2 va = *(const uint2*)(v_s + (dt * 16 + l15) * 72 + (2 * kk) * 16 + quad * 4);
        uint2 vb = *(const uint2*)(v_s + (dt * 16 + l15) * 72 + (2 * kk + 1) * 16 + quad * 4);
        uint4 vv = make_uint4(va.x, va.y, vb.x, vb.y);
        bf16x8 av = __builtin_bit_cast(bf16x8, vv);
#pragma unroll
        for (int qi = 0; qi < NQ; ++qi) o[dt][qi] = __builtin_amdgcn_mfma_f32_16x16x32_bf16(av, pb[qi][kk], o[dt][qi], 0, 0, 0);
      }
    if (t + 1 < ntiles) sstore(cur ^ 1);
    __syncthreads();
  }
#pragma unroll
  for (int qi = 0; qi < NQ; ++qi) {
    float l = lsum[qi];
    l += __shfl_xor(l, 16);
    l += __shfl_xor(l, 32);
    const float inv = 1.f / l;
    const int row = wave * 16 * NQ + qi * 16 + l15;
#pragma unroll
    for (int dt = 0; dt < 4; ++dt)
      *(uint2*)(Op + (size_t)row * ldo + dt * 16 + quad * 4) =
          make_uint2(pack2(o[dt][qi][0] * inv, o[dt][qi][1] * inv), pack2(o[dt][qi][2] * inv, o[dt][qi][3] * inv));
  }
}

__device__ void scan_item(const Params& p, int l, int bl, int h, int dir, unsigned char* smem, const int tid) {
  float* R = (float*)smem;
  float* V = R + 2048;
  float* KK = V + 2048;
  float* KD = KK + 2048;
  float* W = KD + 2048;
  float* T1 = W + 2048;
  float* Y = T1 + 2048;
  float* BONW = Y + 2048;
  u16* XW = (u16*)(BONW + 128);
  u16* XA = XW + 32 * 72;
  const int lane = tid & 63, wave = tid >> 6, l15 = lane & 15, quad = lane >> 4;
  const u16* P = (const u16*)(p.ws + OFF_P);
  u16* Yd = (u16*)(p.ws + (dir ? OFF_YB : OFF_YF));
  float* BON = (float*)(p.ws + OFF_BON);
  const u16* Wl = (const u16*)(p.ws + OFF_W) + (size_t)l * W_TOTAL;
  const float* mu = p.in[15] + l * 1920;
  const int nn = wave * 16 + l15;
  const float w0 = p.in[16][(l * 2 + dir) * 512 + h * 64 + nn];
  const float a0 = p.in[18][(l * 2 + dir) * 512 + h * 64 + nn];
  const float ka = p.in[22][l * 512 + h * 64 + nn];
  const float rk = p.in[23][l * 512 + h * 64 + nn];
  bf16x8 wdec[2], waaa[2];
#pragma unroll
  for (int ks = 0; ks < 2; ++ks) {
    wdec[ks] = *(const bf16x8*)(Wl + W_DEC + ((size_t)dir * 512 + h * 64 + nn) * 64 + ks * 32 + quad * 8);
    waaa[ks] = *(const bf16x8*)(Wl + W_AAA + ((size_t)dir * 512 + h * 64 + nn) * 64 + ks * 32 + quad * 8);
  }
  const int st_t = tid >> 3, part = tid & 7, n0 = part * 8;
  const int rl = lane >> 2, sl = lane & 3, srow = wave * 16 + rl;
  float S[16];
#pragma unroll
  for (int i = 0; i < 16; ++i) S[i] = 0.f;

  for (int seg = 0; seg < 2; ++seg) {
    const int len = seg ? 2048 : 256;
    const int tb = bl * TL + (seg ? 256 : 0);
    const int nch = len >> 5;
    for (int cc = 0; cc < nch; ++cc) {
      const int c = dir ? (nch - 1 - cc) : cc;
      const int pos0 = c * 32;
      {
        const int pos = pos0 + st_t;
        const bool hasp = pos > 0, hasn = pos < len - 1;
        const u16* rowp = P + (size_t)(tb + pos) * NP;
        auto shifted8 = [&](int col, int mucol, float* z) {
          uint4 c4 = *(const uint4*)(rowp + col);
          uint4 p4 = make_uint4(0, 0, 0, 0), n4 = make_uint4(0, 0, 0, 0);
          if (hasp) p4 = *(const uint4*)(rowp + col - NP);
          if (hasn) n4 = *(const uint4*)(rowp + col + NP);
          float4 m0 = *(const float4*)(mu + mucol), m1 = *(const float4*)(mu + mucol + 4);
          float mm[8] = {m0.x, m0.y, m0.z, m0.w, m1.x, m1.y, m1.z, m1.w};
          uint32_t cu[4] = {c4.x, c4.y, c4.z, c4.w}, pu[4] = {p4.x, p4.y, p4.z, p4.w}, nu[4] = {n4.x, n4.y, n4.z, n4.w};
#pragma unroll
          for (int i = 0; i < 4; ++i) {
            float c0 = lo2f(cu[i]), c1 = hi2f(cu[i]);
            z[2 * i] = c0 + (0.5f * (lo2f(pu[i]) + lo2f(nu[i])) - c0) * mm[2 * i];
            z[2 * i + 1] = c1 + (0.5f * (hi2f(pu[i]) + hi2f(nu[i])) - c1) * mm[2 * i + 1];
          }
        };
        float z[8];
        shifted8(PC_R + h * 64 + n0, h * 64 + n0, z);
#pragma unroll
        for (int i = 0; i < 8; ++i) R[st_t * 64 + n0 + i] = z[i];
        shifted8(PC_V + h * 64 + n0, 1024 + h * 64 + n0, z);
#pragma unroll
        for (int i = 0; i < 8; ++i) V[st_t * 64 + n0 + i] = z[i];
        shifted8(PC_K + h * 64 + n0, 512 + h * 64 + n0, z);
        {
          const float* kkp = p.in[21] + l * 512 + h * 64 + n0;
          float q[8], ss = 0.f;
#pragma unroll
          for (int i = 0; i < 8; ++i) { KD[st_t * 64 + n0 + i] = z[i]; q[i] = z[i] * kkp[i]; ss += q[i] * q[i]; }
          ss += __shfl_xor(ss, 1); ss += __shfl_xor(ss, 2); ss += __shfl_xor(ss, 4);
          float inv = 1.f / fmaxf(sqrtf(ss), 1e-12f);
#pragma unroll
          for (int i = 0; i < 8; ++i) KK[st_t * 64 + n0 + i] = q[i] * inv;
        }
        shifted8(PC_WLO + dir * 64 + n0, 1536 + dir * 64 + n0, z);
        *(uint4*)(XW + st_t * 72 + n0) = make_uint4(pack2(tanhf(z[0]), tanhf(z[1])), pack2(tanhf(z[2]), tanhf(z[3])),
                                                     pack2(tanhf(z[4]), tanhf(z[5])), pack2(tanhf(z[6]), tanhf(z[7])));
        shifted8(PC_ALO + dir * 64 + n0, 1664 + dir * 64 + n0, z);
        *(uint4*)(XA + st_t * 72 + n0) = make_uint4(pack2(z[0], z[1]), pack2(z[2], z[3]), pack2(z[4], z[5]), pack2(z[6], z[7]));
      }
      __syncthreads();
#pragma unroll
      for (int mt = 0; mt < 2; ++mt) {
        f32x4 aw = (f32x4){0.f, 0.f, 0.f, 0.f}, aa = (f32x4){0.f, 0.f, 0.f, 0.f};
#pragma unroll
        for (int ks = 0; ks < 2; ++ks) {
          bf16x8 xw = *(const bf16x8*)(XW + (mt * 16 + l15) * 72 + ks * 32 + quad * 8);
          bf16x8 xa = *(const bf16x8*)(XA + (mt * 16 + l15) * 72 + ks * 32 + quad * 8);
          aw = __builtin_amdgcn_mfma_f32_16x16x32_bf16(xw, wdec[ks], aw, 0, 0, 0);
          aa = __builtin_amdgcn_mfma_f32_16x16x32_bf16(xa, waaa[ks], aa, 0, 0, 0);
        }
#pragma unroll
        for (int j = 0; j < 4; ++j) {
          const int t = mt * 16 + quad * 4 + j;
          const float u = -(w0 + aw[j]);
          const float sp = (u > 20.f) ? u : log1pf(expf(u));
          const float wv = expf(-expf(-sp - 0.5f));
          const float av = 1.f / (1.f + expf(-(a0 + aa[j])));
          W[t * 64 + nn] = wv;
          T1[t * 64 + nn] = KK[t * 64 + nn] * av;
          const float kd = KD[t * 64 + nn] * (1.f + (av - 1.f) * ka);
          KD[t * 64 + nn] = kd;
          float bon = R[t * 64 + nn] * kd * rk;
          bon += __shfl_xor(bon, 1); bon += __shfl_xor(bon, 2); bon += __shfl_xor(bon, 4); bon += __shfl_xor(bon, 8);
          if (l15 == 0) BONW[wave * 32 + t] = bon;
        }
      }
      __syncthreads();
      for (int s = 0; s < 32; ++s) {
        const int i = dir ? (31 - s) : s;
        const float4* kk4 = (const float4*)(KK + i * 64 + sl * 16);
        const float4* t14 = (const float4*)(T1 + i * 64 + sl * 16);
        const float4* kd4 = (const float4*)(KD + i * 64 + sl * 16);
        const float4* w4 = (const float4*)(W + i * 64 + sl * 16);
        const float4* r4 = (const float4*)(R + i * 64 + sl * 16);
        const float vv = V[i * 64 + srow];
        float sa = 0.f;
#pragma unroll
        for (int q = 0; q < 4; ++q) {
          float4 k = kk4[q];
          sa += S[4 * q] * k.x + S[4 * q + 1] * k.y + S[4 * q + 2] * k.z + S[4 * q + 3] * k.w;
        }
        sa = quad_sum(sa);
        float y = 0.f;
#pragma unroll
        for (int q = 0; q < 4; ++q) {
          float4 t1 = t14[q], kd = kd4[q], w = w4[q], r = r4[q];
          S[4 * q] = S[4 * q] * w.x + (vv * kd.x - sa * t1.x);
          S[4 * q + 1] = S[4 * q + 1] * w.y + (vv * kd.y - sa * t1.y);
          S[4 * q + 2] = S[4 * q + 2] * w.z + (vv * kd.z - sa * t1.z);
          S[4 * q + 3] = S[4 * q + 3] * w.w + (vv * kd.w - sa * t1.w);
          y += S[4 * q] * r.x + S[4 * q + 1] * r.y + S[4 * q + 2] * r.z + S[4 * q + 3] * r.w;
        }
        y = quad_sum(y);
        if (sl == 0) Y[i * 64 + srow] = y;
      }
      __syncthreads();
      {
        const float* yp = Y + st_t * 64 + n0;
        const size_t tok = (size_t)(tb + pos0 + st_t);
        *(uint4*)(Yd + tok * 512 + h * 64 + n0) =
            make_uint4(pack2(yp[0], yp[1]), pack2(yp[2], yp[3]), pack2(yp[4], yp[5]), pack2(yp[6], yp[7]));
        if (part == 0) BON[tok * 16 + h * 2 + dir] = BONW[st_t] + BONW[32 + st_t] + BONW[64 + st_t] + BONW[96 + st_t];
      }
    }
  }
  __syncthreads();
}

__device__ void phase_mixers(const Params& p, int chunk, int l, bool with_ctx, int* counter, unsigned char* smem) {
  __shared__ int s_item;
  u16* sm = (u16*)smem;
  u16* P = (u16*)(p.ws + OFF_P);
  const u16* KA = (const u16*)(p.ws + OFF_KA);
  const u16* VtA = (const u16*)(p.ws + OFF_VTA);
  const u16* QB = (const u16*)(p.ws + OFF_QB);
  const u16* KB = (const u16*)(p.ws + OFF_KB);
  const u16* VtB = (const u16*)(p.ws + OFF_VTB);
  const u16* VtD = (const u16*)(p.ws + OFF_VTD);
  const float* ropeB = (const float*)(p.ws + OFF_ROPE) + 64 * 16 * 2;
  const int n_scan = BC * 8 * 2;
  const int n_al = BC * 8 * 16;
  const int n_nat = BC * 8 * 32;
  const int n_cx = BC * 8 * 2;
  const int total = n_scan + 2 * n_al + n_nat + (with_ctx ? 3 * n_cx : 0);
  const float scaleB = 0.10206207261596575f;
  while (true) {
    const int tid = otid();
    if (tid == 0) s_item = atomicAdd(counter, 1);
    __syncthreads();
    int it = s_item;
    __syncthreads();
    if (it >= total) break;
    if (it < n_scan) {
      int dir = it & 1, h = (it >> 1) & 7, bl = it >> 4;
      scan_item(p, l, bl, h, dir, smem, otid());
      continue;
    }
    it -= n_scan;
    int kind, h, bl, ntl;
    size_t tok0;
    bool rq = false;
    int qtok0 = 0, natr = 0;
    if (it < 2 * n_al) {
      kind = (it >= n_al) ? 1 : 0;
      int i2 = it - kind * n_al;
      int qt = i2 & 15; h = (i2 >> 4) & 7; bl = i2 >> 7;
      tok0 = (size_t)bl * TL + 256 + qt * 128; ntl = 36; rq = true; qtok0 = qt * 128;
    } else if (it < 2 * n_al + n_nat) {
      int i2 = it - 2 * n_al;
      kind = 3; natr = i2 & 31; h = (i2 >> 5) & 7; bl = i2 >> 8;
      tok0 = (size_t)bl * TL + 256 + natr * 64; ntl = 12;
    } else {
      int i2 = it - 2 * n_al - n_nat;
      kind = i2 / n_cx; i2 -= kind * n_cx;
      int qt = i2 & 1; h = (i2 >> 1) & 7; bl = i2 >> 4;
      tok0 = (size_t)bl * TL + qt * 128; ntl = 4;
    }
    if (kind == 1) {
      flash_item<96, 2, 0>(QB + tok0 * 768 + h * 96, 768, KB + (size_t)(bl * 8 + h) * TL * 96, 96, VtB + (size_t)(bl * 8 + h) * 64 * TL,
                           ntl, P + tok0 * NP + O_B + h * 64, NP, scaleB, rq, qtok0, ropeB, 0, nullptr, sm, otid());
    } else if (kind == 3) {
      u16* q = P + tok0 * NP + PD_Q + h * 64;
      flash_item<64, 1, 1>(q, NP, P + (size_t)bl * TL * NP + PD_K + h * 64, NP, VtD + (size_t)(bl * 8 + h) * 64 * TL, ntl, q, NP, 0.125f,
                           false, 0, ropeB, natr, p.in[26] + (size_t)(l * 8 + h) * 15 * 31, sm, otid());
    } else {
      u16* q = P + tok0 * NP + (kind == 0 ? PA_Q : PD_Q) + h * 64;
      const u16* kp = (kind == 0) ? (KA + (size_t)(bl * 2 + (h >> 2)) * TL * 64) : (P + (size_t)bl * TL * NP + PD_K + h * 64);
      const u16* vp = (kind == 0) ? (VtA + (size_t)(bl * 2 + (h >> 2)) * 64 * TL) : (VtD + (size_t)(bl * 8 + h) * 64 * TL);
      flash_item<64, 2, 0>(q, NP, kp, (kind == 0) ? 64 : NP, vp, ntl, q, NP, 0.125f, false, 0, ropeB, 0, nullptr, sm, otid());
    }
  }
}

__device__ void phase_cout(const Params& p, int l, bool latonly) {
  const int tid = otid();
  const int lane = tid & 63, wave = tid >> 6;
  u16* P = (u16*)(p.ws + OFF_P);
  const u16* YF = (const u16*)(p.ws + OFF_YF);
  const u16* YB = (const u16*)(p.ws + OFF_YB);
  const u16* G = (const u16*)(p.ws + OFF_G);
  const float* BON = (const float*)(p.ws + OFF_BON);
  const float* gnw = p.in[24] + l * 512;
  const float* gnb = p.in[25] + l * 512;
  const float* mu = p.in[15] + l * 1920 + 1024;
  for (int tok = blockIdx.x * 4 + wave; tok < TC; tok += gridDim.x * 4) {
    const int bl = tok / TL, j = tok - bl * TL;
    const bool islat = j >= 256;
    if (latonly && !islat) continue;
    const int jj = j - 256;
    const bool hasp = islat ? (jj > 0) : (j > 0);
    const bool hasn = islat ? (jj < 2047) : (j < 255);
    u16* pr = P + (size_t)tok * NP;
    for (int h = 0; h < 8; ++h) {
      const int col = h * 64 + lane;
      float y = bf2f(YF[(size_t)tok * 512 + col]) + bf2f(YB[(size_t)tok * 512 + col]);
      float mean = wave_sum(y) * (1.f / 64.f);
      float d = y - mean;
      float var = wave_sum(d * d) * (1.f / 64.f);
      float yn = d * rsqrtf(var + 64e-5f) * gnw[col] + gnb[col];
      float vc = bf2f(pr[PC_V + col]);
      float vp = hasp ? bf2f(pr[PC_V + col - NP]) : 0.f;
      float vn = hasn ? bf2f(pr[PC_V + col + NP]) : 0.f;
      float vs = vc + (0.5f * (vp + vn) - vc) * mu[col];
      float bon = BON[(size_t)tok * 16 + h * 2] + BON[(size_t)tok * 16 + h * 2 + 1];
      float oc = (yn + bon * vs) * bf2f(G[(size_t)tok * 512 + col]);
      pr[O_C + col] = f2bf(oc);
    }
  }
}

constexpr int SMEM_BYTES = 73728;
__global__ void __launch_bounds__(256, 2) fwd_megakernel(Params p) {
  __shared__ __attribute__((aligned(16))) unsigned char smem[SMEM_BYTES];
  cg::grid_group grid = cg::this_grid();
  u16* sm = (u16*)smem;
  phase0(p, smem);
  grid.sync();
  u16* H = (u16*)(p.ws + OFF_H);
  u16* P = (u16*)(p.ws + OFF_P);
  int* ctr = (int*)(p.ws + OFF_CTR);
  for (int chunk = 0; chunk < NCHUNK; ++chunk) {
    for (int l = 0; l < 2; ++l) {
      const bool last = (l == 1);
      const u16* W = (const u16*)(p.ws + OFF_W) + (size_t)l * W_TOTAL;
      const float* mod = (const float*)(p.ws + OFF_MOD) + (size_t)l * 17 * 6144;
      phase_norm(p, chunk, l, 0, false);
      grid.sync();
      gemm_phase(H, 1024, W + W_IN, 1024, 39, false, EpiStore{P, NP}, sm);
      grid.sync();
      phase_prep(p, l, sm);
      grid.sync();
      gemm_phase(P + PB_CQ, NP, W + W_QUP, 384, 6, false, EpiStore{(u16*)(p.ws + OFF_QB), 768}, sm);
      gemm_phase(P + PB_CKV, NP, W + W_KVUP, 256, 8, false, EpiKV{(u16*)(p.ws + OFF_KB), (u16*)(p.ws + OFF_VTB)}, sm);
      gemm_phase((const u16*)(p.ws + OFF_GL), 128, W + W_GATE, 128, 4, false, EpiStore{(u16*)(p.ws + OFF_G), 512}, sm);
      grid.sync();
      phase_mixers(p, chunk, l, !last, ctr + chunk * 2 + l, smem);
      grid.sync();
      phase_cout(p, l, last);
      grid.sync();
      phase_merge(p, l, last, sm);
      grid.sync();
      gemm_phase((const u16*)(p.ws + OFF_YM), 1024, W + W_OUT, 1024, 8, last, EpiResid{p, chunk, mod, 2048, l == 0}, sm);
      grid.sync();
      phase_norm(p, chunk, l, 1, last);
      grid.sync();
      gemm_phase(H, 1024, W + W_1, 1024, 32, last, EpiRelu2{P}, sm);
      grid.sync();
      gemm_phase(P, 4096, W + W_2, 4096, 8, last, EpiResid{p, chunk, mod, 5120, false}, sm);
      grid.sync();
    }
    phase_final(p, chunk);
    grid.sync();
  }
}

extern "C" void kernel_launch(void* const* d_in, const int* in_sizes, int n_in, void* d_out, int out_size, void* d_ws,
                              size_t ws_size, hipStream_t stream) {
  static int grid_blocks = 0;
  if (!grid_blocks) {
    int dev = 0, cus = 0, per_cu = 0;
    hipGetDevice(&dev);
    hipDeviceGetAttribute(&cus, hipDeviceAttributeMultiprocessorCount, dev);
    hipOccupancyMaxActiveBlocksPerMultiprocessor(&per_cu, fwd_megakernel, 256, 0);
    if (per_cu > 2) per_cu = 2;
    if (per_cu < 1) per_cu = 1;
    grid_blocks = cus * per_cu;
  }
  if (ws_size < OFF_END) fprintf(stderr, "workspace too small: %zu < %zu\n", ws_size, (size_t)OFF_END);
  Params p{};
  for (int i = 0; i < 32; ++i) p.in[i] = (const float*)d_in[i];
  p.out = (float*)d_out;
  p.ws = (unsigned char*)d_ws;
  hipMemsetAsync(d_ws, 0, 1048576, stream);
  void* args[] = {&p};
  hipError_t e = hipLaunchCooperativeKernel((void*)fwd_megakernel, dim3(grid_blocks), dim3(256), args, 0, stream);
  if (e != hipSuccess) fprintf(stderr, "cooperative launch failed: %s (grid %d)\n", hipGetErrorString(e), grid_blocks);
}
```

```cpp
#include <hip/hip_runtime.h>
#include <hip/hip_cooperative_groups.h>
#include <stdint.h>
#include <cstdio>
namespace cg = cooperative_groups;

typedef unsigned short u16;
typedef __attribute__((ext_vector_type(8))) short bf16x8;
typedef __attribute__((ext_vector_type(4))) float f32x4;
typedef __attribute__((ext_vector_type(2))) float v2f;
#define DI __device__ __forceinline__

constexpr int DM = 1024, TL = 2304;
constexpr int BC = 8, NCHUNK = 2, TC = BC * TL;
constexpr int NP = 4992;
constexpr int PA_Q = 0, PA_K = 512, PA_V = 640, PB_CQ = 768, PB_CKV = 1152, PB_KR = 1408;
constexpr int PC_R = 1440, PC_K = 1952, PC_V = 2464, PC_WLO = 2976, PC_ALO = 3104, PC_GLO = 3232;
constexpr int PD_Q = 3360, PD_K = 3872, PD_V = 4384;
constexpr int O_A = 0, O_B = 768, O_C = 1440, O_D = 3360;

constexpr int W_IN = 0, W_G = 5111808, W_QUP = 9306112, W_KVUP = 9601024, W_GATE = 9863168, W_DEC = 9928704,
              W_AAA = 9994240, W_BR = 10059776, W_OUT = 12156928, W_1 = 13205504, W_2 = 17399808, W_TOTAL = 21594112;

constexpr size_t OFF_MOD = 0;
constexpr size_t OFF_CTR = 835584;
constexpr size_t OFF_BAR = 851968;
constexpr size_t OFF_ROPE = 1048576;
constexpr size_t OFF_W = 2097152;
constexpr size_t OFF_H = OFF_W + (size_t)2 * W_TOTAL * 2;
constexpr size_t OFF_P = OFF_H + (size_t)TC * 1024 * 2;
constexpr size_t OFF_KA = OFF_P + (size_t)TC * NP * 2;
constexpr size_t OFF_VTA = OFF_KA + (size_t)BC * 2 * TL * 64 * 2;
constexpr size_t OFF_QB = OFF_VTA + (size_t)BC * 2 * TL * 64 * 2;
constexpr size_t OFF_KB = OFF_QB + (size_t)TC * 768 * 2;
constexpr size_t OFF_VTB = OFF_KB + (size_t)TC * 768 * 2;
constexpr size_t OFF_VTD = OFF_VTB + (size_t)TC * 512 * 2;
constexpr size_t OFF_GL = OFF_VTD + (size_t)TC * 512 * 2;
constexpr size_t OFF_G = OFF_GL + (size_t)TC * 128 * 2;
constexpr size_t OFF_YF = OFF_G + (size_t)TC * 512 * 2;
constexpr size_t OFF_YB = OFF_YF + (size_t)TC * 512 * 2;
constexpr size_t OFF_BON = OFF_YB + (size_t)TC * 512 * 2;
constexpr size_t OFF_XC = OFF_BON + (size_t)TC * 16 * 4;
constexpr size_t OFF_END = OFF_XC + (size_t)BC * 256 * 1024 * 4;
constexpr size_t OFF_YM = OFF_QB;

struct Params {
  const float* in[32];
  float* out;
  unsigned char* ws;
};

DI u16 f2bf(float f) { uint32_t u = __float_as_uint(f); u += 0x7fffu + ((u >> 16) & 1u); return (u16)(u >> 16); }
DI float bf2f(u16 h) { return __uint_as_float(((uint32_t)h) << 16); }
DI uint32_t pack2(float a, float b) { return (uint32_t)f2bf(a) | ((uint32_t)f2bf(b) << 16); }
DI float lo2f(uint32_t u) { return __uint_as_float(u << 16); }
DI float hi2f(uint32_t u) { return __uint_as_float(u & 0xffff0000u); }
DI float dpp_f(float v, const int ctrl_is_unused) { return v; }
#define DPP_ADD(v, ctrl) ((v) + __int_as_float(__builtin_amdgcn_update_dpp(0, __float_as_int(v), (ctrl), 0xF, 0xF, true)))
DI float row8_sum(float v) {
  v = DPP_ADD(v, 0xB1); v = DPP_ADD(v, 0x4E); v = DPP_ADD(v, 0x141);
  return v;
}
DI float row16_sum(float v) {
  v = DPP_ADD(v, 0xB1); v = DPP_ADD(v, 0x4E); v = DPP_ADD(v, 0x141); v = DPP_ADD(v, 0x140);
  return v;
}
DI float xq_sum(float v) {
  auto r = __builtin_amdgcn_permlane16_swap(__float_as_uint(v), __float_as_uint(v), false, false);
  v = __uint_as_float(r[0]) + __uint_as_float(r[1]);
  auto r2 = __builtin_amdgcn_permlane32_swap(__float_as_uint(v), __float_as_uint(v), false, false);
  return __uint_as_float(r2[0]) + __uint_as_float(r2[1]);
}
DI float xq_max(float v) {
  auto r = __builtin_amdgcn_permlane16_swap(__float_as_uint(v), __float_as_uint(v), false, false);
  v = fmaxf(__uint_as_float(r[0]), __uint_as_float(r[1]));
  auto r2 = __builtin_amdgcn_permlane32_swap(__float_as_uint(v), __float_as_uint(v), false, false);
  return fmaxf(__uint_as_float(r2[0]), __uint_as_float(r2[1]));
}
DI float wave_sum(float v) { return xq_sum(row16_sum(v)); }
DI float quad_sum(float v) {
  v += __int_as_float(__builtin_amdgcn_update_dpp(0, __float_as_int(v), 0xB1, 0xF, 0xF, true));
  v += __int_as_float(__builtin_amdgcn_update_dpp(0, __float_as_int(v), 0x4E, 0xF, 0xF, true));
  return v;
}
DI int otid() { int t = threadIdx.x; asm volatile("" : "+v"(t)); return t; }
DI float sigmoidf_(float x) { return 1.f / (1.f + __expf(-x)); }

DI float* x1_row(const Params& p, int chunk, int row) {
  int bl = row / TL, j = row - bl * TL;
  if (j < 256) return (float*)(p.ws + OFF_XC) + ((size_t)(bl * 256 + j)) * DM;
  return p.out + ((size_t)((chunk * BC + bl) * 2048 + (j - 256))) * DM;
}
DI const float* xin_row(const Params& p, int chunk, int row) {
  int bl = row / TL, j = row - bl * TL;
  int b = chunk * BC + bl;
  if (j < 256) return p.in[2] + ((size_t)(b * 256 + j)) * DM;
  return p.in[0] + ((size_t)(b * 2048 + (j - 256))) * DM;
}
DI int mod_row(int chunk, int row) {
  int bl = row / TL, j = row - bl * TL;
  return (j < 256) ? 16 : (chunk * BC + bl);
}

__constant__ int CONVTAB[16][8] = {
  {8, 1024 * 8992, 0, 1024, 8992, 0, 4896, W_IN},
  {8, 1024 * 8992, 0, 1024, 8992, 4896, 4096, W_G},
  {13, 384 * 768, 0, 384, 768, 0, 768, W_QUP},
  {14, 256 * 1024, 0, 256, 1024, 0, 1024, W_KVUP},
  {20, 128 * 512, 0, 128, 512, 0, 512, W_GATE},
  {17, 2 * 64 * 512, 0, 64, 512, 0, 512, W_DEC},
  {17, 2 * 64 * 512, 64 * 512, 64, 512, 0, 512, W_DEC + 512 * 64},
  {19, 2 * 64 * 512, 0, 64, 512, 0, 512, W_AAA},
  {19, 2 * 64 * 512, 64 * 512, 64, 512, 0, 512, W_AAA + 512 * 64},
  {27, 4 * 512 * 1024, 0, 512, 1024, 0, 1024, W_BR},
  {27, 4 * 512 * 1024, 512 * 1024, 512, 1024, 0, 1024, W_BR + 1024 * 512},
  {27, 4 * 512 * 1024, 2 * 512 * 1024, 512, 1024, 0, 1024, W_BR + 2 * 1024 * 512},
  {27, 4 * 512 * 1024, 3 * 512 * 1024, 512, 1024, 0, 1024, W_BR + 3 * 1024 * 512},
  {28, 1024 * 1024, 0, 1024, 1024, 0, 1024, W_OUT},
  {29, 1024 * 4096, 0, 1024, 4096, 0, 4096, W_1},
  {30, 4096 * 1024, 0, 4096, 1024, 0, 1024, W_2},
};
constexpr int CONV_TILES_PER_LAYER = 1232 + 1024 + 72 + 64 + 16 + 8 + 8 + 8 + 8 + 128 * 4 + 256 + 1024 + 1024;

__device__ void conv_tile(const float* __restrict__ src, int ld, int k0, int n0, int ncols, u16* __restrict__ dst, int K,
                          float* tile, const int tid) {
  {
    const int c4 = (tid & 15) * 4;
#pragma unroll
    for (int i = 0; i < 4; ++i) {
      int r = (tid >> 4) + 16 * i;
      float4 v = make_float4(0.f, 0.f, 0.f, 0.f);
      if (n0 + c4 < ncols) v = *(const float4*)(src + (size_t)(k0 + r) * ld + n0 + c4);
      tile[r * 65 + c4 + 0] = v.x; tile[r * 65 + c4 + 1] = v.y; tile[r * 65 + c4 + 2] = v.z; tile[r * 65 + c4 + 3] = v.w;
    }
  }
  __syncthreads();
  {
    const int n = tid >> 2, kc = (tid & 3) * 16;
    if (n0 + n < ncols) {
      uint32_t w[8];
#pragma unroll
      for (int i = 0; i < 8; ++i) w[i] = pack2(tile[(kc + 2 * i) * 65 + n], tile[(kc + 2 * i + 1) * 65 + n]);
      uint4* d = (uint4*)(dst + (size_t)(n0 + n) * K + k0 + kc);
      d[0] = make_uint4(w[0], w[1], w[2], w[3]);
      d[1] = make_uint4(w[4], w[5], w[6], w[7]);
    }
  }
  __syncthreads();
}

__device__ void phase0(const Params& p, unsigned char* smem) {
  float* fsm = (float*)smem;
  const int tid = otid();
  const int n_conv = 2 * CONV_TILES_PER_LAYER;
  const int n_pad = 2 * 48;
  const int n_ada = 2 * 16 * 24;
  const int total = n_conv + n_pad + n_ada + 1;
  u16* wbase = (u16*)(p.ws + OFF_W);
  for (int it = blockIdx.x; it < total; it += gridDim.x) {
    if (it < n_conv) {
      int l = it / CONV_TILES_PER_LAYER, r = it - l * CONV_TILES_PER_LAYER;
      int job = 0;
      for (; job < 16; ++job) {
        int nt = (CONVTAB[job][3] >> 6) * ((CONVTAB[job][6] + 63) >> 6);
        if (r < nt) break;
        r -= nt;
      }
      const int K = CONVTAB[job][3], ld = CONVTAB[job][4], col0 = CONVTAB[job][5], ncols = CONVTAB[job][6];
      const int nkt = K >> 6;
      const int kt = r % nkt, ntile = r / nkt;
      const float* src = p.in[CONVTAB[job][0]] + (size_t)l * CONVTAB[job][1] + CONVTAB[job][2] + col0;
      u16* dst = wbase + (size_t)l * W_TOTAL + CONVTAB[job][7];
      conv_tile(src, ld, kt * 64, ntile * 64, ncols, dst, K, fsm, tid);
    } else if (it < n_conv + n_pad) {
      int r = it - n_conv;
      int l = r / 48, q = r - l * 48;
      u16* dst = wbase + (size_t)l * W_TOTAL + W_IN + (size_t)(4896 + q * 2) * 1024;
      *(uint4*)(dst + tid * 8) = make_uint4(0, 0, 0, 0);
    } else if (it < n_conv + n_pad + n_ada) {
      int r = it - n_conv - n_pad;
      int l = r / 384; r -= l * 384;
      int kc = r / 24, nb = r - kc * 24;
      for (int idx = tid; idx < 17 * 64; idx += 256) {
        int rr = idx >> 6, k = idx & 63;
        float cv = (rr < 16) ? p.in[1][rr * 1024 + kc * 64 + k] : p.in[3][kc * 64 + k];
        fsm[idx] = cv / (1.f + expf(-cv));
      }
      __syncthreads();
      const int n = nb * 256 + tid;
      float acc[17];
#pragma unroll
      for (int i = 0; i < 17; ++i) acc[i] = 0.f;
      const float* wp = p.in[4] + ((size_t)l * 1024 + kc * 64) * 6144 + n;
#pragma unroll 4
      for (int k = 0; k < 64; ++k) {
        float w = wp[(size_t)k * 6144];
#pragma unroll
        for (int i = 0; i < 17; ++i) acc[i] += fsm[i * 64 + k] * w;
      }
      float bias = (kc == 0) ? p.in[5][l * 6144 + n] : 0.f;
      float* mod = (float*)(p.ws + OFF_MOD);
#pragma unroll
      for (int i = 0; i < 17; ++i) atomicAdd(&mod[(size_t)(l * 17 + i) * 6144 + n], acc[i] + bias);
      __syncthreads();
    } else {
      float* ra = (float*)(p.ws + OFF_ROPE);
      float* rb = ra + 64 * 16 * 2;
      for (int idx = tid; idx < 64 * 16; idx += 256) {
        int pos = idx >> 4, i = idx & 15;
        float inv = powf(10000.f, -(float)i / 16.f);
        float ang = (float)pos * inv;
        ra[idx * 2] = cosf(ang); ra[idx * 2 + 1] = sinf(ang);
      }
      for (int idx = tid; idx < 64 * 8; idx += 256) {
        int pos = idx >> 3, i = idx & 7;
        float inv = powf(10000.f, -(float)i / 8.f);
        float ang = (float)pos * inv;
        rb[idx * 2] = cosf(ang); rb[idx * 2 + 1] = sinf(ang);
      }
    }
  }
}

__device__ void phase_norm(const Params& p, int chunk, int l, int which, bool latonly) {
  const int tid = otid();
  const int lane = tid & 63, wave = tid >> 6;
  const float* g = p.in[which == 0 ? 6 : 7] + l * 1024;
  const float* mod = (const float*)(p.ws + OFF_MOD) + (size_t)l * 17 * 6144;
  u16* H = (u16*)(p.ws + OFF_H);
  for (int row = blockIdx.x * 4 + wave; row < TC; row += gridDim.x * 4) {
    int j = row % TL;
    if (latonly && j < 256) continue;
    const float* src = (which == 0 && l == 0) ? xin_row(p, chunk, row) : (const float*)x1_row(p, chunk, row);
    const float* mr = mod + (size_t)mod_row(chunk, row) * 6144 + which * 3072;
    float4 v[4];
    float ss = 0.f;
#pragma unroll
    for (int i = 0; i < 4; ++i) {
      v[i] = *(const float4*)(src + i * 256 + lane * 4);
      ss += v[i].x * v[i].x + v[i].y * v[i].y + v[i].z * v[i].z + v[i].w * v[i].w;
    }
    ss = wave_sum(ss);
    float rs = rsqrtf(ss * (1.f / 1024.f) + 1e-6f);
#pragma unroll
    for (int i = 0; i < 4; ++i) {
      int c = i * 256 + lane * 4;
      float4 gg = *(const float4*)(g + c);
      float4 sh = *(const float4*)(mr + c);
      float4 sc = *(const float4*)(mr + 1024 + c);
      float a0 = v[i].x * rs * gg.x * (1.f + sc.x) + sh.x;
      float a1 = v[i].y * rs * gg.y * (1.f + sc.y) + sh.y;
      float a2 = v[i].z * rs * gg.z * (1.f + sc.z) + sh.z;
      float a3 = v[i].w * rs * gg.w * (1.f + sc.w) + sh.w;
      *(uint2*)(H + (size_t)row * 1024 + c) = make_uint2(pack2(a0, a1), pack2(a2, a3));
    }
  }
}

__device__ void phase_final(const Params& p, int chunk) {
  const int tid = otid();
  const int lane = tid & 63, wave = tid >> 6;
  const float* g = p.in[31];
  for (int r = blockIdx.x * 4 + wave; r < BC * 2048; r += gridDim.x * 4) {
    float* px = p.out + ((size_t)chunk * BC * 2048 + r) * DM;
    float4 v[4];
    float ss = 0.f;
#pragma unroll
    for (int i = 0; i < 4; ++i) {
      v[i] = *(const float4*)(px + i * 256 + lane * 4);
      ss += v[i].x * v[i].x + v[i].y * v[i].y + v[i].z * v[i].z + v[i].w * v[i].w;
    }
    ss = wave_sum(ss);
    float rs = rsqrtf(ss * (1.f / 1024.f) + 1e-6f);
#pragma unroll
    for (int i = 0; i < 4; ++i) {
      int c = i * 256 + lane * 4;
      float4 gg = *(const float4*)(g + c);
      *(float4*)(px + c) = make_float4(v[i].x * rs * gg.x, v[i].y * rs * gg.y, v[i].z * rs * gg.z, v[i].w * rs * gg.w);
    }
  }
}

constexpr int LROW = 72;
template <int NI>
DI void gemm_mainloop(const u16* __restrict__ A, int lda, const u16* __restrict__ Bt, int ldb, int K, f32x4 (&acc)[4][NI],
                      u16* sm, const int tid) {
  constexpr int BN = 32 * NI;
  constexpr int NBCH = BN / 32;
  u16* sA = sm;
  u16* sB = sm + 2 * 128 * LROW;
  const int lane = tid & 63, wave = tid >> 6, l15 = lane & 15, quad = lane >> 4;
  const int wm = wave >> 1, wn = wave & 1;
  const int lr = tid >> 3, lc = (tid & 7) * 8;
  const u16* Ap = A + (size_t)lr * lda + lc;
  const u16* Bp = Bt + (size_t)lr * ldb + lc;
  uint4 ra[4], rb[NBCH];
#pragma unroll
  for (int i = 0; i < 4; ++i) ra[i] = *(const uint4*)(Ap + (size_t)(32 * i) * lda);
#pragma unroll
  for (int i = 0; i < NBCH; ++i) rb[i] = *(const uint4*)(Bp + (size_t)(32 * i) * ldb);
#pragma unroll
  for (int i = 0; i < 4; ++i) *(uint4*)(sA + (lr + 32 * i) * LROW + lc) = ra[i];
#pragma unroll
  for (int i = 0; i < NBCH; ++i) *(uint4*)(sB + (lr + 32 * i) * LROW + lc) = rb[i];
  __syncthreads();
  const int nk = K >> 6;
  for (int kt = 0; kt < nk; ++kt) {
    const int cur = kt & 1;
    if (kt + 1 < nk) {
      const int ko = (kt + 1) * 64;
#pragma unroll
      for (int i = 0; i < 4; ++i) ra[i] = *(const uint4*)(Ap + (size_t)(32 * i) * lda + ko);
#pragma unroll
      for (int i = 0; i < NBCH; ++i) rb[i] = *(const uint4*)(Bp + (size_t)(32 * i) * ldb + ko);
    }
    const u16* a_s = sA + cur * 128 * LROW;
    const u16* b_s = sB + cur * BN * LROW;
#pragma unroll
    for (int ks = 0; ks < 2; ++ks) {
      bf16x8 af[4], bfr[NI];
#pragma unroll
      for (int mi = 0; mi < 4; ++mi) af[mi] = *(const bf16x8*)(a_s + (wm * 64 + mi * 16 + l15) * LROW + ks * 32 + quad * 8);
#pragma unroll
      for (int ni = 0; ni < NI; ++ni) bfr[ni] = *(const bf16x8*)(b_s + (wn * 16 * NI + ni * 16 + l15) * LROW + ks * 32 + quad * 8);
#pragma unroll
      for (int mi = 0; mi < 4; ++mi)
#pragma unroll
        for (int ni = 0; ni < NI; ++ni) acc[mi][ni] = __builtin_amdgcn_mfma_f32_16x16x32_bf16(af[mi], bfr[ni], acc[mi][ni], 0, 0, 0);
    }
    if (kt + 1 < nk) {
      u16* a_d = sA + (cur ^ 1) * 128 * LROW;
      u16* b_d = sB + (cur ^ 1) * BN * LROW;
#pragma unroll
      for (int i = 0; i < 4; ++i) *(uint4*)(a_d + (lr + 32 * i) * LROW + lc) = ra[i];
#pragma unroll
      for (int i = 0; i < NBCH; ++i) *(uint4*)(b_d + (lr + 32 * i) * LROW + lc) = rb[i];
    }
    __syncthreads();
  }
}

DI bool tile_map(int t, int nMg, int nNt, bool latonly, int& mt, int& nt) {
  int x = t & 7, rest = t >> 3;
  int ni = rest & 7, q = rest >> 3;
  int mg = q % nMg, ng = q / nMg;
  nt = ng * 8 + ni;
  if (nt >= nNt) return false;
  int mti = mg * 8 + x;
  mt = latonly ? ((mti >> 4) * 18 + 2 + (mti & 15)) : mti;
  return true;
}

template <class Epi>
__device__ void gemm_phase(const u16* A, int lda, const u16* Bt, int K, int nNt, bool latonly, Epi epi, u16* sm) {
  const int nMg = latonly ? 16 : 18;
  const int total = 64 * nMg * ((nNt + 7) >> 3);
  const int tid = otid();
  const int lane = tid & 63, wave = tid >> 6, l15 = lane & 15, quad = lane >> 4;
  const int wm = wave >> 1, wn = wave & 1;
  for (int t = blockIdx.x; t < total; t += gridDim.x) {
    int mt, nt;
    if (!tile_map(t, nMg, nNt, latonly, mt, nt)) continue;
    const int m0 = mt * 128, n0 = nt * 128;
    f32x4 acc[4][4];
#pragma unroll
    for (int mi = 0; mi < 4; ++mi)
#pragma unroll
      for (int ni = 0; ni < 4; ++ni) acc[mi][ni] = (f32x4){0.f, 0.f, 0.f, 0.f};
    gemm_mainloop<4>(A + (size_t)m0 * lda, lda, Bt + (size_t)n0 * K, K, K, acc, sm, tid);
#pragma unroll
    for (int mi = 0; mi < 4; ++mi)
#pragma unroll
      for (int ni = 0; ni < 4; ++ni) epi(m0 + wm * 64 + mi * 16 + quad * 4, n0 + wn * 64 + ni * 16 + l15, acc[mi][ni]);
  }
}

struct EpiStore {
  u16* C; int ldc;
  DI void operator()(int r0, int c, f32x4 v) const {
#pragma unroll
    for (int j = 0; j < 4; ++j) C[(size_t)(r0 + j) * ldc + c] = f2bf(v[j]);
  }
};
struct EpiKV {
  u16* KB; u16* VtB;
  DI void operator()(int r0, int c, f32x4 v) const {
    int bl = r0 / TL, j0 = r0 - bl * TL;
    int head = c >> 7, w = c & 127;
    if (w < 64) {
#pragma unroll
      for (int j = 0; j < 4; ++j) KB[((size_t)(bl * 8 + head) * TL + j0 + j) * 96 + w] = f2bf(v[j]);
    } else {
      *(uint2*)(VtB + ((size_t)(bl * 8 + head) * 64 + (w - 64)) * TL + j0) = make_uint2(pack2(v[0], v[1]), pack2(v[2], v[3]));
    }
  }
};
struct EpiRelu2 {
  u16* C;
  DI void operator()(int r0, int c, f32x4 v) const {
#pragma unroll
    for (int j = 0; j < 4; ++j) { float t = fmaxf(v[j], 0.f); C[(size_t)(r0 + j) * 4096 + c] = f2bf(t * t); }
  }
};
struct EpiResid {
  Params p; int chunk; const float* mod; int gofs; bool from_input;
  DI void operator()(int r0, int c, f32x4 v) const {
    const float gt = mod[(size_t)mod_row(chunk, r0) * 6144 + gofs + c];
#pragma unroll
    for (int j = 0; j < 4; ++j) {
      float* dst = x1_row(p, chunk, r0 + j) + c;
      float xin = from_input ? xin_row(p, chunk, r0 + j)[c] : *dst;
      *dst = xin + gt * v[j];
    }
  }
};

__device__ void phase_merge(const Params& p, int l, bool latonly, u16* sm) {
  const u16* H = (const u16*)(p.ws + OFF_H);
  const u16* P = (const u16*)(p.ws + OFF_P);
  const u16* W = (const u16*)(p.ws + OFF_W) + (size_t)l * W_TOTAL;
  u16* YM = (u16*)(p.ws + OFF_YM);
  const int nMg = latonly ? 16 : 18;
  const int nNt = 16;
  const int total = 64 * nMg * 2;
  const int tid = otid();
  const int lane = tid & 63, wave = tid >> 6, l15 = lane & 15, quad = lane >> 4;
  const int wm = wave >> 1, wn = wave & 1;
  for (int t = blockIdx.x; t < total; t += gridDim.x) {
    int mt, nt;
    if (!tile_map(t, nMg, nNt, latonly, mt, nt)) continue;
    const int m0 = mt * 128, n0 = nt * 64;
    f32x4 y[4][2];
#pragma unroll
    for (int mi = 0; mi < 4; ++mi)
#pragma unroll
      for (int ni = 0; ni < 2; ++ni) y[mi][ni] = (f32x4){0.f, 0.f, 0.f, 0.f};
    for (int i = 0; i < 4; ++i) {
      const int ocol = (i == 0) ? O_A : (i == 1) ? O_B : (i == 2) ? O_C : O_D;
      f32x4 g[4][2], b[4][2];
#pragma unroll
      for (int mi = 0; mi < 4; ++mi)
#pragma unroll
        for (int ni = 0; ni < 2; ++ni) { g[mi][ni] = (f32x4){0.f, 0.f, 0.f, 0.f}; b[mi][ni] = (f32x4){0.f, 0.f, 0.f, 0.f}; }
      gemm_mainloop<2>(H + (size_t)m0 * 1024, 1024, W + W_G + (size_t)(i * 1024 + n0) * 1024, 1024, 1024, g, sm, tid);
      gemm_mainloop<2>(P + (size_t)m0 * NP + ocol, NP, W + W_BR + (size_t)(i * 1024 + n0) * 512, 512, 512, b, sm, tid);
#pragma unroll
      for (int mi = 0; mi < 4; ++mi)
#pragma unroll
        for (int ni = 0; ni < 2; ++ni)
#pragma unroll
          for (int j = 0; j < 4; ++j) y[mi][ni][j] += sigmoidf_(g[mi][ni][j]) * b[mi][ni][j];
    }
#pragma unroll
    for (int mi = 0; mi < 4; ++mi)
#pragma unroll
      for (int ni = 0; ni < 2; ++ni)
#pragma unroll
        for (int j = 0; j < 4; ++j)
          YM[(size_t)(m0 + wm * 64 + mi * 16 + quad * 4 + j) * 1024 + n0 + wn * 32 + ni * 16 + l15] = f2bf(y[mi][ni][j]);
  }
}

__device__ void transpose64(const u16* __restrict__ src, int lds_, u16* __restrict__ dst, int ldd, u16* tile, const int tid) {
  {
    const int r = tid >> 2, c = (tid & 3) * 16;
    uint4 a = *(const uint4*)(src + (size_t)r * lds_ + c);
    uint4 b = *(const uint4*)(src + (size_t)r * lds_ + c + 8);
    uint32_t* t32 = (uint32_t*)(tile + r * 66 + c);
    t32[0] = a.x; t32[1] = a.y; t32[2] = a.z; t32[3] = a.w; t32[4] = b.x; t32[5] = b.y; t32[6] = b.z; t32[7] = b.w;
  }
  __syncthreads();
  {
    const int d = tid >> 2, tc = (tid & 3) * 16;
    uint32_t w[8];
#pragma unroll
    for (int i = 0; i < 8; ++i) w[i] = (uint32_t)tile[(tc + 2 * i) * 66 + d] | ((uint32_t)tile[(tc + 2 * i + 1) * 66 + d] << 16);
    uint4* o = (uint4*)(dst + (size_t)d * ldd + tc);
    o[0] = make_uint4(w[0], w[1], w[2], w[3]);
    o[1] = make_uint4(w[4], w[5], w[6], w[7]);
  }
  __syncthreads();
}

__device__ void phase_prep(const Params& p, int l, u16* sm) {
  const int tid = otid();
  const int lane = tid & 63, wave = tid >> 6;
  u16* P = (u16*)(p.ws + OFF_P);
  u16* KA = (u16*)(p.ws + OFF_KA);
  u16* VtA = (u16*)(p.ws + OFF_VTA);
  u16* KB = (u16*)(p.ws + OFF_KB);
  u16* VtD = (u16*)(p.ws + OFF_VTD);
  u16* GL = (u16*)(p.ws + OFF_GL);
  const float* ropeA = (const float*)(p.ws + OFF_ROPE);
  const float* ropeB = ropeA + 64 * 16 * 2;
  const float aqg = p.in[9][l * 64 + lane], akg = p.in[10][l * 64 + lane];
  const float* bqg = p.in[11] + l * 384;
  const float* bkvg = p.in[12] + l * 256;
  const float* mu = p.in[15] + l * 1920;
  for (int tok = blockIdx.x * 4 + wave; tok < TC; tok += gridDim.x * 4) {
    const int bl = tok / TL, j = tok - bl * TL;
    const bool islat = j >= 256;
    const int jj = j - 256;
    const int grow = (jj >> 6) & 31, gcol = jj & 63;
    u16* pr = P + (size_t)tok * NP;
    float ca = 1.f, sa = 0.f;
    if (islat) {
      int pos = (lane < 32) ? grow : gcol;
      ca = ropeA[(pos * 16 + (lane & 15)) * 2];
      sa = ropeA[(pos * 16 + (lane & 15)) * 2 + 1];
    }
    for (int h = 0; h < 10; ++h) {
      float x = bf2f(pr[h * 64 + lane]);
      float ss = wave_sum(x * x);
      float y = x * rsqrtf(ss * (1.f / 64.f) + 1e-6f) * (h < 8 ? aqg : akg);
      float yp = __shfl_xor(y, 16);
      float o = ((lane & 16) == 0) ? (y * ca - yp * sa) : (yp * sa + y * ca);
      if (h < 8) pr[h * 64 + lane] = f2bf(o);
      else KA[((size_t)(bl * 2 + (h - 8)) * TL + j) * 64 + lane] = f2bf(o);
    }
    {
      float x[6], ss = 0.f;
#pragma unroll
      for (int i = 0; i < 6; ++i) { x[i] = bf2f(pr[PB_CQ + lane + 64 * i]); ss += x[i] * x[i]; }
      ss = wave_sum(ss);
      float rs = rsqrtf(ss * (1.f / 384.f) + 1e-6f);
#pragma unroll
      for (int i = 0; i < 6; ++i) pr[PB_CQ + lane + 64 * i] = f2bf(x[i] * rs * bqg[lane + 64 * i]);
    }
    {
      float x[4], ss = 0.f;
#pragma unroll
      for (int i = 0; i < 4; ++i) { x[i] = bf2f(pr[PB_CKV + lane + 64 * i]); ss += x[i] * x[i]; }
      ss = wave_sum(ss);
      float rs = rsqrtf(ss * (1.f / 256.f) + 1e-6f);
#pragma unroll
      for (int i = 0; i < 4; ++i) pr[PB_CKV + lane + 64 * i] = f2bf(x[i] * rs * bkvg[lane + 64 * i]);
    }
    {
      float x = bf2f(pr[PB_KR + (lane & 31)]);
      float xp = __shfl_xor(x, 8);
      float o = x;
      if (islat) {
        int pos = ((lane & 31) < 16) ? grow : gcol;
        float c = ropeB[(pos * 8 + (lane & 7)) * 2], s = ropeB[(pos * 8 + (lane & 7)) * 2 + 1];
        o = ((lane & 8) == 0) ? (x * c - xp * s) : (xp * s + x * c);
      }
      if (lane < 32) {
        u16 ob = f2bf(o);
#pragma unroll
        for (int h = 0; h < 8; ++h) KB[((size_t)(bl * 8 + h) * TL + j) * 96 + 64 + lane] = ob;
      }
    }
    {
      const bool hasp = islat ? (jj > 0) : (j > 0);
      const bool hasn = islat ? (jj < 2047) : (j < 255);
#pragma unroll
      for (int i = 0; i < 2; ++i) {
        int c = lane + 64 * i;
        float cur = bf2f(pr[PC_GLO + c]);
        float pv = hasp ? bf2f(pr[PC_GLO + c - NP]) : 0.f;
        float nv = hasn ? bf2f(pr[PC_GLO + c + NP]) : 0.f;
        float z = cur + (0.5f * (pv + nv) - cur) * mu[1792 + c];
        GL[(size_t)tok * 128 + c] = f2bf(sigmoidf_(z));
      }
    }
  }
  for (int it = blockIdx.x; it < (TC / 64) * 10; it += gridDim.x) {
    int tg = it / 10, hh = it - tg * 10;
    int tok0 = tg * 64, bl = tok0 / TL, j0 = tok0 - bl * TL;
    if (hh < 2) transpose64(P + (size_t)tok0 * NP + PA_V + hh * 64, NP, VtA + ((size_t)(bl * 2 + hh) * 64) * TL + j0, TL, sm, tid);
    else transpose64(P + (size_t)tok0 * NP + PD_V + (hh - 2) * 64, NP, VtD + ((size_t)(bl * 8 + hh - 2) * 64) * TL + j0, TL, sm, tid);
  }
}

template <int DQK, int NQ, int MODE>
__device__ void flash_item(const u16* __restrict__ Qp, int ldq, const u16* __restrict__ Kp, int ldk, const u16* __restrict__ Vtp,
                           int ntiles, u16* __restrict__ Op, int ldo, float scale, bool ropeq, int qtok0,
                           const float* __restrict__ ropeB, int nat_r, const float* __restrict__ bias_g, u16* sm, const int tid) {
  constexpr int KS = DQK / 32;
  constexpr int KROW = DQK + 8;
  constexpr int KCH = (64 * DQK / 8) / 256;
  constexpr int DCH = DQK / 8;
  u16* sK = sm;
  u16* sV = sm + 2 * 64 * KROW;
  float* sBias = (float*)(sm + 2 * 64 * KROW + 2 * 64 * 72);
  const int lane = tid & 63, wave = tid >> 6, l15 = lane & 15, quad = lane >> 4;
  const float L2E = 1.4426950408889634f;
  int r0 = 0;
  if (MODE == 1) {
    r0 = min(max(nat_r - 4, 0), 24);
    for (int i = tid; i < 15 * 31; i += 256) sBias[i] = bias_g[i];
  }
  bf16x8 qf[NQ][KS];
#pragma unroll
  for (int qi = 0; qi < NQ; ++qi) {
    const int row = wave * 16 * NQ + qi * 16 + l15;
#pragma unroll
    for (int ks = 0; ks < KS; ++ks) qf[qi][ks] = *(const bf16x8*)(Qp + (size_t)row * ldq + ks * 32 + quad * 8);
    if (DQK == 96 && ropeq) {
      bf16x8 own = qf[qi][KS - 1];
      bf16x8 par = *(const bf16x8*)(Qp + (size_t)row * ldq + 64 + (quad ^ 1) * 8);
      const int qt = qtok0 + row;
      const int pos = (quad < 2) ? ((qt >> 6) & 31) : (qt & 63);
      bf16x8 res;
#pragma unroll
      for (int i = 0; i < 8; ++i) {
        float c = ropeB[(pos * 8 + i) * 2], s = ropeB[(pos * 8 + i) * 2 + 1];
        float xo = bf2f((u16)own[i]), xp = bf2f((u16)par[i]);
        float o = ((quad & 1) == 0) ? (xo * c - xp * s) : (xp * s + xo * c);
        res[i] = (short)f2bf(o);
      }
      qf[qi][KS - 1] = res;
    }
  }
  auto koff = [&](int t) -> int { return (MODE == 1) ? ((t < 8) ? (256 + (r0 + t) * 64) : ((t - 8) * 64)) : t * 64; };
  uint4 rk[KCH], rv[2];
  auto gload = [&](int t) {
    const int ko = koff(t);
#pragma unroll
    for (int i = 0; i < KCH; ++i) {
      int id = tid + 256 * i;
      int row = id / DCH, c = id - row * DCH;
      rk[i] = *(const uint4*)(Kp + (size_t)(ko + row) * ldk + c * 8);
    }
#pragma unroll
    for (int i = 0; i < 2; ++i) {
      int id = tid + 256 * i;
      int d = id >> 3, c = id & 7;
      rv[i] = *(const uint4*)(Vtp + (size_t)d * TL + ko + c * 8);
    }
  };
  auto sstore = [&](int buf) {
#pragma unroll
    for (int i = 0; i < KCH; ++i) {
      int id = tid + 256 * i;
      int row = id / DCH, c = id - row * DCH;
      *(uint4*)(sK + buf * 64 * KROW + row * KROW + c * 8) = rk[i];
    }
#pragma unroll
    for (int i = 0; i < 2; ++i) {
      int id = tid + 256 * i;
      int d = id >> 3, c = id & 7;
      *(uint4*)(sV + buf * 64 * 72 + d * 72 + c * 8) = rv[i];
    }
  };
  f32x4 o[4][NQ];
  float m[NQ], lsum[NQ];
#pragma unroll
  for (int qi = 0; qi < NQ; ++qi) {
    m[qi] = -INFINITY; lsum[qi] = 0.f;
#pragma unroll
    for (int dt = 0; dt < 4; ++dt) o[dt][qi] = (f32x4){0.f, 0.f, 0.f, 0.f};
  }
  gload(0);
  sstore(0);
  __syncthreads();
  const int qc = wave * 16 + l15;
  const int st = min(max(qc - 8, 0), 48);
  for (int t = 0; t < ntiles; ++t) {
    const int cur = t & 1;
    if (t + 1 < ntiles) gload(t + 1);
    const u16* k_s = sK + cur * 64 * KROW;
    const u16* v_s = sV + cur * 64 * 72;
    f32x4 s[4][NQ];
#pragma unroll
    for (int kt = 0; kt < 4; ++kt) {
#pragma unroll
      for (int qi = 0; qi < NQ; ++qi) s[kt][qi] = (f32x4){0.f, 0.f, 0.f, 0.f};
#pragma unroll
      for (int ks = 0; ks < KS; ++ks) {
        bf16x8 kf = *(const bf16x8*)(k_s + (kt * 16 + l15) * KROW + ks * 32 + quad * 8);
#pragma unroll
        for (int qi = 0; qi < NQ; ++qi) s[kt][qi] = __builtin_amdgcn_mfma_f32_16x16x32_bf16(kf, qf[qi][ks], s[kt][qi], 0, 0, 0);
      }
    }
    if (MODE == 1 && t < 8) {
      const int drow = r0 + t - nat_r + 7;
#pragma unroll
      for (int kt = 0; kt < 4; ++kt)
#pragma unroll
        for (int j = 0; j < 4; ++j) {
          int kc = kt * 16 + quad * 4 + j;
          bool valid = (kc >= st) && (kc < st + 16);
          int bi = drow * 31 + (kc - qc + 15);
          bi = valid ? bi : 0;
          float bv = sBias[bi];
          s[kt][0][j] = valid ? (s[kt][0][j] * scale + bv) : -INFINITY;
        }
    } else {
#pragma unroll
      for (int kt = 0; kt < 4; ++kt)
#pragma unroll
        for (int qi = 0; qi < NQ; ++qi)
#pragma unroll
          for (int j = 0; j < 4; ++j) s[kt][qi][j] *= scale;
    }
    bf16x8 pb[NQ][2];
#pragma unroll
    for (int qi = 0; qi < NQ; ++qi) {
      float mx = -INFINITY;
#pragma unroll
      for (int kt = 0; kt < 4; ++kt)
#pragma unroll
        for (int j = 0; j < 4; ++j) mx = fmaxf(mx, s[kt][qi][j]);
      mx = xq_max(mx);
      const float mnew = fmaxf(m[qi], mx);
      const float alpha = __builtin_amdgcn_exp2f((m[qi] - mnew) * L2E);
      m[qi] = mnew;
      float ps = 0.f;
#pragma unroll
      for (int kt = 0; kt < 4; ++kt)
#pragma unroll
        for (int j = 0; j < 4; ++j) {
          float pv = __builtin_amdgcn_exp2f((s[kt][qi][j] - mnew) * L2E);
          s[kt][qi][j] = pv;
          ps += pv;
        }
      lsum[qi] = lsum[qi] * alpha + ps;
#pragma unroll
      for (int dt = 0; dt < 4; ++dt)
#pragma unroll
        for (int j = 0; j < 4; ++j) o[dt][qi][j] *= alpha;
#pragma unroll
      for (int kk = 0; kk < 2; ++kk) {
        bf16x8 b;
#pragma unroll
        for (int j = 0; j < 4; ++j) {
          b[j] = (short)f2bf(s[2 * kk][qi][j]);
          b[4 + j] = (short)f2bf(s[2 * kk + 1][qi][j]);
        }
        pb[qi][kk] = b;
      }
    }
#pragma unroll
    for (int kk = 0; kk < 2; ++kk)
#pragma unroll
      for (int dt = 0; dt < 4; ++dt) {
        uint2 va = *(const uint2*)(v_s + (dt * 16 + l15) * 72 + (2 * kk) * 16 + quad * 4);
        uint2 vb = *(const uint2*)(v_s + (dt * 16 + l15) * 72 + (2 * kk + 1) * 16 + quad * 4);
        uint4 vv = make_uint4(va.x, va.y, vb.x, vb.y);
        bf16x8 av = __builtin_bit_cast(bf16x8, vv);
#pragma unroll
        for (int qi = 0; qi < NQ; ++qi) o[dt][qi] = __builtin_amdgcn_mfma_f32_16x16x32_bf16(av, pb[qi][kk], o[dt][qi], 0, 0, 0);
      }
    if (t + 1 < ntiles) sstore(cur ^ 1);
    __syncthreads();
  }
#pragma unroll
  for (int qi = 0; qi < NQ; ++qi) {
    float l = xq_sum(lsum[qi]);
    const float inv = 1.f / l;
    const int row = wave * 16 * NQ + qi * 16 + l15;
#pragma unroll
    for (int dt = 0; dt < 4; ++dt)
      *(uint2*)(Op + (size_t)row * ldo + dt * 16 + quad * 4) =
          make_uint2(pack2(o[dt][qi][0] * inv, o[dt][qi][1] * inv), pack2(o[dt][qi][2] * inv, o[dt][qi][3] * inv));
  }
}

__device__ void scan_item(const Params& p, int l, int bl, int h, int dir, unsigned char* smem, const int tid) {
  float* R = (float*)smem;
  float* V = R + 2048;
  float* KK = V + 2048;
  float* KD = KK + 2048;
  float* W = KD + 2048;
  float* T1 = W + 2048;
  float* Y = T1 + 2048;
  float* BONW = Y + 2048;
  u16* XW = (u16*)(BONW + 128);
  u16* XA = XW + 32 * 72;
  const int lane = tid & 63, wave = tid >> 6, l15 = lane & 15, quad = lane >> 4;
  const u16* P = (const u16*)(p.ws + OFF_P);
  u16* Yd = (u16*)(p.ws + (dir ? OFF_YB : OFF_YF));
  float* BON = (float*)(p.ws + OFF_BON);
  const u16* Wl = (const u16*)(p.ws + OFF_W) + (size_t)l * W_TOTAL;
  const float* mu = p.in[15] + l * 1920;
  const int nn = wave * 16 + l15;
  const float w0 = p.in[16][(l * 2 + dir) * 512 + h * 64 + nn];
  const float a0 = p.in[18][(l * 2 + dir) * 512 + h * 64 + nn];
  const float ka = p.in[22][l * 512 + h * 64 + nn];
  const float rk = p.in[23][l * 512 + h * 64 + nn];
  bf16x8 wdec[2], waaa[2];
#pragma unroll
  for (int ks = 0; ks < 2; ++ks) {
    wdec[ks] = *(const bf16x8*)(Wl + W_DEC + ((size_t)dir * 512 + h * 64 + nn) * 64 + ks * 32 + quad * 8);
    waaa[ks] = *(const bf16x8*)(Wl + W_AAA + ((size_t)dir * 512 + h * 64 + nn) * 64 + ks * 32 + quad * 8);
  }
  const int st_t = tid >> 3, part = tid & 7, n0 = part * 8;
  const int rl = lane >> 2, sl = lane & 3, srow = wave * 16 + rl;
  v2f S2[8];
#pragma unroll
  for (int i = 0; i < 8; ++i) S2[i] = (v2f){0.f, 0.f};
  float* MU = (float*)(XA + 32 * 72);
  float* KKC = MU + 320;
  for (int i = tid; i < 384; i += 256) {
    int g = i >> 6, n = i & 63;
    float v;
    if (g == 0) v = mu[h * 64 + n];
    else if (g == 1) v = mu[1024 + h * 64 + n];
    else if (g == 2) v = mu[512 + h * 64 + n];
    else if (g == 3) v = mu[1536 + dir * 64 + n];
    else if (g == 4) v = mu[1664 + dir * 64 + n];
    else v = p.in[21][l * 512 + h * 64 + n];
    MU[i] = v;
  }
  uint4 raw[15];
  auto issue_raw = [&](int cidx) {
    const int seg = cidx >= 8;
    const int cc = seg ? cidx - 8 : cidx, nch = seg ? 64 : 8, len = seg ? 2048 : 256;
    const int tb = bl * TL + (seg ? 256 : 0);
    const int c = dir ? (nch - 1 - cc) : cc;
    const int pos = c * 32 + st_t;
    const bool hasp = pos > 0, hasn = pos < len - 1;
    const u16* rowp = P + (size_t)(tb + pos) * NP + n0;
    const int cols[5] = {PC_R + h * 64, PC_V + h * 64, PC_K + h * 64, PC_WLO + dir * 64, PC_ALO + dir * 64};
#pragma unroll
    for (int g = 0; g < 5; ++g) {
      raw[3 * g] = *(const uint4*)(rowp + cols[g]);
      raw[3 * g + 1] = make_uint4(0, 0, 0, 0);
      raw[3 * g + 2] = make_uint4(0, 0, 0, 0);
      if (hasp) raw[3 * g + 1] = *(const uint4*)(rowp + cols[g] - NP);
      if (hasn) raw[3 * g + 2] = *(const uint4*)(rowp + cols[g] + NP);
    }
  };
  issue_raw(0);
  __syncthreads();

  for (int cidx = 0; cidx < 72; ++cidx) {
    {
      const int seg = cidx >= 8;
      const int cc = seg ? cidx - 8 : cidx, nch = seg ? 64 : 8;
      const int tb = bl * TL + (seg ? 256 : 0);
      const int c = dir ? (nch - 1 - cc) : cc;
      const int pos0 = c * 32;
      {
#define SHIFT8(G, z)                                                                              \
  {                                                                                               \
    const uint4 c4 = raw[3 * (G)], p4 = raw[3 * (G) + 1], n4 = raw[3 * (G) + 2];                  \
    const float4 m0 = *(const float4*)(MU + (G)*64 + n0), m1 = *(const float4*)(MU + (G)*64 + n0 + 4); \
    const float mm[8] = {m0.x, m0.y, m0.z, m0.w, m1.x, m1.y, m1.z, m1.w};                          \
    const uint32_t cu[4] = {c4.x, c4.y, c4.z, c4.w}, pu[4] = {p4.x, p4.y, p4.z, p4.w}, nu[4] = {n4.x, n4.y, n4.z, n4.w}; \
    _Pragma("unroll") for (int i = 0; i < 4; ++i) {                                               \
      float c0 = lo2f(cu[i]), c1 = hi2f(cu[i]);                                                   \
      z[2 * i] = c0 + (0.5f * (lo2f(pu[i]) + lo2f(nu[i])) - c0) * mm[2 * i];                      \
      z[2 * i + 1] = c1 + (0.5f * (hi2f(pu[i]) + hi2f(nu[i])) - c1) * mm[2 * i + 1];              \
    }                                                                                             \
  }
        float z[8];
        SHIFT8(0, z);
        *(float4*)(R + st_t * 64 + n0) = make_float4(z[0], z[1], z[2], z[3]);
        *(float4*)(R + st_t * 64 + n0 + 4) = make_float4(z[4], z[5], z[6], z[7]);
        SHIFT8(1, z);
        *(float4*)(V + st_t * 64 + n0) = make_float4(z[0], z[1], z[2], z[3]);
        *(float4*)(V + st_t * 64 + n0 + 4) = make_float4(z[4], z[5], z[6], z[7]);
        SHIFT8(2, z);
        {
          const float4 k0 = *(const float4*)(KKC + n0), k1 = *(const float4*)(KKC + n0 + 4);
          const float kc[8] = {k0.x, k0.y, k0.z, k0.w, k1.x, k1.y, k1.z, k1.w};
          float q[8], ss = 0.f;
#pragma unroll
          for (int i = 0; i < 8; ++i) { q[i] = z[i] * kc[i]; ss += q[i] * q[i]; }
          *(float4*)(KD + st_t * 64 + n0) = make_float4(z[0], z[1], z[2], z[3]);
          *(float4*)(KD + st_t * 64 + n0 + 4) = make_float4(z[4], z[5], z[6], z[7]);
          ss = row8_sum(ss);
          const float inv = 1.f / fmaxf(sqrtf(ss), 1e-12f);
          *(float4*)(KK + st_t * 64 + n0) = make_float4(q[0] * inv, q[1] * inv, q[2] * inv, q[3] * inv);
          *(float4*)(KK + st_t * 64 + n0 + 4) = make_float4(q[4] * inv, q[5] * inv, q[6] * inv, q[7] * inv);
        }
        SHIFT8(3, z);
        {
          float th[8];
#pragma unroll
          for (int i = 0; i < 8; ++i) th[i] = 1.f - 2.f / (1.f + __expf(2.f * z[i]));
          *(uint4*)(XW + st_t * 72 + n0) = make_uint4(pack2(th[0], th[1]), pack2(th[2], th[3]), pack2(th[4], th[5]), pack2(th[6], th[7]));
        }
        SHIFT8(4, z);
        *(uint4*)(XA + st_t * 72 + n0) = make_uint4(pack2(z[0], z[1]), pack2(z[2], z[3]), pack2(z[4], z[5]), pack2(z[6], z[7]));
#undef SHIFT8
      }
      __syncthreads();
#pragma unroll
      for (int mt = 0; mt < 2; ++mt) {
        f32x4 aw = (f32x4){0.f, 0.f, 0.f, 0.f}, aa = (f32x4){0.f, 0.f, 0.f, 0.f};
#pragma unroll
        for (int ks = 0; ks < 2; ++ks) {
          bf16x8 xw = *(const bf16x8*)(XW + (mt * 16 + l15) * 72 + ks * 32 + quad * 8);
          bf16x8 xa = *(const bf16x8*)(XA + (mt * 16 + l15) * 72 + ks * 32 + quad * 8);
          aw = __builtin_amdgcn_mfma_f32_16x16x32_bf16(xw, wdec[ks], aw, 0, 0, 0);
          aa = __builtin_amdgcn_mfma_f32_16x16x32_bf16(xa, waaa[ks], aa, 0, 0, 0);
        }
#pragma unroll
        for (int j = 0; j < 4; ++j) {
          const int t = mt * 16 + quad * 4 + j;
          const float u = -(w0 + aw[j]);
          const float sp = (u > 20.f) ? u : __logf(1.f + __expf(u));
          const float wv = __expf(-__expf(-sp - 0.5f));
          const float av = 1.f / (1.f + __expf(-(a0 + aa[j])));
          W[t * 64 + nn] = wv;
          T1[t * 64 + nn] = KK[t * 64 + nn] * av;
          const float kd = KD[t * 64 + nn] * (1.f + (av - 1.f) * ka);
          KD[t * 64 + nn] = kd;
          const float bon = row16_sum(R[t * 64 + nn] * kd * rk);
          if (l15 == 0) BONW[wave * 32 + t] = bon;
        }
      }
      if (cidx + 1 < 72) issue_raw(cidx + 1);
      __syncthreads();
      {
        float4 nkk[4];
        float nvv;
        {
          const int i_ = dir ? 31 : 0;
#pragma unroll
          for (int q = 0; q < 4; ++q) nkk[q] = *(const float4*)(KK + i_ * 64 + sl * 16 + q * 4);
          nvv = V[i_ * 64 + srow];
        }
        for (int s = 0; s < 32; ++s) {
          const int i = dir ? (31 - s) : s;
          float4 t1[4], kd[4], w[4], r[4], kk[4];
#pragma unroll
          for (int q = 0; q < 4; ++q) {
            t1[q] = *(const float4*)(T1 + i * 64 + sl * 16 + q * 4);
            kd[q] = *(const float4*)(KD + i * 64 + sl * 16 + q * 4);
            w[q] = *(const float4*)(W + i * 64 + sl * 16 + q * 4);
            r[q] = *(const float4*)(R + i * 64 + sl * 16 + q * 4);
            kk[q] = nkk[q];
          }
          const float vv = nvv;
          v2f sa0 = (v2f){0.f, 0.f}, sa1 = (v2f){0.f, 0.f};
#pragma unroll
          for (int q = 0; q < 4; ++q) {
            sa0 += S2[2 * q] * (v2f){kk[q].x, kk[q].y};
            sa1 += S2[2 * q + 1] * (v2f){kk[q].z, kk[q].w};
          }
          if (s + 1 < 32) {
            const int i_ = dir ? (30 - s) : (s + 1);
#pragma unroll
            for (int q = 0; q < 4; ++q) nkk[q] = *(const float4*)(KK + i_ * 64 + sl * 16 + q * 4);
            nvv = V[i_ * 64 + srow];
          }
          sa0 += sa1;
          const float sa = quad_sum(sa0.x + sa0.y);
          const v2f vv2 = (v2f){vv, vv}, nsa = (v2f){-sa, -sa};
          v2f y0 = (v2f){0.f, 0.f}, y1 = (v2f){0.f, 0.f};
#pragma unroll
          for (int q = 0; q < 4; ++q) {
            v2f ta = vv2 * (v2f){kd[q].x, kd[q].y} + nsa * (v2f){t1[q].x, t1[q].y};
            v2f tb = vv2 * (v2f){kd[q].z, kd[q].w} + nsa * (v2f){t1[q].z, t1[q].w};
            S2[2 * q] = S2[2 * q] * (v2f){w[q].x, w[q].y} + ta;
            S2[2 * q + 1] = S2[2 * q + 1] * (v2f){w[q].z, w[q].w} + tb;
            y0 += S2[2 * q] * (v2f){r[q].x, r[q].y};
            y1 += S2[2 * q + 1] * (v2f){r[q].z, r[q].w};
          }
          y0 += y1;
          const float y = quad_sum(y0.x + y0.y);
          if (sl == 0) Y[i * 64 + srow] = y;
        }
      }
      __syncthreads();
      {
        const float* yp = Y + st_t * 64 + n0;
        const size_t tok = (size_t)(tb + pos0 + st_t);
        *(uint4*)(Yd + tok * 512 + h * 64 + n0) =
            make_uint4(pack2(yp[0], yp[1]), pack2(yp[2], yp[3]), pack2(yp[4], yp[5]), pack2(yp[6], yp[7]));
        if (part == 0) BON[tok * 16 + h * 2 + dir] = BONW[st_t] + BONW[32 + st_t] + BONW[64 + st_t] + BONW[96 + st_t];
      }
    }
  }
  __syncthreads();
}

__device__ void phase_mixers(const Params& p, int chunk, int l, bool with_ctx, int* counter, unsigned char* smem) {
  __shared__ int s_item;
  u16* sm = (u16*)smem;
  u16* P = (u16*)(p.ws + OFF_P);
  const u16* KA = (const u16*)(p.ws + OFF_KA);
  const u16* VtA = (const u16*)(p.ws + OFF_VTA);
  const u16* QB = (const u16*)(p.ws + OFF_QB);
  const u16* KB = (const u16*)(p.ws + OFF_KB);
  const u16* VtB = (const u16*)(p.ws + OFF_VTB);
  const u16* VtD = (const u16*)(p.ws + OFF_VTD);
  const float* ropeB = (const float*)(p.ws + OFF_ROPE) + 64 * 16 * 2;
  const int n_scan = BC * 8 * 2;
  const int n_al = BC * 8 * 16;
  const int n_nat = BC * 8 * 32;
  const int n_cx = BC * 8 * 2;
  const int total = n_scan + 2 * n_al + n_nat + (with_ctx ? 3 * n_cx : 0);
  const float scaleB = 0.10206207261596575f;
  while (true) {
    const int tid = otid();
    if (tid == 0) s_item = atomicAdd(counter, 1);
    __syncthreads();
    int it = s_item;
    __syncthreads();
    if (it >= total) break;
    if (it < n_scan) {
      int dir = it & 1, h = (it >> 1) & 7, bl = it >> 4;
      scan_item(p, l, bl, h, dir, smem, otid());
      continue;
    }
    it -= n_scan;
    int kind, h, bl, ntl;
    size_t tok0;
    bool rq = false;
    int qtok0 = 0, natr = 0;
    if (it < 2 * n_al) {
      kind = (it >= n_al) ? 1 : 0;
      int i2 = it - kind * n_al;
      int qt = i2 & 15; h = (i2 >> 4) & 7; bl = i2 >> 7;
      tok0 = (size_t)bl * TL + 256 + qt * 128; ntl = 36; rq = true; qtok0 = qt * 128;
    } else if (it < 2 * n_al + n_nat) {
      int i2 = it - 2 * n_al;
      kind = 3; natr = i2 & 31; h = (i2 >> 5) & 7; bl = i2 >> 8;
      tok0 = (size_t)bl * TL + 256 + natr * 64; ntl = 12;
    } else {
      int i2 = it - 2 * n_al - n_nat;
      kind = i2 / n_cx; i2 -= kind * n_cx;
      int qt = i2 & 1; h = (i2 >> 1) & 7; bl = i2 >> 4;
      tok0 = (size_t)bl * TL + qt * 128; ntl = 4;
    }
    if (kind == 1) {
      flash_item<96, 2, 0>(QB + tok0 * 768 + h * 96, 768, KB + (size_t)(bl * 8 + h) * TL * 96, 96, VtB + (size_t)(bl * 8 + h) * 64 * TL,
                           ntl, P + tok0 * NP + O_B + h * 64, NP, scaleB, rq, qtok0, ropeB, 0, nullptr, sm, otid());
    } else if (kind == 3) {
      u16* q = P + tok0 * NP + PD_Q + h * 64;
      flash_item<64, 1, 1>(q, NP, P + (size_t)bl * TL * NP + PD_K + h * 64, NP, VtD + (size_t)(bl * 8 + h) * 64 * TL, ntl, q, NP, 0.125f,
                           false, 0, ropeB, natr, p.in[26] + (size_t)(l * 8 + h) * 15 * 31, sm, otid());
    } else {
      u16* q = P + tok0 * NP + (kind == 0 ? PA_Q : PD_Q) + h * 64;
      const u16* kp = (kind == 0) ? (KA + (size_t)(bl * 2 + (h >> 2)) * TL * 64) : (P + (size_t)bl * TL * NP + PD_K + h * 64);
      const u16* vp = (kind == 0) ? (VtA + (size_t)(bl * 2 + (h >> 2)) * 64 * TL) : (VtD + (size_t)(bl * 8 + h) * 64 * TL);
      flash_item<64, 2, 0>(q, NP, kp, (kind == 0) ? 64 : NP, vp, ntl, q, NP, 0.125f, false, 0, ropeB, 0, nullptr, sm, otid());
    }
  }
}

__device__ void phase_cout(const Params& p, int l, bool latonly) {
  const int tid = otid();
  const int lane = tid & 63, wave = tid >> 6;
  u16* P = (u16*)(p.ws + OFF_P);
  const u16* YF = (const u16*)(p.ws + OFF_YF);
  const u16* YB = (const u16*)(p.ws + OFF_YB);
  const u16* G = (const u16*)(p.ws + OFF_G);
  const float* BON = (const float*)(p.ws + OFF_BON);
  const float* gnw = p.in[24] + l * 512;
  const float* gnb = p.in[25] + l * 512;
  const float* mu = p.in[15] + l * 1920 + 1024;
  for (int tok = blockIdx.x * 4 + wave; tok < TC; tok += gridDim.x * 4) {
    const int bl = tok / TL, j = tok - bl * TL;
    const bool islat = j >= 256;
    if (latonly && !islat) continue;
    const int jj = j - 256;
    const bool hasp = islat ? (jj > 0) : (j > 0);
    const bool hasn = islat ? (jj < 2047) : (j < 255);
    u16* pr = P + (size_t)tok * NP;
    for (int h = 0; h < 8; ++h) {
      const int col = h * 64 + lane;
      float y = bf2f(YF[(size_t)tok * 512 + col]) + bf2f(YB[(size_t)tok * 512 + col]);
      float mean = wave_sum(y) * (1.f / 64.f);
      float d = y - mean;
      float var = wave_sum(d * d) * (1.f / 64.f);
      float yn = d * rsqrtf(var + 64e-5f) * gnw[col] + gnb[col];
      float vc = bf2f(pr[PC_V + col]);
      float vp = hasp ? bf2f(pr[PC_V + col - NP]) : 0.f;
      float vn = hasn ? bf2f(pr[PC_V + col + NP]) : 0.f;
      float vs = vc + (0.5f * (vp + vn) - vc) * mu[col];
      float bon = BON[(size_t)tok * 16 + h * 2] + BON[(size_t)tok * 16 + h * 2 + 1];
      float oc = (yn + bon * vs) * bf2f(G[(size_t)tok * 512 + col]);
      pr[O_C + col] = f2bf(oc);
    }
  }
}

#ifndef PR_GEMM1
#define PR_GEMM1 0
#endif
#ifndef PR_MERGE
#define PR_MERGE 0
#endif
#ifndef PR_KIND
#define PR_KIND -1
#endif
__device__ void phase_probe(const Params& p, int l, int kind, unsigned char* smem) {
  u16* sm = (u16*)smem;
  u16* P = (u16*)(p.ws + OFF_P);
  u16* DUM = (u16*)(p.ws + OFF_YM);
  const float* ropeB = (const float*)(p.ws + OFF_ROPE) + 64 * 16 * 2;
  const int total = (kind == 0) ? 128 : (kind == 3 ? 2048 : 1024);
  for (int it = blockIdx.x; it < total; it += gridDim.x) {
    if (kind == 0) {
      int dir = it & 1, h = (it >> 1) & 7, bl = it >> 4;
      scan_item(p, l, bl, h, dir, smem, otid());
    } else if (kind == 1) {
      int qt = it & 15, h = (it >> 4) & 7, bl = it >> 7;
      size_t tok0 = (size_t)bl * TL + 256 + qt * 128;
      flash_item<64, 2, 0>(P + tok0 * NP + PA_Q + h * 64, NP, (const u16*)(p.ws + OFF_KA) + (size_t)(bl * 2 + (h >> 2)) * TL * 64, 64,
                           (const u16*)(p.ws + OFF_VTA) + (size_t)(bl * 2 + (h >> 2)) * 64 * TL, 36, DUM + tok0 * 1024 + h * 64, 1024,
                           0.125f, false, 0, ropeB, 0, nullptr, sm, otid());
    } else if (kind == 2) {
      int qt = it & 15, h = (it >> 4) & 7, bl = it >> 7;
      size_t tok0 = (size_t)bl * TL + 256 + qt * 128;
      flash_item<96, 2, 0>((const u16*)(p.ws + OFF_QB) + tok0 * 768 + h * 96, 768, (const u16*)(p.ws + OFF_KB) + (size_t)(bl * 8 + h) * TL * 96,
                           96, (const u16*)(p.ws + OFF_VTB) + (size_t)(bl * 8 + h) * 64 * TL, 36, P + tok0 * NP + O_B + h * 64, NP,
                           0.10206207261596575f, true, qt * 128, ropeB, 0, nullptr, sm, otid());
    } else {
      int r = it & 31, h = (it >> 5) & 7, bl = it >> 8;
      size_t tok0 = (size_t)bl * TL + 256 + r * 64;
      flash_item<64, 1, 1>(P + tok0 * NP + PD_Q + h * 64, NP, P + (size_t)bl * TL * NP + PD_K + h * 64, NP,
                           (const u16*)(p.ws + OFF_VTD) + (size_t)(bl * 8 + h) * 64 * TL, 12, DUM + tok0 * 1024 + h * 64, 1024, 0.125f,
                           false, 0, ropeB, r, p.in[26] + (size_t)(l * 8 + h) * 15 * 31, sm, otid());
    }
  }
}

#define XB_TMO      128
#define XB_XCNT(j)  (256  + 64 * (j))
#define XB_XSUB(j)  (1280 + 64 * (j))
#define XB_XGEN(j)  (2304 + 64 * (j))
#define XB_TOP      3328
#define XB_TOPGEN   3392
#define XCD_BAR_WORDS 3456
#define XB_SPIN_CAP (1u << 18)
#define LAS __attribute__((address_space(3)))
DI unsigned xb_ld(unsigned* p) { return __hip_atomic_load(p, __ATOMIC_RELAXED, __HIP_MEMORY_SCOPE_AGENT); }
DI unsigned xb_add(unsigned* p, unsigned v) { return __hip_atomic_fetch_add(p, v, __ATOMIC_RELAXED, __HIP_MEMORY_SCOPE_AGENT); }
DI unsigned xb_xcc_id() { return (unsigned)__builtin_amdgcn_s_getreg((3 << 11) | 20) & 0xFu; }
#define XB_SPIN(cond, bar) do { unsigned _sp = 0; while (cond) { __builtin_amdgcn_s_sleep(1); \
    if ((++_sp & 255u) == 0u) { if (xb_ld(&(bar)[XB_TMO])) break; if (_sp > XB_SPIN_CAP) { atomicAdd(&(bar)[XB_TMO], 1u); break; } } } } while (0)
struct XcdBarrier { unsigned* bar; unsigned x; volatile LAS unsigned* st; };
DI XcdBarrier xcd_barrier_post(unsigned* bar, volatile LAS unsigned* st) {
  XcdBarrier b; b.bar = bar; b.x = xb_xcc_id(); b.st = st;
  if (threadIdx.x == 0) (void)xb_add(&bar[XB_XCNT(b.x)], 1u);
  return b;
}
DI void xcd_barrier_complete(unsigned* bar, unsigned x, unsigned& nloc, unsigned& nx) {
  const unsigned G = gridDim.x * gridDim.y * gridDim.z;
  unsigned sum, cnt, mine, sp = 0u;
  for (;;) {
    sum = 0u; cnt = 0u; mine = 0u;
#pragma unroll
    for (unsigned j = 0; j < 16; ++j) { const unsigned c = xb_ld(&bar[XB_XCNT(j)]); sum += c; cnt += (c > 0u) ? 1u : 0u; mine = (j == x) ? c : mine; }
    if (sum == G) break;
    __builtin_amdgcn_s_sleep(1);
    if ((++sp & 255u) == 0u) { if (xb_ld(&bar[XB_TMO])) break; if (sp > XB_SPIN_CAP) { atomicAdd(&bar[XB_TMO], 1u); break; } }
  }
  nloc = mine > 0u ? mine : 1u; nx = cnt > 0u ? cnt : 1u;
}
DI void xcd_barrier(const XcdBarrier& b) {
  asm volatile("s_waitcnt vmcnt(0)" ::: "memory");
  __syncthreads();
  if (threadIdx.x == 0) {
    unsigned* bar = b.bar;
    __builtin_amdgcn_s_waitcnt(0);
    unsigned nloc = b.st[0], nx = b.st[1];
    if (nloc == 0u) { xcd_barrier_complete(bar, b.x, nloc, nx); b.st[0] = nloc; b.st[1] = nx; }
    const unsigned old = xb_add(&bar[XB_XSUB(b.x)], 1u);
    const unsigned gen = old / nloc;
    if (old + 1u == (gen + 1u) * nloc) {
      __builtin_amdgcn_fence(__ATOMIC_RELEASE, "agent");
      asm volatile("s_waitcnt vmcnt(0)" ::: "memory");
      const unsigned og = xb_add(&bar[XB_TOP], 1u);
      const unsigned tg = og / nx;
      if (og + 1u == (tg + 1u) * nx) xb_add(&bar[XB_TOPGEN], 1u);
      else XB_SPIN(xb_ld(&bar[XB_TOPGEN]) == tg, bar);
      __builtin_amdgcn_fence(__ATOMIC_ACQUIRE, "agent");
      xb_add(&bar[XB_XGEN(b.x)], 1u);
      asm volatile("s_waitcnt vmcnt(0)" ::: "memory");
    } else {
      XB_SPIN(xb_ld(&bar[XB_XGEN(b.x)]) == gen, bar);
      __builtin_amdgcn_fence(__ATOMIC_ACQUIRE, "agent");
      asm volatile("s_waitcnt vmcnt(0)" ::: "memory");
    }
  }
  __syncthreads();
}

constexpr int SMEM_BYTES = 73728;
__global__ void __launch_bounds__(256, 2) fwd_megakernel(Params p) {
  __shared__ __attribute__((aligned(16))) unsigned char smem[SMEM_BYTES];
  cg::grid_group grid = cg::this_grid();
  u16* sm = (u16*)smem;
  __shared__ __attribute__((aligned(16))) unsigned xb_words[4];
  if (threadIdx.x < 4) xb_words[threadIdx.x] = 0u;
  __syncthreads();
  const XcdBarrier xb = xcd_barrier_post((unsigned*)(p.ws + OFF_BAR), (volatile LAS unsigned*)xb_words);
  phase0(p, smem);
  grid.sync();
  u16* H = (u16*)(p.ws + OFF_H);
  u16* P = (u16*)(p.ws + OFF_P);
  int* ctr = (int*)(p.ws + OFF_CTR);
  for (int chunk = 0; chunk < NCHUNK; ++chunk) {
    for (int l = 0; l < 2; ++l) {
      const bool last = (l == 1);
      const u16* W = (const u16*)(p.ws + OFF_W) + (size_t)l * W_TOTAL;
      const float* mod = (const float*)(p.ws + OFF_MOD) + (size_t)l * 17 * 6144;
      phase_norm(p, chunk, l, 0, false);
      xcd_barrier(xb);
      for (int rep = 0; rep <= PR_GEMM1; ++rep) {
        gemm_phase(H, 1024, W + W_IN, 1024, 39, false, EpiStore{P, NP}, sm);
        xcd_barrier(xb);
      }
      phase_prep(p, l, sm);
      xcd_barrier(xb);
      gemm_phase(P + PB_CQ, NP, W + W_QUP, 384, 6, false, EpiStore{(u16*)(p.ws + OFF_QB), 768}, sm);
      gemm_phase(P + PB_CKV, NP, W + W_KVUP, 256, 8, false, EpiKV{(u16*)(p.ws + OFF_KB), (u16*)(p.ws + OFF_VTB)}, sm);
      gemm_phase((const u16*)(p.ws + OFF_GL), 128, W + W_GATE, 128, 4, false, EpiStore{(u16*)(p.ws + OFF_G), 512}, sm);
      xcd_barrier(xb);
      if (PR_KIND >= 0) {
        phase_probe(p, l, PR_KIND, smem);
        xcd_barrier(xb);
      }
      phase_mixers(p, chunk, l, !last, ctr + chunk * 2 + l, smem);
      xcd_barrier(xb);
      phase_cout(p, l, last);
      xcd_barrier(xb);
      for (int rep = 0; rep <= PR_MERGE; ++rep) {
        phase_merge(p, l, last, sm);
        xcd_barrier(xb);
      }
      gemm_phase((const u16*)(p.ws + OFF_YM), 1024, W + W_OUT, 1024, 8, last, EpiResid{p, chunk, mod, 2048, l == 0}, sm);
      xcd_barrier(xb);
      phase_norm(p, chunk, l, 1, last);
      xcd_barrier(xb);
      gemm_phase(H, 1024, W + W_1, 1024, 32, last, EpiRelu2{P}, sm);
      xcd_barrier(xb);
      gemm_phase(P, 4096, W + W_2, 4096, 8, last, EpiResid{p, chunk, mod, 5120, false}, sm);
      xcd_barrier(xb);
    }
    phase_final(p, chunk);
    xcd_barrier(xb);
  }
}

extern "C" void kernel_launch(void* const* d_in, const int* in_sizes, int n_in, void* d_out, int out_size, void* d_ws,
                              size_t ws_size, hipStream_t stream) {
  static int grid_blocks = 0;
  if (!grid_blocks) {
    int dev = 0, cus = 0, per_cu = 0;
    hipGetDevice(&dev);
    hipDeviceGetAttribute(&cus, hipDeviceAttributeMultiprocessorCount, dev);
    hipOccupancyMaxActiveBlocksPerMultiprocessor(&per_cu, fwd_megakernel, 256, 0);
    if (per_cu > 2) per_cu = 2;
    if (per_cu < 1) per_cu = 1;
    grid_blocks = cus * per_cu;
  }
  if (ws_size < OFF_END) fprintf(stderr, "workspace too small: %zu < %zu\n", ws_size, (size_t)OFF_END);
  Params p{};
  for (int i = 0; i < 32; ++i) p.in[i] = (const float*)d_in[i];
  p.out = (float*)d_out;
  p.ws = (unsigned char*)d_ws;
  hipMemsetAsync(d_ws, 0, 1048576, stream);
  void* args[] = {&p};
  hipError_t e = hipLaunchCooperativeKernel((void*)fwd_megakernel, dim3(grid_blocks), dim3(256), args, 0, stream);
  if (e != hipSuccess) fprintf(stderr, "cooperative launch failed: %s (grid %d)\n", hipGetErrorString(e), grid_blocks);
}
```

```cpp
#include <hip/hip_runtime.h>
#include <hip/hip_cooperative_groups.h>
#include <stdint.h>
#include <cstdio>
namespace cg = cooperative_groups;

typedef unsigned short u16;
typedef __attribute__((ext_vector_type(8))) short bf16x8;
typedef __attribute__((ext_vector_type(4))) float f32x4;
typedef __attribute__((ext_vector_type(2))) float v2f;
#define DI __device__ __forceinline__

constexpr int SMEM_BYTES = 73728;
constexpr int SMEM_DYN = SMEM_BYTES + 64;
constexpr int DM = 1024, TL = 2304;
constexpr int BC = 8, NCHUNK = 2, TC = BC * TL;
constexpr int NP = 4992;
constexpr int PA_Q = 0, PA_K = 512, PA_V = 640, PB_CQ = 768, PB_CKV = 1152, PB_KR = 1408;
constexpr int PC_R = 1440, PC_K = 1952, PC_V = 2464, PC_WLO = 2976, PC_ALO = 3104, PC_GLO = 3232;
constexpr int PD_Q = 3360, PD_K = 3872, PD_V = 4384;
constexpr int O_A = 0, O_B = 768, O_C = 1440, O_D = 3360;

constexpr int W_IN = 0, W_G = 5111808, W_QUP = 9306112, W_KVUP = 9601024, W_GATE = 9863168, W_DEC = 9928704,
              W_AAA = 9994240, W_BR = 10059776, W_OUT = 12156928, W_1 = 13205504, W_2 = 17399808, W_TOTAL = 21594112;

constexpr size_t OFF_MOD = 0;
constexpr size_t OFF_CTR = 835584;
constexpr size_t OFF_BAR = 851968;
constexpr size_t OFF_ROPE = 1048576;
constexpr size_t OFF_W = 2097152;
constexpr size_t OFF_H = OFF_W + (size_t)2 * W_TOTAL * 2;
constexpr size_t OFF_P = OFF_H + (size_t)TC * 1024 * 2;
constexpr size_t OFF_KA = OFF_P + (size_t)TC * NP * 2;
constexpr size_t OFF_VTA = OFF_KA + (size_t)BC * 2 * TL * 64 * 2;
constexpr size_t OFF_QB = OFF_VTA + (size_t)BC * 2 * TL * 64 * 2;
constexpr size_t OFF_KB = OFF_QB + (size_t)TC * 768 * 2;
constexpr size_t OFF_VTB = OFF_KB + (size_t)TC * 768 * 2;
constexpr size_t OFF_VTD = OFF_VTB + (size_t)TC * 512 * 2;
constexpr size_t OFF_GL = OFF_VTD + (size_t)TC * 512 * 2;
constexpr size_t OFF_G = OFF_GL + (size_t)TC * 128 * 2;
constexpr size_t OFF_YF = OFF_G + (size_t)TC * 512 * 2;
constexpr size_t OFF_YB = OFF_YF + (size_t)TC * 512 * 2;
constexpr size_t OFF_BON = OFF_YB + (size_t)TC * 512 * 2;
constexpr size_t OFF_XC = OFF_BON + (size_t)TC * 16 * 4;
constexpr size_t OFF_END = OFF_XC + (size_t)BC * 256 * 1024 * 4;
constexpr size_t OFF_YM = OFF_QB;

struct Params {
  const float* in[32];
  float* out;
  unsigned char* ws;
};

DI u16 f2bf(float f) { uint32_t u = __float_as_uint(f); u += 0x7fffu + ((u >> 16) & 1u); return (u16)(u >> 16); }
DI float bf2f(u16 h) { return __uint_as_float(((uint32_t)h) << 16); }
DI uint32_t pack2(float a, float b) { return (uint32_t)f2bf(a) | ((uint32_t)f2bf(b) << 16); }
DI float lo2f(uint32_t u) { return __uint_as_float(u << 16); }
DI float hi2f(uint32_t u) { return __uint_as_float(u & 0xffff0000u); }
DI float dpp_f(float v, const int ctrl_is_unused) { return v; }
#define DPP_ADD(v, ctrl) ((v) + __int_as_float(__builtin_amdgcn_update_dpp(0, __float_as_int(v), (ctrl), 0xF, 0xF, true)))
DI float row8_sum(float v) {
  v = DPP_ADD(v, 0xB1); v = DPP_ADD(v, 0x4E); v = DPP_ADD(v, 0x141);
  return v;
}
DI float row16_sum(float v) {
  v = DPP_ADD(v, 0xB1); v = DPP_ADD(v, 0x4E); v = DPP_ADD(v, 0x141); v = DPP_ADD(v, 0x140);
  return v;
}
DI float xq_sum(float v) {
  auto r = __builtin_amdgcn_permlane16_swap(__float_as_uint(v), __float_as_uint(v), false, false);
  v = __uint_as_float(r[0]) + __uint_as_float(r[1]);
  auto r2 = __builtin_amdgcn_permlane32_swap(__float_as_uint(v), __float_as_uint(v), false, false);
  return __uint_as_float(r2[0]) + __uint_as_float(r2[1]);
}
DI float xq_max(float v) {
  auto r = __builtin_amdgcn_permlane16_swap(__float_as_uint(v), __float_as_uint(v), false, false);
  v = fmaxf(__uint_as_float(r[0]), __uint_as_float(r[1]));
  auto r2 = __builtin_amdgcn_permlane32_swap(__float_as_uint(v), __float_as_uint(v), false, false);
  return fmaxf(__uint_as_float(r2[0]), __uint_as_float(r2[1]));
}
DI float wave_sum(float v) { return xq_sum(row16_sum(v)); }
DI float quad_sum(float v) {
  v += __int_as_float(__builtin_amdgcn_update_dpp(0, __float_as_int(v), 0xB1, 0xF, 0xF, true));
  v += __int_as_float(__builtin_amdgcn_update_dpp(0, __float_as_int(v), 0x4E, 0xF, 0xF, true));
  return v;
}
DI int otid() { int t = threadIdx.x; asm volatile("" : "+v"(t)); return t; }
DI float sigmoidf_(float x) { return 1.f / (1.f + __expf(-x)); }

DI float* x1_row(const Params& p, int chunk, int row) {
  int bl = row / TL, j = row - bl * TL;
  if (j < 256) return (float*)(p.ws + OFF_XC) + ((size_t)(bl * 256 + j)) * DM;
  return p.out + ((size_t)((chunk * BC + bl) * 2048 + (j - 256))) * DM;
}
DI const float* xin_row(const Params& p, int chunk, int row) {
  int bl = row / TL, j = row - bl * TL;
  int b = chunk * BC + bl;
  if (j < 256) return p.in[2] + ((size_t)(b * 256 + j)) * DM;
  return p.in[0] + ((size_t)(b * 2048 + (j - 256))) * DM;
}
DI int mod_row(int chunk, int row) {
  int bl = row / TL, j = row - bl * TL;
  return (j < 256) ? 16 : (chunk * BC + bl);
}

__constant__ int CONVTAB[16][8] = {
  {8, 1024 * 8992, 0, 1024, 8992, 0, 4896, W_IN},
  {8, 1024 * 8992, 0, 1024, 8992, 4896, 4096, W_G},
  {13, 384 * 768, 0, 384, 768, 0, 768, W_QUP},
  {14, 256 * 1024, 0, 256, 1024, 0, 1024, W_KVUP},
  {20, 128 * 512, 0, 128, 512, 0, 512, W_GATE},
  {17, 2 * 64 * 512, 0, 64, 512, 0, 512, W_DEC},
  {17, 2 * 64 * 512, 64 * 512, 64, 512, 0, 512, W_DEC + 512 * 64},
  {19, 2 * 64 * 512, 0, 64, 512, 0, 512, W_AAA},
  {19, 2 * 64 * 512, 64 * 512, 64, 512, 0, 512, W_AAA + 512 * 64},
  {27, 4 * 512 * 1024, 0, 512, 1024, 0, 1024, W_BR},
  {27, 4 * 512 * 1024, 512 * 1024, 512, 1024, 0, 1024, W_BR + 1024 * 512},
  {27, 4 * 512 * 1024, 2 * 512 * 1024, 512, 1024, 0, 1024, W_BR + 2 * 1024 * 512},
  {27, 4 * 512 * 1024, 3 * 512 * 1024, 512, 1024, 0, 1024, W_BR + 3 * 1024 * 512},
  {28, 1024 * 1024, 0, 1024, 1024, 0, 1024, W_OUT},
  {29, 1024 * 4096, 0, 1024, 4096, 0, 4096, W_1},
  {30, 4096 * 1024, 0, 4096, 1024, 0, 1024, W_2},
};
constexpr int CONV_TILES_PER_LAYER = 1232 + 1024 + 72 + 64 + 16 + 8 + 8 + 8 + 8 + 128 * 4 + 256 + 1024 + 1024;

__device__ void conv_tile(const float* __restrict__ src, int ld, int k0, int n0, int ncols, u16* __restrict__ dst, int K,
                          float* tile, const int tid) {
  {
    const int c4 = (tid & 15) * 4;
#pragma unroll
    for (int i = 0; i < 4; ++i) {
      int r = (tid >> 4) + 16 * i;
      float4 v = make_float4(0.f, 0.f, 0.f, 0.f);
      if (n0 + c4 < ncols) v = *(const float4*)(src + (size_t)(k0 + r) * ld + n0 + c4);
      tile[r * 65 + c4 + 0] = v.x; tile[r * 65 + c4 + 1] = v.y; tile[r * 65 + c4 + 2] = v.z; tile[r * 65 + c4 + 3] = v.w;
    }
  }
  __syncthreads();
  {
    const int n = tid >> 2, kc = (tid & 3) * 16;
    if (n0 + n < ncols) {
      uint32_t w[8];
#pragma unroll
      for (int i = 0; i < 8; ++i) w[i] = pack2(tile[(kc + 2 * i) * 65 + n], tile[(kc + 2 * i + 1) * 65 + n]);
      uint4* d = (uint4*)(dst + (size_t)(n0 + n) * K + k0 + kc);
      d[0] = make_uint4(w[0], w[1], w[2], w[3]);
      d[1] = make_uint4(w[4], w[5], w[6], w[7]);
    }
  }
  __syncthreads();
}

__device__ void phase0(const Params& p, unsigned char* smem) {
  float* fsm = (float*)smem;
  const int tid = otid();
  const int n_conv = 2 * CONV_TILES_PER_LAYER;
  const int n_pad = 2 * 48;
  const int n_ada = 2 * 16 * 24;
  const int total = n_conv + n_pad + n_ada + 1;
  u16* wbase = (u16*)(p.ws + OFF_W);
  for (int it = blockIdx.x; it < total; it += gridDim.x) {
    if (it < n_conv) {
      int l = it / CONV_TILES_PER_LAYER, r = it - l * CONV_TILES_PER_LAYER;
      int job = 0;
      for (; job < 16; ++job) {
        int nt = (CONVTAB[job][3] >> 6) * ((CONVTAB[job][6] + 63) >> 6);
        if (r < nt) break;
        r -= nt;
      }
      const int K = CONVTAB[job][3], ld = CONVTAB[job][4], col0 = CONVTAB[job][5], ncols = CONVTAB[job][6];
      const int nkt = K >> 6;
      const int kt = r % nkt, ntile = r / nkt;
      const float* src = p.in[CONVTAB[job][0]] + (size_t)l * CONVTAB[job][1] + CONVTAB[job][2] + col0;
      u16* dst = wbase + (size_t)l * W_TOTAL + CONVTAB[job][7];
      conv_tile(src, ld, kt * 64, ntile * 64, ncols, dst, K, fsm, tid);
    } else if (it < n_conv + n_pad) {
      int r = it - n_conv;
      int l = r / 48, q = r - l * 48;
      u16* dst = wbase + (size_t)l * W_TOTAL + W_IN + (size_t)(4896 + q * 2) * 1024;
      *(uint4*)(dst + tid * 8) = make_uint4(0, 0, 0, 0);
    } else if (it < n_conv + n_pad + n_ada) {
      int r = it - n_conv - n_pad;
      int l = r / 384; r -= l * 384;
      int kc = r / 24, nb = r - kc * 24;
      for (int idx = tid; idx < 17 * 64; idx += 256) {
        int rr = idx >> 6, k = idx & 63;
        float cv = (rr < 16) ? p.in[1][rr * 1024 + kc * 64 + k] : p.in[3][kc * 64 + k];
        fsm[idx] = cv / (1.f + expf(-cv));
      }
      __syncthreads();
      const int n = nb * 256 + tid;
      float acc[17];
#pragma unroll
      for (int i = 0; i < 17; ++i) acc[i] = 0.f;
      const float* wp = p.in[4] + ((size_t)l * 1024 + kc * 64) * 6144 + n;
#pragma unroll 4
      for (int k = 0; k < 64; ++k) {
        float w = wp[(size_t)k * 6144];
#pragma unroll
        for (int i = 0; i < 17; ++i) acc[i] += fsm[i * 64 + k] * w;
      }
      float bias = (kc == 0) ? p.in[5][l * 6144 + n] : 0.f;
      float* mod = (float*)(p.ws + OFF_MOD);
#pragma unroll
      for (int i = 0; i < 17; ++i) atomicAdd(&mod[(size_t)(l * 17 + i) * 6144 + n], acc[i] + bias);
      __syncthreads();
    } else {
      float* ra = (float*)(p.ws + OFF_ROPE);
      float* rb = ra + 64 * 16 * 2;
      for (int idx = tid; idx < 64 * 16; idx += 256) {
        int pos = idx >> 4, i = idx & 15;
        float inv = powf(10000.f, -(float)i / 16.f);
        float ang = (float)pos * inv;
        ra[idx * 2] = cosf(ang); ra[idx * 2 + 1] = sinf(ang);
      }
      for (int idx = tid; idx < 64 * 8; idx += 256) {
        int pos = idx >> 3, i = idx & 7;
        float inv = powf(10000.f, -(float)i / 8.f);
        float ang = (float)pos * inv;
        rb[idx * 2] = cosf(ang); rb[idx * 2 + 1] = sinf(ang);
      }
    }
  }
}

__device__ void phase_norm(const Params& p, int chunk, int l, int which, bool latonly) {
  const int tid = otid();
  const int lane = tid & 63, wave = tid >> 6;
  const float* g = p.in[which == 0 ? 6 : 7] + l * 1024;
  const float* mod = (const float*)(p.ws + OFF_MOD) + (size_t)l * 17 * 6144;
  u16* H = (u16*)(p.ws + OFF_H);
  for (int row = blockIdx.x * 4 + wave; row < TC; row += gridDim.x * 4) {
    int j = row % TL;
    if (latonly && j < 256) continue;
    const float* src = (which == 0 && l == 0) ? xin_row(p, chunk, row) : (const float*)x1_row(p, chunk, row);
    const float* mr = mod + (size_t)mod_row(chunk, row) * 6144 + which * 3072;
    float4 v[4];
    float ss = 0.f;
#pragma unroll
    for (int i = 0; i < 4; ++i) {
      v[i] = *(const float4*)(src + i * 256 + lane * 4);
      ss += v[i].x * v[i].x + v[i].y * v[i].y + v[i].z * v[i].z + v[i].w * v[i].w;
    }
    ss = wave_sum(ss);
    float rs = rsqrtf(ss * (1.f / 1024.f) + 1e-6f);
#pragma unroll
    for (int i = 0; i < 4; ++i) {
      int c = i * 256 + lane * 4;
      float4 gg = *(const float4*)(g + c);
      float4 sh = *(const float4*)(mr + c);
      float4 sc = *(const float4*)(mr + 1024 + c);
      float a0 = v[i].x * rs * gg.x * (1.f + sc.x) + sh.x;
      float a1 = v[i].y * rs * gg.y * (1.f + sc.y) + sh.y;
      float a2 = v[i].z * rs * gg.z * (1.f + sc.z) + sh.z;
      float a3 = v[i].w * rs * gg.w * (1.f + sc.w) + sh.w;
      *(uint2*)(H + (size_t)row * 1024 + c) = make_uint2(pack2(a0, a1), pack2(a2, a3));
    }
  }
}

__device__ void phase_final(const Params& p, int chunk) {
  const int tid = otid();
  const int lane = tid & 63, wave = tid >> 6;
  const float* g = p.in[31];
  for (int r = blockIdx.x * 4 + wave; r < BC * 2048; r += gridDim.x * 4) {
    float* px = p.out + ((size_t)chunk * BC * 2048 + r) * DM;
    float4 v[4];
    float ss = 0.f;
#pragma unroll
    for (int i = 0; i < 4; ++i) {
      v[i] = *(const float4*)(px + i * 256 + lane * 4);
      ss += v[i].x * v[i].x + v[i].y * v[i].y + v[i].z * v[i].z + v[i].w * v[i].w;
    }
    ss = wave_sum(ss);
    float rs = rsqrtf(ss * (1.f / 1024.f) + 1e-6f);
#pragma unroll
    for (int i = 0; i < 4; ++i) {
      int c = i * 256 + lane * 4;
      float4 gg = *(const float4*)(g + c);
      *(float4*)(px + c) = make_float4(v[i].x * rs * gg.x, v[i].y * rs * gg.y, v[i].z * rs * gg.z, v[i].w * rs * gg.w);
    }
  }
}

#define GEMM_WAIT_VM(n) asm volatile("s_waitcnt vmcnt(" #n ")" ::: "memory")
DI void raw_barrier() { asm volatile("s_waitcnt lgkmcnt(0)" ::: "memory"); __builtin_amdgcn_s_barrier(); }
template <int MI, int NI, bool TR>
DI void gemm_dma(const u16* __restrict__ A, int lda, const u16* __restrict__ Bt, int ldb, int K, f32x4 (&acc)[MI][NI],
                 unsigned char* smem, const int tid) {
  constexpr int BM = 32 * MI, BN = 32 * NI;
  constexpr int SB = (BM + BN) * 64;
  constexpr int NS = (73728 / SB) >= 4 ? 4 : 3;
  constexpr int LA = BM / 64, LB = BN / 64, LPT = LA + LB;
  static_assert(LPT == 3 || LPT == 4 || LPT == 6, "unexpected tile");
  const int lane = tid & 63, wave = tid >> 6, l15 = lane & 15, quad = lane >> 4;
  const int wm = wave >> 1, wn = wave & 1;
  const int drow = tid >> 2;
  const int g4 = (0x1230 >> (((drow >> 2) & 3) * 4)) & 3;
  const int dc = (tid & 3) ^ g4;
  const u16* Asrc = A + (size_t)drow * lda + dc * 8;
  const u16* Bsrc = Bt + (size_t)drow * ldb + dc * 8;
  unsigned char* dstw = smem + (tid & ~63) * 16;
  auto issue = [&](int kt, int buf) {
    const int ko = kt * 32;
#pragma unroll
    for (int j = 0; j < LA; ++j)
      __builtin_amdgcn_global_load_lds((const unsigned*)(Asrc + (size_t)(j * 64) * lda + ko), (unsigned*)(dstw + buf * SB + j * 4096), 16, 0, 0);
#pragma unroll
    for (int j = 0; j < LB; ++j)
      __builtin_amdgcn_global_load_lds((const unsigned*)(Bsrc + (size_t)(j * 64) * ldb + ko), (unsigned*)(dstw + buf * SB + (LA + j) * 4096), 16, 0, 0);
  };
  const int rg4 = (0x1230 >> ((l15 >> 2) * 4)) & 3;
  const int aoff = (wm * 16 * MI + l15) * 64 + ((quad ^ rg4) * 16);
  const int boff = BM * 64 + (wn * 16 * NI + l15) * 64 + ((quad ^ rg4) * 16);
  const int nk = K >> 5;
  GEMM_WAIT_VM(0);
#pragma unroll
  for (int s_ = 0; s_ < NS - 1; ++s_)
    if (s_ < nk) issue(s_, s_);
  int buf = 0;
  for (int kt = 0; kt < nk; ++kt) {
    const int rem = nk - 1 - kt;
    if (NS == 4) {
      if (rem >= 2) { if (LPT == 3) GEMM_WAIT_VM(6); else if (LPT == 4) GEMM_WAIT_VM(8); else GEMM_WAIT_VM(12); }
      else if (rem == 1) { if (LPT == 3) GEMM_WAIT_VM(3); else if (LPT == 4) GEMM_WAIT_VM(4); else GEMM_WAIT_VM(6); }
      else GEMM_WAIT_VM(0);
    } else {
      if (rem >= 1) { if (LPT == 3) GEMM_WAIT_VM(3); else if (LPT == 4) GEMM_WAIT_VM(4); else GEMM_WAIT_VM(6); }
      else GEMM_WAIT_VM(0);
    }
    raw_barrier();
    if (kt + NS - 1 < nk) { int nb = buf + NS - 1; if (nb >= NS) nb -= NS; issue(kt + NS - 1, nb); }
    const unsigned char* st = smem + buf * SB;
    bf16x8 af[MI], bfr[NI];
#pragma unroll
    for (int mi = 0; mi < MI; ++mi) af[mi] = *(const bf16x8*)(st + aoff + mi * 1024);
#pragma unroll
    for (int ni = 0; ni < NI; ++ni) bfr[ni] = *(const bf16x8*)(st + boff + ni * 1024);
#pragma unroll
    for (int mi = 0; mi < MI; ++mi)
#pragma unroll
      for (int ni = 0; ni < NI; ++ni)
        acc[mi][ni] = TR ? __builtin_amdgcn_mfma_f32_16x16x32_bf16(bfr[ni], af[mi], acc[mi][ni], 0, 0, 0)
                         : __builtin_amdgcn_mfma_f32_16x16x32_bf16(af[mi], bfr[ni], acc[mi][ni], 0, 0, 0);
    if (++buf == NS) buf = 0;
  }
  raw_barrier();
}

DI bool tile_map(int t, int nMg, int nNt, bool latonly, int MT, int& mt, int& nt) {
  int x = t & 7, rest = t >> 3;
  int ni = rest & 7, q = rest >> 3;
  int mg = q % nMg, ng = q / nMg;
  nt = ng * 8 + ni;
  if (nt >= nNt) return false;
  int mti = mg * 8 + x;
  if (MT == 128) mt = latonly ? ((mti >> 4) * 18 + 2 + (mti & 15)) : mti;
  else mt = latonly ? ((mti >> 3) * 9 + 1 + (mti & 7)) : mti;
  return true;
}

template <int MI, int NI, bool TR, class Epi>
__device__ void gemm_phase(const u16* A, int lda, const u16* Bt, int K, int N, bool latonly, Epi epi, unsigned char* smem) {
  constexpr int BM = 32 * MI, BN = 32 * NI;
  const int nMg = (BM == 128) ? (latonly ? 16 : 18) : (latonly ? 8 : 9);
  const int nNt = N / BN;
  const int total = 64 * nMg * ((nNt + 7) >> 3);
  const int tid = otid();
  const int lane = tid & 63, wave = tid >> 6, l15 = lane & 15, quad = lane >> 4;
  const int wm = wave >> 1, wn = wave & 1;
  for (int t = blockIdx.x; t < total; t += gridDim.x) {
    int mt, nt;
    if (!tile_map(t, nMg, nNt, latonly, BM, mt, nt)) continue;
    const int m0 = mt * BM, n0 = nt * BN;
    f32x4 acc[MI][NI];
#pragma unroll
    for (int mi = 0; mi < MI; ++mi)
#pragma unroll
      for (int ni = 0; ni < NI; ++ni) acc[mi][ni] = (f32x4){0.f, 0.f, 0.f, 0.f};
    gemm_dma<MI, NI, TR>(A + (size_t)m0 * lda, lda, Bt + (size_t)n0 * K, K, K, acc, smem, tid);
#pragma unroll
    for (int mi = 0; mi < MI; ++mi)
#pragma unroll
      for (int ni = 0; ni < NI; ++ni) {
        if (TR) epi(m0 + wm * 16 * MI + mi * 16 + l15, n0 + wn * 16 * NI + ni * 16 + quad * 4, acc[mi][ni]);
        else epi(m0 + wm * 16 * MI + mi * 16 + quad * 4, n0 + wn * 16 * NI + ni * 16 + l15, acc[mi][ni]);
      }
  }
}

struct EpiStore {
  u16* C; int ldc;
  DI void operator()(int r, int c0, f32x4 v) const {
    *(uint2*)(C + (size_t)r * ldc + c0) = make_uint2(pack2(v[0], v[1]), pack2(v[2], v[3]));
  }
};
struct EpiKV {
  u16* KB; u16* VtB;
  DI void operator()(int r0, int c, f32x4 v) const {
    int bl = r0 / TL, j0 = r0 - bl * TL;
    int head = c >> 7, w = c & 127;
    if (w < 64) {
#pragma unroll
      for (int j = 0; j < 4; ++j) KB[((size_t)(bl * 8 + head) * TL + j0 + j) * 96 + w] = f2bf(v[j]);
    } else {
      *(uint2*)(VtB + ((size_t)(bl * 8 + head) * 64 + (w - 64)) * TL + j0) = make_uint2(pack2(v[0], v[1]), pack2(v[2], v[3]));
    }
  }
};
struct EpiRelu2 {
  u16* C;
  DI void operator()(int r, int c0, f32x4 v) const {
    float t0 = fmaxf(v[0], 0.f), t1 = fmaxf(v[1], 0.f), t2 = fmaxf(v[2], 0.f), t3 = fmaxf(v[3], 0.f);
    *(uint2*)(C + (size_t)r * 4096 + c0) = make_uint2(pack2(t0 * t0, t1 * t1), pack2(t2 * t2, t3 * t3));
  }
};
struct EpiResid {
  Params p; int chunk; const float* mod; int gofs; bool from_input;
  DI void operator()(int r, int c0, f32x4 v) const {
    const float4 gt = *(const float4*)(mod + (size_t)mod_row(chunk, r) * 6144 + gofs + c0);
    float* dst = x1_row(p, chunk, r) + c0;
    const float4 xin = from_input ? *(const float4*)(xin_row(p, chunk, r) + c0) : *(const float4*)dst;
    *(float4*)dst = make_float4(xin.x + gt.x * v[0], xin.y + gt.y * v[1], xin.z + gt.z * v[2], xin.w + gt.w * v[3]);
  }
};

__device__ void phase_merge(const Params& p, int l, bool latonly, unsigned char* smem) {
  const u16* H = (const u16*)(p.ws + OFF_H);
  const u16* P = (const u16*)(p.ws + OFF_P);
  const u16* W = (const u16*)(p.ws + OFF_W) + (size_t)l * W_TOTAL;
  u16* YM = (u16*)(p.ws + OFF_YM);
  const int nMg = latonly ? 16 : 18;
  const int nNt = 16;
  const int total = 64 * nMg * 2;
  const int tid = otid();
  const int lane = tid & 63, wave = tid >> 6, l15 = lane & 15, quad = lane >> 4;
  const int wm = wave >> 1, wn = wave & 1;
  for (int t = blockIdx.x; t < total; t += gridDim.x) {
    int mt, nt;
    if (!tile_map(t, nMg, nNt, latonly, 128, mt, nt)) continue;
    const int m0 = mt * 128, n0 = nt * 64;
    f32x4 y[4][2];
#pragma unroll
    for (int mi = 0; mi < 4; ++mi)
#pragma unroll
      for (int ni = 0; ni < 2; ++ni) y[mi][ni] = (f32x4){0.f, 0.f, 0.f, 0.f};
    for (int i = 0; i < 4; ++i) {
      const int ocol = (i == 0) ? O_A : (i == 1) ? O_B : (i == 2) ? O_C : O_D;
      f32x4 g[4][2], b[4][2];
#pragma unroll
      for (int mi = 0; mi < 4; ++mi)
#pragma unroll
        for (int ni = 0; ni < 2; ++ni) { g[mi][ni] = (f32x4){0.f, 0.f, 0.f, 0.f}; b[mi][ni] = (f32x4){0.f, 0.f, 0.f, 0.f}; }
      gemm_dma<4, 2, true>(H + (size_t)m0 * 1024, 1024, W + W_G + (size_t)(i * 1024 + n0) * 1024, 1024, 1024, g, smem, tid);
      gemm_dma<4, 2, true>(P + (size_t)m0 * NP + ocol, NP, W + W_BR + (size_t)(i * 1024 + n0) * 512, 512, 512, b, smem, tid);
#pragma unroll
      for (int mi = 0; mi < 4; ++mi)
#pragma unroll
        for (int ni = 0; ni < 2; ++ni)
#pragma unroll
          for (int j = 0; j < 4; ++j) y[mi][ni][j] += sigmoidf_(g[mi][ni][j]) * b[mi][ni][j];
    }
#pragma unroll
    for (int mi = 0; mi < 4; ++mi)
#pragma unroll
      for (int ni = 0; ni < 2; ++ni)
        *(uint2*)(YM + (size_t)(m0 + wm * 64 + mi * 16 + l15) * 1024 + n0 + wn * 32 + ni * 16 + quad * 4) =
            make_uint2(pack2(y[mi][ni][0], y[mi][ni][1]), pack2(y[mi][ni][2], y[mi][ni][3]));
  }
}

__device__ void transpose64(const u16* __restrict__ src, int lds_, u16* __restrict__ dst, int ldd, u16* tile, const int tid) {
  {
    const int r = tid >> 2, c = (tid & 3) * 16;
    uint4 a = *(const uint4*)(src + (size_t)r * lds_ + c);
    uint4 b = *(const uint4*)(src + (size_t)r * lds_ + c + 8);
    uint32_t* t32 = (uint32_t*)(tile + r * 66 + c);
    t32[0] = a.x; t32[1] = a.y; t32[2] = a.z; t32[3] = a.w; t32[4] = b.x; t32[5] = b.y; t32[6] = b.z; t32[7] = b.w;
  }
  __syncthreads();
  {
    const int d = tid >> 2, tc = (tid & 3) * 16;
    uint32_t w[8];
#pragma unroll
    for (int i = 0; i < 8; ++i) w[i] = (uint32_t)tile[(tc + 2 * i) * 66 + d] | ((uint32_t)tile[(tc + 2 * i + 1) * 66 + d] << 16);
    uint4* o = (uint4*)(dst + (size_t)d * ldd + tc);
    o[0] = make_uint4(w[0], w[1], w[2], w[3]);
    o[1] = make_uint4(w[4], w[5], w[6], w[7]);
  }
  __syncthreads();
}

__device__ void phase_prep(const Params& p, int l, u16* sm) {
  const int tid = otid();
  const int lane = tid & 63, wave = tid >> 6;
  u16* P = (u16*)(p.ws + OFF_P);
  u16* KA = (u16*)(p.ws + OFF_KA);
  u16* VtA = (u16*)(p.ws + OFF_VTA);
  u16* KB = (u16*)(p.ws + OFF_KB);
  u16* VtD = (u16*)(p.ws + OFF_VTD);
  u16* GL = (u16*)(p.ws + OFF_GL);
  const float* ropeA = (const float*)(p.ws + OFF_ROPE);
  const float* ropeB = ropeA + 64 * 16 * 2;
  const float aqg = p.in[9][l * 64 + lane], akg = p.in[10][l * 64 + lane];
  const float* bqg = p.in[11] + l * 384;
  const float* bkvg = p.in[12] + l * 256;
  const float* mu = p.in[15] + l * 1920;
  for (int tok = blockIdx.x * 4 + wave; tok < TC; tok += gridDim.x * 4) {
    const int bl = tok / TL, j = tok - bl * TL;
    const bool islat = j >= 256;
    const int jj = j - 256;
    const int grow = (jj >> 6) & 31, gcol = jj & 63;
    u16* pr = P + (size_t)tok * NP;
    float ca = 1.f, sa = 0.f;
    if (islat) {
      int pos = (lane < 32) ? grow : gcol;
      ca = ropeA[(pos * 16 + (lane & 15)) * 2];
      sa = ropeA[(pos * 16 + (lane & 15)) * 2 + 1];
    }
    for (int h = 0; h < 10; ++h) {
      float x = bf2f(pr[h * 64 + lane]);
      float ss = wave_sum(x * x);
      float y = x * rsqrtf(ss * (1.f / 64.f) + 1e-6f) * (h < 8 ? aqg : akg);
      float yp = __shfl_xor(y, 16);
      float o = ((lane & 16) == 0) ? (y * ca - yp * sa) : (yp * sa + y * ca);
      if (h < 8) pr[h * 64 + lane] = f2bf(o);
      else KA[((size_t)(bl * 2 + (h - 8)) * TL + j) * 64 + lane] = f2bf(o);
    }
    {
      float x[6], ss = 0.f;
#pragma unroll
      for (int i = 0; i < 6; ++i) { x[i] = bf2f(pr[PB_CQ + lane + 64 * i]); ss += x[i] * x[i]; }
      ss = wave_sum(ss);
      float rs = rsqrtf(ss * (1.f / 384.f) + 1e-6f);
#pragma unroll
      for (int i = 0; i < 6; ++i) pr[PB_CQ + lane + 64 * i] = f2bf(x[i] * rs * bqg[lane + 64 * i]);
    }
    {
      float x[4], ss = 0.f;
#pragma unroll
      for (int i = 0; i < 4; ++i) { x[i] = bf2f(pr[PB_CKV + lane + 64 * i]); ss += x[i] * x[i]; }
      ss = wave_sum(ss);
      float rs = rsqrtf(ss * (1.f / 256.f) + 1e-6f);
#pragma unroll
      for (int i = 0; i < 4; ++i) pr[PB_CKV + lane + 64 * i] = f2bf(x[i] * rs * bkvg[lane + 64 * i]);
    }
    {
      float x = bf2f(pr[PB_KR + (lane & 31)]);
      float xp = __shfl_xor(x, 8);
      float o = x;
      if (islat) {
        int pos = ((lane & 31) < 16) ? grow : gcol;
        float c = ropeB[(pos * 8 + (lane & 7)) * 2], s = ropeB[(pos * 8 + (lane & 7)) * 2 + 1];
        o = ((lane & 8) == 0) ? (x * c - xp * s) : (xp * s + x * c);
      }
      if (lane < 32) {
        u16 ob = f2bf(o);
#pragma unroll
        for (int h = 0; h < 8; ++h) KB[((size_t)(bl * 8 + h) * TL + j) * 96 + 64 + lane] = ob;
      }
    }
    {
      const bool hasp = islat ? (jj > 0) : (j > 0);
      const bool hasn = islat ? (jj < 2047) : (j < 255);
#pragma unroll
      for (int i = 0; i < 2; ++i) {
        int c = lane + 64 * i;
        float cur = bf2f(pr[PC_GLO + c]);
        float pv = hasp ? bf2f(pr[PC_GLO + c - NP]) : 0.f;
        float nv = hasn ? bf2f(pr[PC_GLO + c + NP]) : 0.f;
        float z = cur + (0.5f * (pv + nv) - cur) * mu[1792 + c];
        GL[(size_t)tok * 128 + c] = f2bf(sigmoidf_(z));
      }
    }
  }
  for (int it = blockIdx.x; it < (TC / 64) * 10; it += gridDim.x) {
    int tg = it / 10, hh = it - tg * 10;
    int tok0 = tg * 64, bl = tok0 / TL, j0 = tok0 - bl * TL;
    if (hh < 2) transpose64(P + (size_t)tok0 * NP + PA_V + hh * 64, NP, VtA + ((size_t)(bl * 2 + hh) * 64) * TL + j0, TL, sm, tid);
    else transpose64(P + (size_t)tok0 * NP + PD_V + (hh - 2) * 64, NP, VtD + ((size_t)(bl * 8 + hh - 2) * 64) * TL + j0, TL, sm, tid);
  }
}

template <int DQK, int NQ, int MODE>
__device__ void flash_item(const u16* __restrict__ Qp, int ldq, const u16* __restrict__ Kp, int ldk, const u16* __restrict__ Vtp,
                           int ntiles, u16* __restrict__ Op, int ldo, float scale, bool ropeq, int qtok0,
                           const float* __restrict__ ropeB, int nat_r, const float* __restrict__ bias_g, u16* sm, const int tid) {
  constexpr int KS = DQK / 32;
  constexpr int KROW = DQK + 8;
  constexpr int KCH = (64 * DQK / 8) / 256;
  constexpr int DCH = DQK / 8;
  u16* sK = sm;
  u16* sV = sm + 2 * 64 * KROW;
  float* sBias = (float*)(sm + 2 * 64 * KROW + 2 * 64 * 72);
  const int lane = tid & 63, wave = tid >> 6, l15 = lane & 15, quad = lane >> 4;
  const float L2E = 1.4426950408889634f;
  int r0 = 0;
  if (MODE == 1) {
    r0 = min(max(nat_r - 4, 0), 24);
    for (int i = tid; i < 15 * 31; i += 256) sBias[i] = bias_g[i];
  }
  bf16x8 qf[NQ][KS];
#pragma unroll
  for (int qi = 0; qi < NQ; ++qi) {
    const int row = wave * 16 * NQ + qi * 16 + l15;
#pragma unroll
    for (int ks = 0; ks < KS; ++ks) qf[qi][ks] = *(const bf16x8*)(Qp + (size_t)row * ldq + ks * 32 + quad * 8);
    if (DQK == 96 && ropeq) {
      bf16x8 own = qf[qi][KS - 1];
      bf16x8 par = *(const bf16x8*)(Qp + (size_t)row * ldq + 64 + (quad ^ 1) * 8);
      const int qt = qtok0 + row;
      const int pos = (quad < 2) ? ((qt >> 6) & 31) : (qt & 63);
      bf16x8 res;
#pragma unroll
      for (int i = 0; i < 8; ++i) {
        float c = ropeB[(pos * 8 + i) * 2], s = ropeB[(pos * 8 + i) * 2 + 1];
        float xo = bf2f((u16)own[i]), xp = bf2f((u16)par[i]);
        float o = ((quad & 1) == 0) ? (xo * c - xp * s) : (xp * s + xo * c);
        res[i] = (short)f2bf(o);
      }
      qf[qi][KS - 1] = res;
    }
  }
  auto koff = [&](int t) -> int { return (MODE == 1) ? ((t < 8) ? (256 + (r0 + t) * 64) : ((t - 8) * 64)) : t * 64; };
  uint4 rk[KCH], rv[2];
  auto gload = [&](int t) {
    const int ko = koff(t);
#pragma unroll
    for (int i = 0; i < KCH; ++i) {
      int id = tid + 256 * i;
      int row = id / DCH, c = id - row * DCH;
      rk[i] = *(const uint4*)(Kp + (size_t)(ko + row) * ldk + c * 8);
    }
#pragma unroll
    for (int i = 0; i < 2; ++i) {
      int id = tid + 256 * i;
      int d = id >> 3, c = id & 7;
      rv[i] = *(const uint4*)(Vtp + (size_t)d * TL + ko + c * 8);
    }
  };
  auto sstore = [&](int buf) {
#pragma unroll
    for (int i = 0; i < KCH; ++i) {
      int id = tid + 256 * i;
      int row = id / DCH, c = id - row * DCH;
      *(uint4*)(sK + buf * 64 * KROW + row * KROW + c * 8) = rk[i];
    }
#pragma unroll
    for (int i = 0; i < 2; ++i) {
      int id = tid + 256 * i;
      int d = id >> 3, c = id & 7;
      *(uint4*)(sV + buf * 64 * 72 + d * 72 + c * 8) = rv[i];
    }
  };
  f32x4 o[4][NQ];
  float m[NQ], lsum[NQ];
#pragma unroll
  for (int qi = 0; qi < NQ; ++qi) {
    m[qi] = -INFINITY; lsum[qi] = 0.f;
#pragma unroll
    for (int dt = 0; dt < 4; ++dt) o[dt][qi] = (f32x4){0.f, 0.f, 0.f, 0.f};
  }
  gload(0);
  sstore(0);
  __syncthreads();
  const int qc = wave * 16 + l15;
  const int st = min(max(qc - 8, 0), 48);
  for (int t = 0; t < ntiles; ++t) {
    const int cur = t & 1;
    if (t + 1 < ntiles) gload(t + 1);
    const u16* k_s = sK + cur * 64 * KROW;
    const u16* v_s = sV + cur * 64 * 72;
    f32x4 s[4][NQ];
#pragma unroll
    for (int kt = 0; kt < 4; ++kt) {
#pragma unroll
      for (int qi = 0; qi < NQ; ++qi) s[kt][qi] = (f32x4){0.f, 0.f, 0.f, 0.f};
#pragma unroll
      for (int ks = 0; ks < KS; ++ks) {
        bf16x8 kf = *(const bf16x8*)(k_s + (kt * 16 + l15) * KROW + ks * 32 + quad * 8);
#pragma unroll
        for (int qi = 0; qi < NQ; ++qi) s[kt][qi] = __builtin_amdgcn_mfma_f32_16x16x32_bf16(kf, qf[qi][ks], s[kt][qi], 0, 0, 0);
      }
    }
    if (MODE == 1 && t < 8) {
      const int drow = r0 + t - nat_r + 7;
#pragma unroll
      for (int kt = 0; kt < 4; ++kt)
#pragma unroll
        for (int j = 0; j < 4; ++j) {
          int kc = kt * 16 + quad * 4 + j;
          bool valid = (kc >= st) && (kc < st + 16);
          int bi = drow * 31 + (kc - qc + 15);
          bi = valid ? bi : 0;
          float bv = sBias[bi];
          s[kt][0][j] = valid ? (s[kt][0][j] * scale + bv) : -INFINITY;
        }
    } else {
#pragma unroll
      for (int kt = 0; kt < 4; ++kt)
#pragma unroll
        for (int qi = 0; qi < NQ; ++qi)
#pragma unroll
          for (int j = 0; j < 4; ++j) s[kt][qi][j] *= scale;
    }
    bf16x8 pb[NQ][2];
#pragma unroll
    for (int qi = 0; qi < NQ; ++qi) {
      float mx = -INFINITY;
#pragma unroll
      for (int kt = 0; kt < 4; ++kt)
#pragma unroll
        for (int j = 0; j < 4; ++j) mx = fmaxf(mx, s[kt][qi][j]);
      mx = xq_max(mx);
      const float mnew = fmaxf(m[qi], mx);
      const float alpha = __builtin_amdgcn_exp2f((m[qi] - mnew) * L2E);
      m[qi] = mnew;
      float ps = 0.f;
#pragma unroll
      for (int kt = 0; kt < 4; ++kt)
#pragma unroll
        for (int j = 0; j < 4; ++j) {
          float pv = __builtin_amdgcn_exp2f((s[kt][qi][j] - mnew) * L2E);
          s[kt][qi][j] = pv;
          ps += pv;
        }
      lsum[qi] = lsum[qi] * alpha + ps;
#pragma unroll
      for (int dt = 0; dt < 4; ++dt)
#pragma unroll
        for (int j = 0; j < 4; ++j) o[dt][qi][j] *= alpha;
#pragma unroll
      for (int kk = 0; kk < 2; ++kk) {
        bf16x8 b;
#pragma unroll
        for (int j = 0; j < 4; ++j) {
          b[j] = (short)f2bf(s[2 * kk][qi][j]);
          b[4 + j] = (short)f2bf(s[2 * kk + 1][qi][j]);
        }
        pb[qi][kk] = b;
      }
    }
#pragma unroll
    for (int kk = 0; kk < 2; ++kk)
#pragma unroll
      for (int dt = 0; dt < 4; ++dt) {
        uint2 va = *(const uint2*)(v_s + (dt * 16 + l15) * 72 + (2 * kk) * 16 + quad * 4);
        uint2 vb = *(const uint2*)(v_s + (dt * 16 + l15) * 72 + (2 * kk + 1) * 16 + quad * 4);
        uint4 vv = make_uint4(va.x, va.y, vb.x, vb.y);
        bf16x8 av = __builtin_bit_cast(bf16x8, vv);
#pragma unroll
        for (int qi = 0; qi < NQ; ++qi) o[dt][qi] = __builtin_amdgcn_mfma_f32_16x16x32_bf16(av, pb[qi][kk], o[dt][qi], 0, 0, 0);
      }
    if (t + 1 < ntiles) sstore(cur ^ 1);
    __syncthreads();
  }
#pragma unroll
  for (int qi = 0; qi < NQ; ++qi) {
    float l = xq_sum(lsum[qi]);
    const float inv = 1.f / l;
    const int row = wave * 16 * NQ + qi * 16 + l15;
#pragma unroll
    for (int dt = 0; dt < 4; ++dt)
      *(uint2*)(Op + (size_t)row * ldo + dt * 16 + quad * 4) =
          make_uint2(pack2(o[dt][qi][0] * inv, o[dt][qi][1] * inv), pack2(o[dt][qi][2] * inv, o[dt][qi][3] * inv));
  }
}

__device__ void scan_item(const Params& p, int l, int bl, int h, int dir, unsigned char* smem, const int tid) {
  float* R = (float*)smem;
  float* V = R + 2048;
  float* KK = V + 2048;
  float* KD = KK + 2048;
  float* W = KD + 2048;
  float* T1 = W + 2048;
  float* Y = T1 + 2048;
  float* BONW = Y + 2048;
  u16* XW = (u16*)(BONW + 128);
  u16* XA = XW + 32 * 72;
  const int lane = tid & 63, wave = tid >> 6, l15 = lane & 15, quad = lane >> 4;
  const u16* P = (const u16*)(p.ws + OFF_P);
  u16* Yd = (u16*)(p.ws + (dir ? OFF_YB : OFF_YF));
  float* BON = (float*)(p.ws + OFF_BON);
  const u16* Wl = (const u16*)(p.ws + OFF_W) + (size_t)l * W_TOTAL;
  const float* mu = p.in[15] + l * 1920;
  const int nn = wave * 16 + l15;
  const float w0 = p.in[16][(l * 2 + dir) * 512 + h * 64 + nn];
  const float a0 = p.in[18][(l * 2 + dir) * 512 + h * 64 + nn];
  const float ka = p.in[22][l * 512 + h * 64 + nn];
  const float rk = p.in[23][l * 512 + h * 64 + nn];
  bf16x8 wdec[2], waaa[2];
#pragma unroll
  for (int ks = 0; ks < 2; ++ks) {
    wdec[ks] = *(const bf16x8*)(Wl + W_DEC + ((size_t)dir * 512 + h * 64 + nn) * 64 + ks * 32 + quad * 8);
    waaa[ks] = *(const bf16x8*)(Wl + W_AAA + ((size_t)dir * 512 + h * 64 + nn) * 64 + ks * 32 + quad * 8);
  }
  const int st_t = tid >> 3, part = tid & 7, n0 = part * 8;
  const int rl = lane >> 2, sl = lane & 3, srow = wave * 16 + rl;
  v2f S2[8];
#pragma unroll
  for (int i = 0; i < 8; ++i) S2[i] = (v2f){0.f, 0.f};
  float* MU = (float*)(XA + 32 * 72);
  float* KKC = MU + 320;
  for (int i = tid; i < 384; i += 256) {
    int g = i >> 6, n = i & 63;
    float v;
    if (g == 0) v = mu[h * 64 + n];
    else if (g == 1) v = mu[1024 + h * 64 + n];
    else if (g == 2) v = mu[512 + h * 64 + n];
    else if (g == 3) v = mu[1536 + dir * 64 + n];
    else if (g == 4) v = mu[1664 + dir * 64 + n];
    else v = p.in[21][l * 512 + h * 64 + n];
    MU[i] = v;
  }
  uint4 raw[15];
  auto issue_raw = [&](int cidx) {
    const int seg = cidx >= 8;
    const int cc = seg ? cidx - 8 : cidx, nch = seg ? 64 : 8, len = seg ? 2048 : 256;
    const int tb = bl * TL + (seg ? 256 : 0);
    const int c = dir ? (nch - 1 - cc) : cc;
    const int pos = c * 32 + st_t;
    const bool hasp = pos > 0, hasn = pos < len - 1;
    const u16* rowp = P + (size_t)(tb + pos) * NP + n0;
    const int cols[5] = {PC_R + h * 64, PC_V + h * 64, PC_K + h * 64, PC_WLO + dir * 64, PC_ALO + dir * 64};
#pragma unroll
    for (int g = 0; g < 5; ++g) {
      raw[3 * g] = *(const uint4*)(rowp + cols[g]);
      raw[3 * g + 1] = make_uint4(0, 0, 0, 0);
      raw[3 * g + 2] = make_uint4(0, 0, 0, 0);
      if (hasp) raw[3 * g + 1] = *(const uint4*)(rowp + cols[g] - NP);
      if (hasn) raw[3 * g + 2] = *(const uint4*)(rowp + cols[g] + NP);
    }
  };
  issue_raw(0);
  __syncthreads();

  for (int cidx = 0; cidx < 72; ++cidx) {
    {
      const int seg = cidx >= 8;
      const int cc = seg ? cidx - 8 : cidx, nch = seg ? 64 : 8;
      const int tb = bl * TL + (seg ? 256 : 0);
      const int c = dir ? (nch - 1 - cc) : cc;
      const int pos0 = c * 32;
      {
#define SHIFT8(G, z)                                                                              \
  {                                                                                               \
    const uint4 c4 = raw[3 * (G)], p4 = raw[3 * (G) + 1], n4 = raw[3 * (G) + 2];                  \
    const float4 m0 = *(const float4*)(MU + (G)*64 + n0), m1 = *(const float4*)(MU + (G)*64 + n0 + 4); \
    const float mm[8] = {m0.x, m0.y, m0.z, m0.w, m1.x, m1.y, m1.z, m1.w};                          \
    const uint32_t cu[4] = {c4.x, c4.y, c4.z, c4.w}, pu[4] = {p4.x, p4.y, p4.z, p4.w}, nu[4] = {n4.x, n4.y, n4.z, n4.w}; \
    _Pragma("unroll") for (int i = 0; i < 4; ++i) {                                               \
      float c0 = lo2f(cu[i]), c1 = hi2f(cu[i]);                                                   \
      z[2 * i] = c0 + (0.5f * (lo2f(pu[i]) + lo2f(nu[i])) - c0) * mm[2 * i];                      \
      z[2 * i + 1] = c1 + (0.5f * (hi2f(pu[i]) + hi2f(nu[i])) - c1) * mm[2 * i + 1];              \
    }                                                                                             \
  }
        float z[8];
        SHIFT8(0, z);
        *(float4*)(R + st_t * 64 + n0) = make_float4(z[0], z[1], z[2], z[3]);
        *(float4*)(R + st_t * 64 + n0 + 4) = make_float4(z[4], z[5], z[6], z[7]);
        SHIFT8(1, z);
        *(float4*)(V + st_t * 64 + n0) = make_float4(z[0], z[1], z[2], z[3]);
        *(float4*)(V + st_t * 64 + n0 + 4) = make_float4(z[4], z[5], z[6], z[7]);
        SHIFT8(2, z);
        {
          const float4 k0 = *(const float4*)(KKC + n0), k1 = *(const float4*)(KKC + n0 + 4);
          const float kc[8] = {k0.x, k0.y, k0.z, k0.w, k1.x, k1.y, k1.z, k1.w};
          float q[8], ss = 0.f;
#pragma unroll
          for (int i = 0; i < 8; ++i) { q[i] = z[i] * kc[i]; ss += q[i] * q[i]; }
          *(float4*)(KD + st_t * 64 + n0) = make_float4(z[0], z[1], z[2], z[3]);
          *(float4*)(KD + st_t * 64 + n0 + 4) = make_float4(z[4], z[5], z[6], z[7]);
          ss = row8_sum(ss);
          const float inv = 1.f / fmaxf(sqrtf(ss), 1e-12f);
          *(float4*)(KK + st_t * 64 + n0) = make_float4(q[0] * inv, q[1] * inv, q[2] * inv, q[3] * inv);
          *(float4*)(KK + st_t * 64 + n0 + 4) = make_float4(q[4] * inv, q[5] * inv, q[6] * inv, q[7] * inv);
        }
        SHIFT8(3, z);
        {
          float th[8];
#pragma unroll
          for (int i = 0; i < 8; ++i) th[i] = 1.f - 2.f / (1.f + __expf(2.f * z[i]));
          *(uint4*)(XW + st_t * 72 + n0) = make_uint4(pack2(th[0], th[1]), pack2(th[2], th[3]), pack2(th[4], th[5]), pack2(th[6], th[7]));
        }
        SHIFT8(4, z);
        *(uint4*)(XA + st_t * 72 + n0) = make_uint4(pack2(z[0], z[1]), pack2(z[2], z[3]), pack2(z[4], z[5]), pack2(z[6], z[7]));
#undef SHIFT8
      }
      __syncthreads();
#pragma unroll
      for (int mt = 0; mt < 2; ++mt) {
        f32x4 aw = (f32x4){0.f, 0.f, 0.f, 0.f}, aa = (f32x4){0.f, 0.f, 0.f, 0.f};
#pragma unroll
        for (int ks = 0; ks < 2; ++ks) {
          bf16x8 xw = *(const bf16x8*)(XW + (mt * 16 + l15) * 72 + ks * 32 + quad * 8);
          bf16x8 xa = *(const bf16x8*)(XA + (mt * 16 + l15) * 72 + ks * 32 + quad * 8);
          aw = __builtin_amdgcn_mfma_f32_16x16x32_bf16(xw, wdec[ks], aw, 0, 0, 0);
          aa = __builtin_amdgcn_mfma_f32_16x16x32_bf16(xa, waaa[ks], aa, 0, 0, 0);
        }
#pragma unroll
        for (int j = 0; j < 4; ++j) {
          const int t = mt * 16 + quad * 4 + j;
          const float u = -(w0 + aw[j]);
          const float sp = (u > 20.f) ? u : __logf(1.f + __expf(u));
          const float wv = __expf(-__expf(-sp - 0.5f));
          const float av = 1.f / (1.f + __expf(-(a0 + aa[j])));
          W[t * 64 + nn] = wv;
          T1[t * 64 + nn] = KK[t * 64 + nn] * av;
          const float kd = KD[t * 64 + nn] * (1.f + (av - 1.f) * ka);
          KD[t * 64 + nn] = kd;
          const float bon = row16_sum(R[t * 64 + nn] * kd * rk);
          if (l15 == 0) BONW[wave * 32 + t] = bon;
        }
      }
      if (cidx + 1 < 72) issue_raw(cidx + 1);
      __syncthreads();
      {
        float4 nkk[4];
        float nvv;
        {
          const int i_ = dir ? 31 : 0;
#pragma unroll
          for (int q = 0; q < 4; ++q) nkk[q] = *(const float4*)(KK + i_ * 64 + sl * 16 + q * 4);
          nvv = V[i_ * 64 + srow];
        }
        for (int s = 0; s < 32; ++s) {
          const int i = dir ? (31 - s) : s;
          float4 t1[4], kd[4], w[4], r[4], kk[4];
#pragma unroll
          for (int q = 0; q < 4; ++q) {
            t1[q] = *(const float4*)(T1 + i * 64 + sl * 16 + q * 4);
            kd[q] = *(const float4*)(KD + i * 64 + sl * 16 + q * 4);
            w[q] = *(const float4*)(W + i * 64 + sl * 16 + q * 4);
            r[q] = *(const float4*)(R + i * 64 + sl * 16 + q * 4);
            kk[q] = nkk[q];
          }
          const float vv = nvv;
          v2f sa0 = (v2f){0.f, 0.f}, sa1 = (v2f){0.f, 0.f};
#pragma unroll
          for (int q = 0; q < 4; ++q) {
            sa0 += S2[2 * q] * (v2f){kk[q].x, kk[q].y};
            sa1 += S2[2 * q + 1] * (v2f){kk[q].z, kk[q].w};
          }
          if (s + 1 < 32) {
            const int i_ = dir ? (30 - s) : (s + 1);
#pragma unroll
            for (int q = 0; q < 4; ++q) nkk[q] = *(const float4*)(KK + i_ * 64 + sl * 16 + q * 4);
            nvv = V[i_ * 64 + srow];
          }
          sa0 += sa1;
          const float sa = quad_sum(sa0.x + sa0.y);
          const v2f vv2 = (v2f){vv, vv}, nsa = (v2f){-sa, -sa};
          v2f y0 = (v2f){0.f, 0.f}, y1 = (v2f){0.f, 0.f};
#pragma unroll
          for (int q = 0; q < 4; ++q) {
            v2f ta = vv2 * (v2f){kd[q].x, kd[q].y} + nsa * (v2f){t1[q].x, t1[q].y};
            v2f tb = vv2 * (v2f){kd[q].z, kd[q].w} + nsa * (v2f){t1[q].z, t1[q].w};
            S2[2 * q] = S2[2 * q] * (v2f){w[q].x, w[q].y} + ta;
            S2[2 * q + 1] = S2[2 * q + 1] * (v2f){w[q].z, w[q].w} + tb;
            y0 += S2[2 * q] * (v2f){r[q].x, r[q].y};
            y1 += S2[2 * q + 1] * (v2f){r[q].z, r[q].w};
          }
          y0 += y1;
          const float y = quad_sum(y0.x + y0.y);
          if (sl == 0) Y[i * 64 + srow] = y;
        }
      }
      __syncthreads();
      {
        const float* yp = Y + st_t * 64 + n0;
        const size_t tok = (size_t)(tb + pos0 + st_t);
        *(uint4*)(Yd + tok * 512 + h * 64 + n0) =
            make_uint4(pack2(yp[0], yp[1]), pack2(yp[2], yp[3]), pack2(yp[4], yp[5]), pack2(yp[6], yp[7]));
        if (part == 0) BON[tok * 16 + h * 2 + dir] = BONW[st_t] + BONW[32 + st_t] + BONW[64 + st_t] + BONW[96 + st_t];
      }
    }
  }
  __syncthreads();
}

__device__ void phase_mixers(const Params& p, int chunk, int l, bool with_ctx, int* counter, unsigned char* smem) {
  int& s_item = *(int*)(smem + SMEM_BYTES + 16);
  u16* sm = (u16*)smem;
  u16* P = (u16*)(p.ws + OFF_P);
  const u16* KA = (const u16*)(p.ws + OFF_KA);
  const u16* VtA = (const u16*)(p.ws + OFF_VTA);
  const u16* QB = (const u16*)(p.ws + OFF_QB);
  const u16* KB = (const u16*)(p.ws + OFF_KB);
  const u16* VtB = (const u16*)(p.ws + OFF_VTB);
  const u16* VtD = (const u16*)(p.ws + OFF_VTD);
  const float* ropeB = (const float*)(p.ws + OFF_ROPE) + 64 * 16 * 2;
  const int n_scan = BC * 8 * 2;
  const int n_al = BC * 8 * 16;
  const int n_nat = BC * 8 * 32;
  const int n_cx = BC * 8 * 2;
  const int total = n_scan + 2 * n_al + n_nat + (with_ctx ? 3 * n_cx : 0);
  const float scaleB = 0.10206207261596575f;
  while (true) {
    const int tid = otid();
    if (tid == 0) s_item = atomicAdd(counter, 1);
    __syncthreads();
    int it = s_item;
    __syncthreads();
    if (it >= total) break;
    if (it < n_scan) {
      int dir = it & 1, h = (it >> 1) & 7, bl = it >> 4;
      scan_item(p, l, bl, h, dir, smem, otid());
      continue;
    }
    it -= n_scan;
    int kind, h, bl, ntl;
    size_t tok0;
    bool rq = false;
    int qtok0 = 0, natr = 0;
    if (it < 2 * n_al) {
      kind = (it >= n_al) ? 1 : 0;
      int i2 = it - kind * n_al;
      int qt = i2 & 15; h = (i2 >> 4) & 7; bl = i2 >> 7;
      tok0 = (size_t)bl * TL + 256 + qt * 128; ntl = 36; rq = true; qtok0 = qt * 128;
    } else if (it < 2 * n_al + n_nat) {
      int i2 = it - 2 * n_al;
      kind = 3; natr = i2 & 31; h = (i2 >> 5) & 7; bl = i2 >> 8;
      tok0 = (size_t)bl * TL + 256 + natr * 64; ntl = 12;
    } else {
      int i2 = it - 2 * n_al - n_nat;
      kind = i2 / n_cx; i2 -= kind * n_cx;
      int qt = i2 & 1; h = (i2 >> 1) & 7; bl = i2 >> 4;
      tok0 = (size_t)bl * TL + qt * 128; ntl = 4;
    }
    if (kind == 1) {
      flash_item<96, 2, 0>(QB + tok0 * 768 + h * 96, 768, KB + (size_t)(bl * 8 + h) * TL * 96, 96, VtB + (size_t)(bl * 8 + h) * 64 * TL,
                           ntl, P + tok0 * NP + O_B + h * 64, NP, scaleB, rq, qtok0, ropeB, 0, nullptr, sm, otid());
    } else if (kind == 3) {
      u16* q = P + tok0 * NP + PD_Q + h * 64;
      flash_item<64, 1, 1>(q, NP, P + (size_t)bl * TL * NP + PD_K + h * 64, NP, VtD + (size_t)(bl * 8 + h) * 64 * TL, ntl, q, NP, 0.125f,
                           false, 0, ropeB, natr, p.in[26] + (size_t)(l * 8 + h) * 15 * 31, sm, otid());
    } else {
      u16* q = P + tok0 * NP + (kind == 0 ? PA_Q : PD_Q) + h * 64;
      const u16* kp = (kind == 0) ? (KA + (size_t)(bl * 2 + (h >> 2)) * TL * 64) : (P + (size_t)bl * TL * NP + PD_K + h * 64);
      const u16* vp = (kind == 0) ? (VtA + (size_t)(bl * 2 + (h >> 2)) * 64 * TL) : (VtD + (size_t)(bl * 8 + h) * 64 * TL);
      flash_item<64, 2, 0>(q, NP, kp, (kind == 0) ? 64 : NP, vp, ntl, q, NP, 0.125f, false, 0, ropeB, 0, nullptr, sm, otid());
    }
  }
}

__device__ void phase_cout(const Params& p, int l, bool latonly) {
  const int tid = otid();
  const int lane = tid & 63, wave = tid >> 6;
  u16* P = (u16*)(p.ws + OFF_P);
  const u16* YF = (const u16*)(p.ws + OFF_YF);
  const u16* YB = (const u16*)(p.ws + OFF_YB);
  const u16* G = (const u16*)(p.ws + OFF_G);
  const float* BON = (const float*)(p.ws + OFF_BON);
  const float* gnw = p.in[24] + l * 512;
  const float* gnb = p.in[25] + l * 512;
  const float* mu = p.in[15] + l * 1920 + 1024;
  for (int tok = blockIdx.x * 4 + wave; tok < TC; tok += gridDim.x * 4) {
    const int bl = tok / TL, j = tok - bl * TL;
    const bool islat = j >= 256;
    if (latonly && !islat) continue;
    const int jj = j - 256;
    const bool hasp = islat ? (jj > 0) : (j > 0);
    const bool hasn = islat ? (jj < 2047) : (j < 255);
    u16* pr = P + (size_t)tok * NP;
    for (int h = 0; h < 8; ++h) {
      const int col = h * 64 + lane;
      float y = bf2f(YF[(size_t)tok * 512 + col]) + bf2f(YB[(size_t)tok * 512 + col]);
      float mean = wave_sum(y) * (1.f / 64.f);
      float d = y - mean;
      float var = wave_sum(d * d) * (1.f / 64.f);
      float yn = d * rsqrtf(var + 64e-5f) * gnw[col] + gnb[col];
      float vc = bf2f(pr[PC_V + col]);
      float vp = hasp ? bf2f(pr[PC_V + col - NP]) : 0.f;
      float vn = hasn ? bf2f(pr[PC_V + col + NP]) : 0.f;
      float vs = vc + (0.5f * (vp + vn) - vc) * mu[col];
      float bon = BON[(size_t)tok * 16 + h * 2] + BON[(size_t)tok * 16 + h * 2 + 1];
      float oc = (yn + bon * vs) * bf2f(G[(size_t)tok * 512 + col]);
      pr[O_C + col] = f2bf(oc);
    }
  }
}

#ifndef PR_GEMM1
#define PR_GEMM1 0
#endif
#ifndef PR_MERGE
#define PR_MERGE 0
#endif
#ifndef PR_KIND
#define PR_KIND -1
#endif
__device__ void phase_probe(const Params& p, int l, int kind, unsigned char* smem) {
  u16* sm = (u16*)smem;
  u16* P = (u16*)(p.ws + OFF_P);
  u16* DUM = (u16*)(p.ws + OFF_YM);
  const float* ropeB = (const float*)(p.ws + OFF_ROPE) + 64 * 16 * 2;
  const int total = (kind == 0) ? 128 : (kind == 3 ? 2048 : 1024);
  for (int it = blockIdx.x; it < total; it += gridDim.x) {
    if (kind == 0) {
      int dir = it & 1, h = (it >> 1) & 7, bl = it >> 4;
      scan_item(p, l, bl, h, dir, smem, otid());
    } else if (kind == 1) {
      int qt = it & 15, h = (it >> 4) & 7, bl = it >> 7;
      size_t tok0 = (size_t)bl * TL + 256 + qt * 128;
      flash_item<64, 2, 0>(P + tok0 * NP + PA_Q + h * 64, NP, (const u16*)(p.ws + OFF_KA) + (size_t)(bl * 2 + (h >> 2)) * TL * 64, 64,
                           (const u16*)(p.ws + OFF_VTA) + (size_t)(bl * 2 + (h >> 2)) * 64 * TL, 36, DUM + tok0 * 1024 + h * 64, 1024,
                           0.125f, false, 0, ropeB, 0, nullptr, sm, otid());
    } else if (kind == 2) {
      int qt = it & 15, h = (it >> 4) & 7, bl = it >> 7;
      size_t tok0 = (size_t)bl * TL + 256 + qt * 128;
      flash_item<96, 2, 0>((const u16*)(p.ws + OFF_QB) + tok0 * 768 + h * 96, 768, (const u16*)(p.ws + OFF_KB) + (size_t)(bl * 8 + h) * TL * 96,
                           96, (const u16*)(p.ws + OFF_VTB) + (size_t)(bl * 8 + h) * 64 * TL, 36, P + tok0 * NP + O_B + h * 64, NP,
                           0.10206207261596575f, true, qt * 128, ropeB, 0, nullptr, sm, otid());
    } else {
      int r = it & 31, h = (it >> 5) & 7, bl = it >> 8;
      size_t tok0 = (size_t)bl * TL + 256 + r * 64;
      flash_item<64, 1, 1>(P + tok0 * NP + PD_Q + h * 64, NP, P + (size_t)bl * TL * NP + PD_K + h * 64, NP,
                           (const u16*)(p.ws + OFF_VTD) + (size_t)(bl * 8 + h) * 64 * TL, 12, DUM + tok0 * 1024 + h * 64, 1024, 0.125f,
                           false, 0, ropeB, r, p.in[26] + (size_t)(l * 8 + h) * 15 * 31, sm, otid());
    }
  }
}

#define XB_TMO      128
#define XB_XCNT(j)  (256  + 64 * (j))
#define XB_XSUB(j)  (1280 + 64 * (j))
#define XB_XGEN(j)  (2304 + 64 * (j))
#define XB_TOP      3328
#define XB_TOPGEN   3392
#define XCD_BAR_WORDS 3456
#define XB_SPIN_CAP (1u << 18)
#define LAS __attribute__((address_space(3)))
DI unsigned xb_ld(unsigned* p) { return __hip_atomic_load(p, __ATOMIC_RELAXED, __HIP_MEMORY_SCOPE_AGENT); }
DI unsigned xb_add(unsigned* p, unsigned v) { return __hip_atomic_fetch_add(p, v, __ATOMIC_RELAXED, __HIP_MEMORY_SCOPE_AGENT); }
DI unsigned xb_xcc_id() { return (unsigned)__builtin_amdgcn_s_getreg((3 << 11) | 20) & 0xFu; }
#define XB_SPIN(cond, bar) do { unsigned _sp = 0; while (cond) { __builtin_amdgcn_s_sleep(1); \
    if ((++_sp & 255u) == 0u) { if (xb_ld(&(bar)[XB_TMO])) break; if (_sp > XB_SPIN_CAP) { atomicAdd(&(bar)[XB_TMO], 1u); break; } } } } while (0)
struct XcdBarrier { unsigned* bar; unsigned x; volatile LAS unsigned* st; };
DI XcdBarrier xcd_barrier_post(unsigned* bar, volatile LAS unsigned* st) {
  XcdBarrier b; b.bar = bar; b.x = xb_xcc_id(); b.st = st;
  if (threadIdx.x == 0) (void)xb_add(&bar[XB_XCNT(b.x)], 1u);
  return b;
}
DI void xcd_barrier_complete(unsigned* bar, unsigned x, unsigned& nloc, unsigned& nx) {
  const unsigned G = gridDim.x * gridDim.y * gridDim.z;
  unsigned sum, cnt, mine, sp = 0u;
  for (;;) {
    sum = 0u; cnt = 0u; mine = 0u;
#pragma unroll
    for (unsigned j = 0; j < 16; ++j) { const unsigned c = xb_ld(&bar[XB_XCNT(j)]); sum += c; cnt += (c > 0u) ? 1u : 0u; mine = (j == x) ? c : mine; }
    if (sum == G) break;
    __builtin_amdgcn_s_sleep(1);
    if ((++sp & 255u) == 0u) { if (xb_ld(&bar[XB_TMO])) break; if (sp > XB_SPIN_CAP) { atomicAdd(&bar[XB_TMO], 1u); break; } }
  }
  nloc = mine > 0u ? mine : 1u; nx = cnt > 0u ? cnt : 1u;
}
DI void xcd_barrier(const XcdBarrier& b) {
  asm volatile("s_waitcnt vmcnt(0)" ::: "memory");
  __syncthreads();
  if (threadIdx.x == 0) {
    unsigned* bar = b.bar;
    __builtin_amdgcn_s_waitcnt(0);
    unsigned nloc = b.st[0], nx = b.st[1];
    if (nloc == 0u) { xcd_barrier_complete(bar, b.x, nloc, nx); b.st[0] = nloc; b.st[1] = nx; }
    const unsigned old = xb_add(&bar[XB_XSUB(b.x)], 1u);
    const unsigned gen = old / nloc;
    if (old + 1u == (gen + 1u) * nloc) {
      __builtin_amdgcn_fence(__ATOMIC_RELEASE, "agent");
      asm volatile("s_waitcnt vmcnt(0)" ::: "memory");
      const unsigned og = xb_add(&bar[XB_TOP], 1u);
      const unsigned tg = og / nx;
      if (og + 1u == (tg + 1u) * nx) xb_add(&bar[XB_TOPGEN], 1u);
      else XB_SPIN(xb_ld(&bar[XB_TOPGEN]) == tg, bar);
      __builtin_amdgcn_fence(__ATOMIC_ACQUIRE, "agent");
      xb_add(&bar[XB_XGEN(b.x)], 1u);
      asm volatile("s_waitcnt vmcnt(0)" ::: "memory");
    } else {
      XB_SPIN(xb_ld(&bar[XB_XGEN(b.x)]) == gen, bar);
      __builtin_amdgcn_fence(__ATOMIC_ACQUIRE, "agent");
      asm volatile("s_waitcnt vmcnt(0)" ::: "memory");
    }
  }
  __syncthreads();
}

__global__ void __launch_bounds__(256, 2) fwd_megakernel(Params p) {
  extern __shared__ __attribute__((aligned(16))) unsigned char smem[];
  cg::grid_group grid = cg::this_grid();
  u16* sm = (u16*)smem;
  unsigned* xb_words = (unsigned*)(smem + SMEM_BYTES);
  if (threadIdx.x < 4) xb_words[threadIdx.x] = 0u;
  __syncthreads();
  const XcdBarrier xb = xcd_barrier_post((unsigned*)(p.ws + OFF_BAR), (volatile LAS unsigned*)xb_words);
  phase0(p, smem);
  grid.sync();
  u16* H = (u16*)(p.ws + OFF_H);
  u16* P = (u16*)(p.ws + OFF_P);
  int* ctr = (int*)(p.ws + OFF_CTR);
  for (int chunk = 0; chunk < NCHUNK; ++chunk) {
    for (int l = 0; l < 2; ++l) {
      const bool last = (l == 1);
      const u16* W = (const u16*)(p.ws + OFF_W) + (size_t)l * W_TOTAL;
      const float* mod = (const float*)(p.ws + OFF_MOD) + (size_t)l * 17 * 6144;
      phase_norm(p, chunk, l, 0, false);
      xcd_barrier(xb);
      for (int rep = 0; rep <= PR_GEMM1; ++rep) {
        gemm_phase<8, 4, true>(H, 1024, W + W_IN, 1024, NP, false, EpiStore{P, NP}, smem);
        xcd_barrier(xb);
      }
      phase_prep(p, l, sm);
      xcd_barrier(xb);
      gemm_phase<4, 4, true>(P + PB_CQ, NP, W + W_QUP, 384, 768, false, EpiStore{(u16*)(p.ws + OFF_QB), 768}, smem);
      gemm_phase<4, 4, false>(P + PB_CKV, NP, W + W_KVUP, 256, 1024, false, EpiKV{(u16*)(p.ws + OFF_KB), (u16*)(p.ws + OFF_VTB)}, smem);
      gemm_phase<4, 4, true>((const u16*)(p.ws + OFF_GL), 128, W + W_GATE, 128, 512, false, EpiStore{(u16*)(p.ws + OFF_G), 512}, smem);
      xcd_barrier(xb);
      if (PR_KIND >= 0) {
        phase_probe(p, l, PR_KIND, smem);
        xcd_barrier(xb);
      }
      phase_mixers(p, chunk, l, !last, ctr + chunk * 2 + l, smem);
      xcd_barrier(xb);
      phase_cout(p, l, last);
      xcd_barrier(xb);
      for (int rep = 0; rep <= PR_MERGE; ++rep) {
        phase_merge(p, l, last, smem);
        xcd_barrier(xb);
      }
      gemm_phase<4, 4, true>((const u16*)(p.ws + OFF_YM), 1024, W + W_OUT, 1024, 1024, last, EpiResid{p, chunk, mod, 2048, l == 0}, smem);
      xcd_barrier(xb);
      phase_norm(p, chunk, l, 1, last);
      xcd_barrier(xb);
      gemm_phase<8, 4, true>(H, 1024, W + W_1, 1024, 4096, last, EpiRelu2{P}, smem);
      xcd_barrier(xb);
      gemm_phase<4, 4, true>(P, 4096, W + W_2, 4096, 1024, last, EpiResid{p, chunk, mod, 5120, false}, smem);
      xcd_barrier(xb);
    }
    phase_final(p, chunk);
    xcd_barrier(xb);
  }
}

extern "C" void kernel_launch(void* const* d_in, const int* in_sizes, int n_in, void* d_out, int out_size, void* d_ws,
                              size_t ws_size, hipStream_t stream) {
  static int grid_blocks = 0;
  if (!grid_blocks) {
    int dev = 0, cus = 0, per_cu = 0;
    hipGetDevice(&dev);
    hipDeviceGetAttribute(&cus, hipDeviceAttributeMultiprocessorCount, dev);
    hipFuncSetAttribute((const void*)fwd_megakernel, hipFuncAttributeMaxDynamicSharedMemorySize, SMEM_DYN);
    hipOccupancyMaxActiveBlocksPerMultiprocessor(&per_cu, fwd_megakernel, 256, SMEM_DYN);
    if (per_cu > 2) per_cu = 2;
    if (per_cu < 1) per_cu = 1;
    grid_blocks = cus * per_cu;
  }
  if (ws_size < OFF_END) fprintf(stderr, "workspace too small: %zu < %zu\n", ws_size, (size_t)OFF_END);
  Params p{};
  for (int i = 0; i < 32; ++i) p.in[i] = (const float*)d_in[i];
  p.out = (float*)d_out;
  p.ws = (unsigned char*)d_ws;
  hipMemsetAsync(d_ws, 0, 1048576, stream);
  void* args[] = {&p};
  hipError_t e = hipLaunchCooperativeKernel((void*)fwd_megakernel, dim3(grid_blocks), dim3(256), args, SMEM_DYN, stream);
  if (e != hipSuccess) fprintf(stderr, "cooperative launch failed: %s (grid %d)\n", hipGetErrorString(e), grid_blocks);
}
```

```cpp
#include <hip/hip_runtime.h>
#include <hip/hip_cooperative_groups.h>
#include <stdint.h>
#include <cstdio>
namespace cg = cooperative_groups;

typedef unsigned short u16;
typedef __attribute__((ext_vector_type(8))) short bf16x8;
typedef __attribute__((ext_vector_type(4))) float f32x4;
typedef __attribute__((ext_vector_type(2))) float v2f;
#define DI __device__ __forceinline__

#ifndef PR_ABL
#define PR_ABL 0
#endif
constexpr int SMEM_BYTES = 73728;
constexpr int SMEM_DYN = SMEM_BYTES + 64;
constexpr int DM = 1024, TL = 2304;
constexpr int BC = 8, NCHUNK = 2, TC = BC * TL;
constexpr int NP = 4992;
constexpr int PA_Q = 0, PA_K = 512, PA_V = 640, PB_CQ = 768, PB_CKV = 1152, PB_KR = 1408;
constexpr int PC_R = 1440, PC_K = 1952, PC_V = 2464, PC_WLO = 2976, PC_ALO = 3104, PC_GLO = 3232;
constexpr int PD_Q = 3360, PD_K = 3872, PD_V = 4384;
constexpr int O_A = 0, O_B = 768, O_C = 1440, O_D = 3360;

constexpr int W_IN = 0, W_G = 5111808, W_QUP = 9306112, W_KVUP = 9601024, W_GATE = 9863168, W_DEC = 9928704,
              W_AAA = 9994240, W_BR = 10059776, W_OUT = 12156928, W_1 = 13205504, W_2 = 17399808, W_TOTAL = 21594112;

constexpr size_t OFF_MOD = 0;
constexpr size_t OFF_CTR = 835584;
constexpr size_t OFF_BAR = 851968;
constexpr size_t OFF_ROPE = 1048576;
constexpr size_t OFF_W = 2097152;
constexpr size_t OFF_H = OFF_W + (size_t)2 * W_TOTAL * 2;
constexpr size_t OFF_P = OFF_H + (size_t)TC * 1024 * 2;
constexpr size_t OFF_KA = OFF_P + (size_t)TC * NP * 2;
constexpr size_t OFF_VTA = OFF_KA + (size_t)BC * 2 * TL * 64 * 2;
constexpr size_t OFF_QB = OFF_VTA + (size_t)BC * 2 * TL * 64 * 2;
constexpr size_t OFF_KB = OFF_QB + (size_t)TC * 768 * 2;
constexpr size_t OFF_VTB = OFF_KB + (size_t)TC * 768 * 2;
constexpr size_t OFF_VTD = OFF_VTB + (size_t)TC * 512 * 2;
constexpr size_t OFF_GL = OFF_VTD + (size_t)TC * 512 * 2;
constexpr size_t OFF_G = OFF_GL + (size_t)TC * 128 * 2;
constexpr size_t OFF_YF = OFF_G + (size_t)TC * 512 * 2;
constexpr size_t OFF_YB = OFF_YF + (size_t)TC * 512 * 2;
constexpr size_t OFF_BON = OFF_YB + (size_t)TC * 512 * 2;
constexpr size_t OFF_XC = OFF_BON + (size_t)TC * 16 * 4;
constexpr size_t OFF_END = OFF_XC + (size_t)BC * 256 * 1024 * 4;
constexpr size_t OFF_YM = OFF_QB;

struct Params {
  const float* in[32];
  float* out;
  unsigned char* ws;
};

DI u16 f2bf(float f) { uint32_t u = __float_as_uint(f); u += 0x7fffu + ((u >> 16) & 1u); return (u16)(u >> 16); }
DI float bf2f(u16 h) { return __uint_as_float(((uint32_t)h) << 16); }
typedef __bf16 bf2_t __attribute__((ext_vector_type(2)));
DI uint32_t pack2(float a, float b) { v2f v = {a, b}; bf2_t r = __builtin_convertvector(v, bf2_t); return __builtin_bit_cast(uint32_t, r); }
DI float lo2f(uint32_t u) { return __uint_as_float(u << 16); }
DI float hi2f(uint32_t u) { return __uint_as_float(u & 0xffff0000u); }
DI float dpp_f(float v, const int ctrl_is_unused) { return v; }
#define DPP_ADD(v, ctrl) ((v) + __int_as_float(__builtin_amdgcn_update_dpp(0, __float_as_int(v), (ctrl), 0xF, 0xF, true)))
DI float row8_sum(float v) {
  v = DPP_ADD(v, 0xB1); v = DPP_ADD(v, 0x4E); v = DPP_ADD(v, 0x141);
  return v;
}
DI float row16_sum(float v) {
  v = DPP_ADD(v, 0xB1); v = DPP_ADD(v, 0x4E); v = DPP_ADD(v, 0x141); v = DPP_ADD(v, 0x140);
  return v;
}
DI float xq_sum(float v) {
  auto r = __builtin_amdgcn_permlane16_swap(__float_as_uint(v), __float_as_uint(v), false, false);
  v = __uint_as_float(r[0]) + __uint_as_float(r[1]);
  auto r2 = __builtin_amdgcn_permlane32_swap(__float_as_uint(v), __float_as_uint(v), false, false);
  return __uint_as_float(r2[0]) + __uint_as_float(r2[1]);
}
DI float xq_max(float v) {
  auto r = __builtin_amdgcn_permlane16_swap(__float_as_uint(v), __float_as_uint(v), false, false);
  v = fmaxf(__uint_as_float(r[0]), __uint_as_float(r[1]));
  auto r2 = __builtin_amdgcn_permlane32_swap(__float_as_uint(v), __float_as_uint(v), false, false);
  return fmaxf(__uint_as_float(r2[0]), __uint_as_float(r2[1]));
}
DI float wave_sum(float v) { return xq_sum(row16_sum(v)); }
DI float quad_sum(float v) {
  v += __int_as_float(__builtin_amdgcn_update_dpp(0, __float_as_int(v), 0xB1, 0xF, 0xF, true));
  v += __int_as_float(__builtin_amdgcn_update_dpp(0, __float_as_int(v), 0x4E, 0xF, 0xF, true));
  return v;
}
DI int otid() { int t = threadIdx.x; asm volatile("" : "+v"(t)); return t; }
DI float sigmoidf_(float x) { return 1.f / (1.f + __expf(-x)); }

DI float* x1_row(const Params& p, int chunk, int row) {
  int bl = row / TL, j = row - bl * TL;
  if (j < 256) return (float*)(p.ws + OFF_XC) + ((size_t)(bl * 256 + j)) * DM;
  return p.out + ((size_t)((chunk * BC + bl) * 2048 + (j - 256))) * DM;
}
DI const float* xin_row(const Params& p, int chunk, int row) {
  int bl = row / TL, j = row - bl * TL;
  int b = chunk * BC + bl;
  if (j < 256) return p.in[2] + ((size_t)(b * 256 + j)) * DM;
  return p.in[0] + ((size_t)(b * 2048 + (j - 256))) * DM;
}
DI int mod_row(int chunk, int row) {
  int bl = row / TL, j = row - bl * TL;
  return (j < 256) ? 16 : (chunk * BC + bl);
}

__constant__ int CONVTAB[16][8] = {
  {8, 1024 * 8992, 0, 1024, 8992, 0, 4896, W_IN},
  {8, 1024 * 8992, 0, 1024, 8992, 4896, 4096, W_G},
  {13, 384 * 768, 0, 384, 768, 0, 768, W_QUP},
  {14, 256 * 1024, 0, 256, 1024, 0, 1024, W_KVUP},
  {20, 128 * 512, 0, 128, 512, 0, 512, W_GATE},
  {17, 2 * 64 * 512, 0, 64, 512, 0, 512, W_DEC},
  {17, 2 * 64 * 512, 64 * 512, 64, 512, 0, 512, W_DEC + 512 * 64},
  {19, 2 * 64 * 512, 0, 64, 512, 0, 512, W_AAA},
  {19, 2 * 64 * 512, 64 * 512, 64, 512, 0, 512, W_AAA + 512 * 64},
  {27, 4 * 512 * 1024, 0, 512, 1024, 0, 1024, W_BR},
  {27, 4 * 512 * 1024, 512 * 1024, 512, 1024, 0, 1024, W_BR + 1024 * 512},
  {27, 4 * 512 * 1024, 2 * 512 * 1024, 512, 1024, 0, 1024, W_BR + 2 * 1024 * 512},
  {27, 4 * 512 * 1024, 3 * 512 * 1024, 512, 1024, 0, 1024, W_BR + 3 * 1024 * 512},
  {28, 1024 * 1024, 0, 1024, 1024, 0, 1024, W_OUT},
  {29, 1024 * 4096, 0, 1024, 4096, 0, 4096, W_1},
  {30, 4096 * 1024, 0, 4096, 1024, 0, 1024, W_2},
};
constexpr int CONV_TILES_PER_LAYER = 1232 + 1024 + 72 + 64 + 16 + 8 + 8 + 8 + 8 + 128 * 4 + 256 + 1024 + 1024;

__device__ void conv_tile(const float* __restrict__ src, int ld, int k0, int n0, int ncols, u16* __restrict__ dst, int K,
                          float* tile, const int tid) {
  {
    const int c4 = (tid & 15) * 4;
#pragma unroll
    for (int i = 0; i < 4; ++i) {
      int r = (tid >> 4) + 16 * i;
      float4 v = make_float4(0.f, 0.f, 0.f, 0.f);
      if (n0 + c4 < ncols) v = *(const float4*)(src + (size_t)(k0 + r) * ld + n0 + c4);
      tile[r * 65 + c4 + 0] = v.x; tile[r * 65 + c4 + 1] = v.y; tile[r * 65 + c4 + 2] = v.z; tile[r * 65 + c4 + 3] = v.w;
    }
  }
  __syncthreads();
  {
    const int n = tid >> 2, kc = (tid & 3) * 16;
    if (n0 + n < ncols) {
      uint32_t w[8];
#pragma unroll
      for (int i = 0; i < 8; ++i) w[i] = pack2(tile[(kc + 2 * i) * 65 + n], tile[(kc + 2 * i + 1) * 65 + n]);
      uint4* d = (uint4*)(dst + (size_t)(n0 + n) * K + k0 + kc);
      d[0] = make_uint4(w[0], w[1], w[2], w[3]);
      d[1] = make_uint4(w[4], w[5], w[6], w[7]);
    }
  }
  __syncthreads();
}

__device__ void phase0(const Params& p, unsigned char* smem) {
  float* fsm = (float*)smem;
  const int tid = otid();
  const int n_conv = 2 * CONV_TILES_PER_LAYER;
  const int n_pad = 2 * 48;
  const int n_ada = 2 * 16 * 24;
  const int total = n_conv + n_pad + n_ada + 1;
  u16* wbase = (u16*)(p.ws + OFF_W);
  for (int it = blockIdx.x; it < total; it += gridDim.x) {
    if (it < n_conv) {
      int l = it / CONV_TILES_PER_LAYER, r = it - l * CONV_TILES_PER_LAYER;
      int job = 0;
      for (; job < 16; ++job) {
        int nt = (CONVTAB[job][3] >> 6) * ((CONVTAB[job][6] + 63) >> 6);
        if (r < nt) break;
        r -= nt;
      }
      const int K = CONVTAB[job][3], ld = CONVTAB[job][4], col0 = CONVTAB[job][5], ncols = CONVTAB[job][6];
      const int nkt = K >> 6;
      const int kt = r % nkt, ntile = r / nkt;
      const float* src = p.in[CONVTAB[job][0]] + (size_t)l * CONVTAB[job][1] + CONVTAB[job][2] + col0;
      u16* dst = wbase + (size_t)l * W_TOTAL + CONVTAB[job][7];
      conv_tile(src, ld, kt * 64, ntile * 64, ncols, dst, K, fsm, tid);
    } else if (it < n_conv + n_pad) {
      int r = it - n_conv;
      int l = r / 48, q = r - l * 48;
      u16* dst = wbase + (size_t)l * W_TOTAL + W_IN + (size_t)(4896 + q * 2) * 1024;
      *(uint4*)(dst + tid * 8) = make_uint4(0, 0, 0, 0);
    } else if (it < n_conv + n_pad + n_ada) {
      int r = it - n_conv - n_pad;
      int l = r / 384; r -= l * 384;
      int kc = r / 24, nb = r - kc * 24;
      for (int idx = tid; idx < 17 * 64; idx += 256) {
        int rr = idx >> 6, k = idx & 63;
        float cv = (rr < 16) ? p.in[1][rr * 1024 + kc * 64 + k] : p.in[3][kc * 64 + k];
        fsm[idx] = cv / (1.f + expf(-cv));
      }
      __syncthreads();
      const int n = nb * 256 + tid;
      float acc[17];
#pragma unroll
      for (int i = 0; i < 17; ++i) acc[i] = 0.f;
      const float* wp = p.in[4] + ((size_t)l * 1024 + kc * 64) * 6144 + n;
#pragma unroll 4
      for (int k = 0; k < 64; ++k) {
        float w = wp[(size_t)k * 6144];
#pragma unroll
        for (int i = 0; i < 17; ++i) acc[i] += fsm[i * 64 + k] * w;
      }
      float bias = (kc == 0) ? p.in[5][l * 6144 + n] : 0.f;
      float* mod = (float*)(p.ws + OFF_MOD);
#pragma unroll
      for (int i = 0; i < 17; ++i) atomicAdd(&mod[(size_t)(l * 17 + i) * 6144 + n], acc[i] + bias);
      __syncthreads();
    } else {
      float* ra = (float*)(p.ws + OFF_ROPE);
      float* rb = ra + 64 * 16 * 2;
      for (int idx = tid; idx < 64 * 16; idx += 256) {
        int pos = idx >> 4, i = idx & 15;
        float inv = powf(10000.f, -(float)i / 16.f);
        float ang = (float)pos * inv;
        ra[idx * 2] = cosf(ang); ra[idx * 2 + 1] = sinf(ang);
      }
      for (int idx = tid; idx < 64 * 8; idx += 256) {
        int pos = idx >> 3, i = idx & 7;
        float inv = powf(10000.f, -(float)i / 8.f);
        float ang = (float)pos * inv;
        rb[idx * 2] = cosf(ang); rb[idx * 2 + 1] = sinf(ang);
      }
    }
  }
}

__device__ void phase_norm(const Params& p, int chunk, int l, int which, bool latonly) {
  const int tid = otid();
  const int lane = tid & 63, wave = tid >> 6;
  const float* g = p.in[which == 0 ? 6 : 7] + l * 1024;
  const float* mod = (const float*)(p.ws + OFF_MOD) + (size_t)l * 17 * 6144;
  u16* H = (u16*)(p.ws + OFF_H);
  for (int row = blockIdx.x * 4 + wave; row < TC; row += gridDim.x * 4) {
    int j = row % TL;
    if (latonly && j < 256) continue;
    const float* src = (which == 0 && l == 0) ? xin_row(p, chunk, row) : (const float*)x1_row(p, chunk, row);
    const float* mr = mod + (size_t)mod_row(chunk, row) * 6144 + which * 3072;
    float4 v[4];
    float ss = 0.f;
#pragma unroll
    for (int i = 0; i < 4; ++i) {
      v[i] = *(const float4*)(src + i * 256 + lane * 4);
      ss += v[i].x * v[i].x + v[i].y * v[i].y + v[i].z * v[i].z + v[i].w * v[i].w;
    }
    ss = wave_sum(ss);
    float rs = rsqrtf(ss * (1.f / 1024.f) + 1e-6f);
#pragma unroll
    for (int i = 0; i < 4; ++i) {
      int c = i * 256 + lane * 4;
      float4 gg = *(const float4*)(g + c);
      float4 sh = *(const float4*)(mr + c);
      float4 sc = *(const float4*)(mr + 1024 + c);
      float a0 = v[i].x * rs * gg.x * (1.f + sc.x) + sh.x;
      float a1 = v[i].y * rs * gg.y * (1.f + sc.y) + sh.y;
      float a2 = v[i].z * rs * gg.z * (1.f + sc.z) + sh.z;
      float a3 = v[i].w * rs * gg.w * (1.f + sc.w) + sh.w;
      *(uint2*)(H + (size_t)row * 1024 + c) = make_uint2(pack2(a0, a1), pack2(a2, a3));
    }
  }
}

__device__ void phase_final(const Params& p, int chunk) {
  const int tid = otid();
  const int lane = tid & 63, wave = tid >> 6;
  const float* g = p.in[31];
  for (int r = blockIdx.x * 4 + wave; r < BC * 2048; r += gridDim.x * 4) {
    float* px = p.out + ((size_t)chunk * BC * 2048 + r) * DM;
    float4 v[4];
    float ss = 0.f;
#pragma unroll
    for (int i = 0; i < 4; ++i) {
      v[i] = *(const float4*)(px + i * 256 + lane * 4);
      ss += v[i].x * v[i].x + v[i].y * v[i].y + v[i].z * v[i].z + v[i].w * v[i].w;
    }
    ss = wave_sum(ss);
    float rs = rsqrtf(ss * (1.f / 1024.f) + 1e-6f);
#pragma unroll
    for (int i = 0; i < 4; ++i) {
      int c = i * 256 + lane * 4;
      float4 gg = *(const float4*)(g + c);
      *(float4*)(px + c) = make_float4(v[i].x * rs * gg.x, v[i].y * rs * gg.y, v[i].z * rs * gg.z, v[i].w * rs * gg.w);
    }
  }
}

#define GEMM_WAIT_VM(n) asm volatile("s_waitcnt vmcnt(" #n ")" ::: "memory")
DI void raw_barrier() { asm volatile("s_waitcnt lgkmcnt(0)" ::: "memory"); __builtin_amdgcn_s_barrier(); }
template <int MI, int NI, bool TR>
DI void gemm_dma(const u16* __restrict__ A, int lda, const u16* __restrict__ Bt, int ldb, int K, f32x4 (&acc)[MI][NI],
                 unsigned char* smem, const int tid) {
  constexpr int BM = 32 * MI, BN = 32 * NI;
  constexpr int SB = (BM + BN) * 64;
  constexpr int NS = (73728 / SB) >= 4 ? 4 : 3;
  constexpr int LA = BM / 64, LB = BN / 64, LPT = LA + LB;
  static_assert(LPT == 3 || LPT == 4 || LPT == 6, "unexpected tile");
  const int lane = tid & 63, wave = tid >> 6, l15 = lane & 15, quad = lane >> 4;
  const int wm = wave >> 1, wn = wave & 1;
  const int drow = tid >> 2;
  const int g4 = (0x1230 >> (((drow >> 2) & 3) * 4)) & 3;
  const int dc = (tid & 3) ^ g4;
  const u16* Asrc = A + (size_t)drow * lda + dc * 8;
  const u16* Bsrc = Bt + (size_t)drow * ldb + dc * 8;
  unsigned char* dstw = smem + (tid & ~63) * 16;
  auto issue = [&](int kt, int buf) {
    const int ko = kt * 32;
#pragma unroll
    for (int j = 0; j < LA; ++j)
      __builtin_amdgcn_global_load_lds((const unsigned*)(Asrc + (size_t)(j * 64) * lda + ko), (unsigned*)(dstw + buf * SB + j * 4096), 16, 0, 0);
#pragma unroll
    for (int j = 0; j < LB; ++j)
      __builtin_amdgcn_global_load_lds((const unsigned*)(Bsrc + (size_t)(j * 64) * ldb + ko), (unsigned*)(dstw + buf * SB + (LA + j) * 4096), 16, 0, 0);
  };
  const int rg4 = (0x1230 >> ((l15 >> 2) * 4)) & 3;
  const int aoff = (wm * 16 * MI + l15) * 64 + ((quad ^ rg4) * 16);
  const int boff = BM * 64 + (wn * 16 * NI + l15) * 64 + ((quad ^ rg4) * 16);
  const int nk = K >> 5;
  GEMM_WAIT_VM(0);
#pragma unroll
  for (int s_ = 0; s_ < NS - 1; ++s_)
    if (s_ < nk) issue(s_, s_);
  int buf = 0;
  for (int kt = 0; kt < nk; ++kt) {
    const int rem = nk - 1 - kt;
    if (NS == 4) {
      if (rem >= 2) { if (LPT == 3) GEMM_WAIT_VM(6); else if (LPT == 4) GEMM_WAIT_VM(8); else GEMM_WAIT_VM(12); }
      else if (rem == 1) { if (LPT == 3) GEMM_WAIT_VM(3); else if (LPT == 4) GEMM_WAIT_VM(4); else GEMM_WAIT_VM(6); }
      else GEMM_WAIT_VM(0);
    } else {
      if (rem >= 1) { if (LPT == 3) GEMM_WAIT_VM(3); else if (LPT == 4) GEMM_WAIT_VM(4); else GEMM_WAIT_VM(6); }
      else GEMM_WAIT_VM(0);
    }
    raw_barrier();
    if (kt + NS - 1 < nk) { int nb = buf + NS - 1; if (nb >= NS) nb -= NS; issue(kt + NS - 1, nb); }
    const unsigned char* st = smem + buf * SB;
    bf16x8 af[MI], bfr[NI];
#pragma unroll
    for (int mi = 0; mi < MI; ++mi) af[mi] = *(const bf16x8*)(st + aoff + mi * 1024);
#pragma unroll
    for (int ni = 0; ni < NI; ++ni) bfr[ni] = *(const bf16x8*)(st + boff + ni * 1024);
    __builtin_amdgcn_s_setprio(1);
#pragma unroll
    for (int mi = 0; mi < MI; ++mi)
#pragma unroll
      for (int ni = 0; ni < NI; ++ni)
        acc[mi][ni] = TR ? __builtin_amdgcn_mfma_f32_16x16x32_bf16(bfr[ni], af[mi], acc[mi][ni], 0, 0, 0)
                         : __builtin_amdgcn_mfma_f32_16x16x32_bf16(af[mi], bfr[ni], acc[mi][ni], 0, 0, 0);
    __builtin_amdgcn_s_setprio(0);
    if (++buf == NS) buf = 0;
  }
  raw_barrier();
}

DI bool tile_map(int t, int nMg, int nNt, bool latonly, int MT, int& mt, int& nt) {
  int x = t & 7, rest = t >> 3;
  int ni = rest & 7, q = rest >> 3;
  int mg = q % nMg, ng = q / nMg;
  nt = ng * 8 + ni;
  if (nt >= nNt) return false;
  int mti = mg * 8 + x;
  if (MT == 128) mt = latonly ? ((mti >> 4) * 18 + 2 + (mti & 15)) : mti;
  else mt = latonly ? ((mti >> 3) * 9 + 1 + (mti & 7)) : mti;
  return true;
}

template <int MI, int NI, bool TR, class Epi>
__device__ void gemm_phase(const u16* A, int lda, const u16* Bt, int K, int N, bool latonly, Epi epi, unsigned char* smem) {
  constexpr int BM = 32 * MI, BN = 32 * NI;
  const int nMg = (BM == 128) ? (latonly ? 16 : 18) : (latonly ? 8 : 9);
  const int nNt = N / BN;
  const int total = 64 * nMg * ((nNt + 7) >> 3);
  const int tid = otid();
  const int lane = tid & 63, wave = tid >> 6, l15 = lane & 15, quad = lane >> 4;
  const int wm = wave >> 1, wn = wave & 1;
  for (int t = blockIdx.x; t < total; t += gridDim.x) {
    int mt, nt;
    if (!tile_map(t, nMg, nNt, latonly, BM, mt, nt)) continue;
    const int m0 = mt * BM, n0 = nt * BN;
    f32x4 acc[MI][NI];
#pragma unroll
    for (int mi = 0; mi < MI; ++mi)
#pragma unroll
      for (int ni = 0; ni < NI; ++ni) acc[mi][ni] = (f32x4){0.f, 0.f, 0.f, 0.f};
    gemm_dma<MI, NI, TR>(A + (size_t)m0 * lda, lda, Bt + (size_t)n0 * K, K, K, acc, smem, tid);
#pragma unroll
    for (int mi = 0; mi < MI; ++mi)
#pragma unroll
      for (int ni = 0; ni < NI; ++ni) {
        if (TR) epi(m0 + wm * 16 * MI + mi * 16 + l15, n0 + wn * 16 * NI + ni * 16 + quad * 4, acc[mi][ni]);
        else epi(m0 + wm * 16 * MI + mi * 16 + quad * 4, n0 + wn * 16 * NI + ni * 16 + l15, acc[mi][ni]);
      }
  }
}

struct EpiStore {
  u16* C; int ldc;
  DI void operator()(int r, int c0, f32x4 v) const {
    *(uint2*)(C + (size_t)r * ldc + c0) = make_uint2(pack2(v[0], v[1]), pack2(v[2], v[3]));
  }
};
struct EpiKV {
  u16* KB; u16* VtB;
  DI void operator()(int r0, int c, f32x4 v) const {
    int bl = r0 / TL, j0 = r0 - bl * TL;
    int head = c >> 7, w = c & 127;
    if (w < 64) {
#pragma unroll
      for (int j = 0; j < 4; ++j) KB[((size_t)(bl * 8 + head) * TL + j0 + j) * 96 + w] = f2bf(v[j]);
    } else {
      *(uint2*)(VtB + ((size_t)(bl * 8 + head) * 64 + (w - 64)) * TL + j0) = make_uint2(pack2(v[0], v[1]), pack2(v[2], v[3]));
    }
  }
};
struct EpiRelu2 {
  u16* C;
  DI void operator()(int r, int c0, f32x4 v) const {
    float t0 = fmaxf(v[0], 0.f), t1 = fmaxf(v[1], 0.f), t2 = fmaxf(v[2], 0.f), t3 = fmaxf(v[3], 0.f);
    *(uint2*)(C + (size_t)r * 4096 + c0) = make_uint2(pack2(t0 * t0, t1 * t1), pack2(t2 * t2, t3 * t3));
  }
};
struct EpiResid {
  Params p; int chunk; const float* mod; int gofs; bool from_input;
  DI void operator()(int r, int c0, f32x4 v) const {
    const float4 gt = *(const float4*)(mod + (size_t)mod_row(chunk, r) * 6144 + gofs + c0);
    float* dst = x1_row(p, chunk, r) + c0;
    const float4 xin = from_input ? *(const float4*)(xin_row(p, chunk, r) + c0) : *(const float4*)dst;
    *(float4*)dst = make_float4(xin.x + gt.x * v[0], xin.y + gt.y * v[1], xin.z + gt.z * v[2], xin.w + gt.w * v[3]);
  }
};

__device__ void phase_merge(const Params& p, int l, bool latonly, unsigned char* smem) {
  const u16* H = (const u16*)(p.ws + OFF_H);
  const u16* P = (const u16*)(p.ws + OFF_P);
  const u16* W = (const u16*)(p.ws + OFF_W) + (size_t)l * W_TOTAL;
  u16* YM = (u16*)(p.ws + OFF_YM);
  const int nMg = latonly ? 16 : 18;
  const int nNt = 16;
  const int total = 64 * nMg * 2;
  const int tid = otid();
  const int lane = tid & 63, wave = tid >> 6, l15 = lane & 15, quad = lane >> 4;
  const int wm = wave >> 1, wn = wave & 1;
  for (int t = blockIdx.x; t < total; t += gridDim.x) {
    int mt, nt;
    if (!tile_map(t, nMg, nNt, latonly, 128, mt, nt)) continue;
    const int m0 = mt * 128, n0 = nt * 64;
    f32x4 y[4][2];
#pragma unroll
    for (int mi = 0; mi < 4; ++mi)
#pragma unroll
      for (int ni = 0; ni < 2; ++ni) y[mi][ni] = (f32x4){0.f, 0.f, 0.f, 0.f};
    for (int i = 0; i < 4; ++i) {
      const int ocol = (i == 0) ? O_A : (i == 1) ? O_B : (i == 2) ? O_C : O_D;
      f32x4 g[4][2], b[4][2];
#pragma unroll
      for (int mi = 0; mi < 4; ++mi)
#pragma unroll
        for (int ni = 0; ni < 2; ++ni) { g[mi][ni] = (f32x4){0.f, 0.f, 0.f, 0.f}; b[mi][ni] = (f32x4){0.f, 0.f, 0.f, 0.f}; }
      gemm_dma<4, 2, true>(H + (size_t)m0 * 1024, 1024, W + W_G + (size_t)(i * 1024 + n0) * 1024, 1024, 1024, g, smem, tid);
      gemm_dma<4, 2, true>(P + (size_t)m0 * NP + ocol, NP, W + W_BR + (size_t)(i * 1024 + n0) * 512, 512, 512, b, smem, tid);
#pragma unroll
      for (int mi = 0; mi < 4; ++mi)
#pragma unroll
        for (int ni = 0; ni < 2; ++ni)
#pragma unroll
          for (int j = 0; j < 4; ++j) y[mi][ni][j] += sigmoidf_(g[mi][ni][j]) * b[mi][ni][j];
    }
#pragma unroll
    for (int mi = 0; mi < 4; ++mi)
#pragma unroll
      for (int ni = 0; ni < 2; ++ni)
        *(uint2*)(YM + (size_t)(m0 + wm * 64 + mi * 16 + l15) * 1024 + n0 + wn * 32 + ni * 16 + quad * 4) =
            make_uint2(pack2(y[mi][ni][0], y[mi][ni][1]), pack2(y[mi][ni][2], y[mi][ni][3]));
  }
}

__device__ void transpose64(const u16* __restrict__ src, int lds_, u16* __restrict__ dst, int ldd, u16* tile, const int tid) {
  {
    const int r = tid >> 2, c = (tid & 3) * 16;
    uint4 a = *(const uint4*)(src + (size_t)r * lds_ + c);
    uint4 b = *(const uint4*)(src + (size_t)r * lds_ + c + 8);
    uint32_t* t32 = (uint32_t*)(tile + r * 66 + c);
    t32[0] = a.x; t32[1] = a.y; t32[2] = a.z; t32[3] = a.w; t32[4] = b.x; t32[5] = b.y; t32[6] = b.z; t32[7] = b.w;
  }
  __syncthreads();
  {
    const int d = tid >> 2, tc = (tid & 3) * 16;
    uint32_t w[8];
#pragma unroll
    for (int i = 0; i < 8; ++i) w[i] = (uint32_t)tile[(tc + 2 * i) * 66 + d] | ((uint32_t)tile[(tc + 2 * i + 1) * 66 + d] << 16);
    uint4* o = (uint4*)(dst + (size_t)d * ldd + tc);
    o[0] = make_uint4(w[0], w[1], w[2], w[3]);
    o[1] = make_uint4(w[4], w[5], w[6], w[7]);
  }
  __syncthreads();
}

__device__ void phase_prep(const Params& p, int l, u16* sm) {
  const int tid = otid();
  const int lane = tid & 63, wave = tid >> 6;
  u16* P = (u16*)(p.ws + OFF_P);
  u16* KA = (u16*)(p.ws + OFF_KA);
  u16* VtA = (u16*)(p.ws + OFF_VTA);
  u16* KB = (u16*)(p.ws + OFF_KB);
  u16* VtD = (u16*)(p.ws + OFF_VTD);
  u16* GL = (u16*)(p.ws + OFF_GL);
  const float* ropeA = (const float*)(p.ws + OFF_ROPE);
  const float* ropeB = ropeA + 64 * 16 * 2;
  const float aqg = p.in[9][l * 64 + lane], akg = p.in[10][l * 64 + lane];
  const float* bqg = p.in[11] + l * 384;
  const float* bkvg = p.in[12] + l * 256;
  const float* mu = p.in[15] + l * 1920;
  for (int tok = blockIdx.x * 4 + wave; tok < TC; tok += gridDim.x * 4) {
    const int bl = tok / TL, j = tok - bl * TL;
    const bool islat = j >= 256;
    const int jj = j - 256;
    const int grow = (jj >> 6) & 31, gcol = jj & 63;
    u16* pr = P + (size_t)tok * NP;
    float ca = 1.f, sa = 0.f;
    if (islat) {
      int pos = (lane < 32) ? grow : gcol;
      ca = ropeA[(pos * 16 + (lane & 15)) * 2];
      sa = ropeA[(pos * 16 + (lane & 15)) * 2 + 1];
    }
    for (int h = 0; h < 10; ++h) {
      float x = bf2f(pr[h * 64 + lane]);
      float ss = wave_sum(x * x);
      float y = x * rsqrtf(ss * (1.f / 64.f) + 1e-6f) * (h < 8 ? aqg : akg);
      float yp = __shfl_xor(y, 16);
      float o = ((lane & 16) == 0) ? (y * ca - yp * sa) : (yp * sa + y * ca);
      if (h < 8) pr[h * 64 + lane] = f2bf(o);
      else KA[((size_t)(bl * 2 + (h - 8)) * TL + j) * 64 + lane] = f2bf(o);
    }
    {
      float x[6], ss = 0.f;
#pragma unroll
      for (int i = 0; i < 6; ++i) { x[i] = bf2f(pr[PB_CQ + lane + 64 * i]); ss += x[i] * x[i]; }
      ss = wave_sum(ss);
      float rs = rsqrtf(ss * (1.f / 384.f) + 1e-6f);
#pragma unroll
      for (int i = 0; i < 6; ++i) pr[PB_CQ + lane + 64 * i] = f2bf(x[i] * rs * bqg[lane + 64 * i]);
    }
    {
      float x[4], ss = 0.f;
#pragma unroll
      for (int i = 0; i < 4; ++i) { x[i] = bf2f(pr[PB_CKV + lane + 64 * i]); ss += x[i] * x[i]; }
      ss = wave_sum(ss);
      float rs = rsqrtf(ss * (1.f / 256.f) + 1e-6f);
#pragma unroll
      for (int i = 0; i < 4; ++i) pr[PB_CKV + lane + 64 * i] = f2bf(x[i] * rs * bkvg[lane + 64 * i]);
    }
    {
      float x = bf2f(pr[PB_KR + (lane & 31)]);
      float xp = __shfl_xor(x, 8);
      float o = x;
      if (islat) {
        int pos = ((lane & 31) < 16) ? grow : gcol;
        float c = ropeB[(pos * 8 + (lane & 7)) * 2], s = ropeB[(pos * 8 + (lane & 7)) * 2 + 1];
        o = ((lane & 8) == 0) ? (x * c - xp * s) : (xp * s + x * c);
      }
      if (lane < 32) {
        u16 ob = f2bf(o);
#pragma unroll
        for (int h = 0; h < 8; ++h) KB[((size_t)(bl * 8 + h) * TL + j) * 96 + 64 + lane] = ob;
      }
    }
    {
      const bool hasp = islat ? (jj > 0) : (j > 0);
      const bool hasn = islat ? (jj < 2047) : (j < 255);
#pragma unroll
      for (int i = 0; i < 2; ++i) {
        int c = lane + 64 * i;
        float cur = bf2f(pr[PC_GLO + c]);
        float pv = hasp ? bf2f(pr[PC_GLO + c - NP]) : 0.f;
        float nv = hasn ? bf2f(pr[PC_GLO + c + NP]) : 0.f;
        float z = cur + (0.5f * (pv + nv) - cur) * mu[1792 + c];
        GL[(size_t)tok * 128 + c] = f2bf(sigmoidf_(z));
      }
    }
  }
  for (int it = blockIdx.x; it < (TC / 64) * 10; it += gridDim.x) {
    int tg = it / 10, hh = it - tg * 10;
    int tok0 = tg * 64, bl = tok0 / TL, j0 = tok0 - bl * TL;
    if (hh < 2) transpose64(P + (size_t)tok0 * NP + PA_V + hh * 64, NP, VtA + ((size_t)(bl * 2 + hh) * 64) * TL + j0, TL, sm, tid);
    else transpose64(P + (size_t)tok0 * NP + PD_V + (hh - 2) * 64, NP, VtD + ((size_t)(bl * 8 + hh - 2) * 64) * TL + j0, TL, sm, tid);
  }
}

template <int DQK, int NQ, int MODE>
__device__ void flash_item(const u16* __restrict__ Qp, int ldq, const u16* __restrict__ Kp, int ldk, const u16* __restrict__ Vtp,
                           int ntiles, u16* __restrict__ Op, int ldo, float scale, bool ropeq, int qtok0,
                           const float* __restrict__ ropeB, int nat_r, const float* __restrict__ bias_g, unsigned char* smem, const int tid, const int abl) {
  constexpr int KS = DQK / 32;
  constexpr int DCH = DQK / 8;
  constexpr int KB_ = 64 * DQK * 2;
  constexpr int SBF = KB_ + 8192;
  constexpr int NS = (DQK == 64) ? 4 : 3;
  constexpr int LK = (64 * DCH) / 256, LPT = LK + 2;
  float* sBias = (float*)(smem + NS * SBF);
  const int lane = tid & 63, wave = tid >> 6, l15 = lane & 15, quad = lane >> 4;
  const float L2E = 1.4426950408889634f;
  int r0 = 0;
  if (MODE == 1) {
    r0 = min(max(nat_r - 4, 0), 24);
    for (int i = tid; i < 15 * 31; i += 256) sBias[i] = bias_g[i];
  }
  bf16x8 qf[NQ][KS];
#pragma unroll
  for (int qi = 0; qi < NQ; ++qi) {
    const int row = wave * 16 * NQ + qi * 16 + l15;
#pragma unroll
    for (int ks = 0; ks < KS; ++ks) qf[qi][ks] = *(const bf16x8*)(Qp + (size_t)row * ldq + ks * 32 + quad * 8);
    if (DQK == 96 && ropeq) {
      bf16x8 own = qf[qi][KS - 1];
      bf16x8 par = *(const bf16x8*)(Qp + (size_t)row * ldq + 64 + (quad ^ 1) * 8);
      const int qt = qtok0 + row;
      const int pos = (quad < 2) ? ((qt >> 6) & 31) : (qt & 63);
      bf16x8 res;
#pragma unroll
      for (int i = 0; i < 8; ++i) {
        float c = ropeB[(pos * 8 + i) * 2], s = ropeB[(pos * 8 + i) * 2 + 1];
        float xo = bf2f((u16)own[i]), xp = bf2f((u16)par[i]);
        float o = ((quad & 1) == 0) ? (xo * c - xp * s) : (xp * s + xo * c);
        res[i] = (short)f2bf(o);
      }
      qf[qi][KS - 1] = res;
    }
  }
  auto koff = [&](int t) -> int { return (MODE == 1) ? ((t < 8) ? (256 + (r0 + t) * 64) : ((t - 8) * 64)) : t * 64; };
  unsigned char* dstw = smem + (tid & ~63) * 16;
  auto issue = [&](int t, int buf) {
    const int ko = koff(t);
#pragma unroll
    for (int i = 0; i < LK; ++i) {
      const int L = tid + 256 * i;
      int row, c;
      if (DQK == 64) { row = L >> 3; c = (L & 7) ^ (row & 7); }
      else { row = L / 12; const int pp = L - row * 12; c = (pp & ~3) | ((pp & 3) ^ ((0x1230 >> (((row >> 2) & 3) * 4)) & 3)); }
      __builtin_amdgcn_global_load_lds((const unsigned*)(Kp + (size_t)(ko + row) * ldk + c * 8), (unsigned*)(dstw + buf * SBF + i * 4096), 16, 0, 0);
    }
#pragma unroll
    for (int i = 0; i < 2; ++i) {
      const int L = tid + 256 * i;
      const int d = L >> 3, c = (L & 7) ^ (d & 7);
      __builtin_amdgcn_global_load_lds((const unsigned*)(Vtp + (size_t)d * TL + ko + c * 8), (unsigned*)(dstw + buf * SBF + KB_ + i * 4096), 16, 0, 0);
    }
  };
  int koffs[KS];
#pragma unroll
  for (int ks = 0; ks < KS; ++ks) {
    const int c = ks * 4 + quad;
    if (DQK == 64) koffs[ks] = l15 * 128 + ((c ^ (l15 & 7)) * 16);
    else koffs[ks] = l15 * 192 + (((c & ~3) | ((c & 3) ^ ((0x1230 >> ((l15 >> 2) * 4)) & 3))) * 16);
  }
  int voffs[2][2];
#pragma unroll
  for (int kk = 0; kk < 2; ++kk)
#pragma unroll
    for (int ab = 0; ab < 2; ++ab) {
      const int keyb = ((2 * kk + ab) * 16 + quad * 4) * 2;
      const int c = keyb >> 4;
      voffs[kk][ab] = l15 * 128 + ((c ^ (l15 & 7)) * 16) + (keyb & 15);
    }
  f32x4 o[4][NQ];
  float m[NQ], lsum[NQ];
#pragma unroll
  for (int qi = 0; qi < NQ; ++qi) {
    m[qi] = -INFINITY; lsum[qi] = 0.f;
#pragma unroll
    for (int dt = 0; dt < 4; ++dt) o[dt][qi] = (f32x4){0.f, 0.f, 0.f, 0.f};
  }
  const int qc = wave * 16 + l15;
  const int st = min(max(qc - 8, 0), 48);
  GEMM_WAIT_VM(0);
#pragma unroll
  for (int s_ = 0; s_ < NS - 1; ++s_)
    if (s_ < ntiles) issue(s_, s_);
  int buf = 0;
  for (int t = 0; t < ntiles; ++t) {
    if (!(abl & 4)) {
      const int rem = ntiles - 1 - t;
      if (NS == 4) {
        if (rem >= 2) GEMM_WAIT_VM(8); else if (rem == 1) GEMM_WAIT_VM(4); else GEMM_WAIT_VM(0);
      } else {
        if (rem >= 1) GEMM_WAIT_VM(5); else GEMM_WAIT_VM(0);
      }
    }
    if (!(abl & 8)) raw_barrier();
    if (!(abl & 4) && t + NS - 1 < ntiles) { int nb = buf + NS - 1; if (nb >= NS) nb -= NS; issue(t + NS - 1, nb); }
    const unsigned char* k_s = smem + buf * SBF;
    const unsigned char* v_s = k_s + KB_;
    f32x4 s[4][NQ];
    {
      bf16x8 kf[4][KS];
#pragma unroll
      for (int kt = 0; kt < 4; ++kt)
#pragma unroll
        for (int ks = 0; ks < KS; ++ks) kf[kt][ks] = *(const bf16x8*)(k_s + kt * 16 * DQK * 2 + koffs[ks]);
      __builtin_amdgcn_sched_barrier(0);
#pragma unroll
      for (int kt = 0; kt < 4; ++kt) {
#pragma unroll
        for (int qi = 0; qi < NQ; ++qi) s[kt][qi] = (f32x4){0.f, 0.f, 0.f, 0.f};
#pragma unroll
        for (int ks = 0; ks < KS; ++ks)
#pragma unroll
          for (int qi = 0; qi < NQ; ++qi) s[kt][qi] = __builtin_amdgcn_mfma_f32_16x16x32_bf16(kf[kt][ks], qf[qi][ks], s[kt][qi], 0, 0, 0);
      }
    }
    uint2 vfa[2][4], vfb[2][4];
#pragma unroll
    for (int kk = 0; kk < 2; ++kk)
#pragma unroll
      for (int dt = 0; dt < 4; ++dt) {
        vfa[kk][dt] = *(const uint2*)(v_s + dt * 2048 + voffs[kk][0]);
        vfb[kk][dt] = *(const uint2*)(v_s + dt * 2048 + voffs[kk][1]);
      }
    __builtin_amdgcn_sched_barrier(0);
    const float c2 = scale * L2E;
    if (MODE == 1 && t < 8) {
      const int drow = r0 + t - nat_r + 7;
#pragma unroll
      for (int kt = 0; kt < 4; ++kt)
#pragma unroll
        for (int j = 0; j < 4; ++j) {
          int kc = kt * 16 + quad * 4 + j;
          bool valid = (kc >= st) && (kc < st + 16);
          int bi = drow * 31 + (kc - qc + 15);
          bi = valid ? bi : 0;
          float bv = sBias[bi];
          s[kt][0][j] = valid ? (s[kt][0][j] * c2 + bv * L2E) : -INFINITY;
        }
    }
    const bool pre = (MODE == 1 && t < 8);
    bf16x8 pb[NQ][2];
    if (abl & 1) {
#pragma unroll
      for (int qi = 0; qi < NQ; ++qi)
#pragma unroll
        for (int kk = 0; kk < 2; ++kk) {
          uint4 u = make_uint4(pack2(s[2 * kk][qi][0], s[2 * kk][qi][1]), pack2(s[2 * kk][qi][2], s[2 * kk][qi][3]),
                               pack2(s[2 * kk + 1][qi][0], s[2 * kk + 1][qi][1]), pack2(s[2 * kk + 1][qi][2], s[2 * kk + 1][qi][3]));
          pb[qi][kk] = __builtin_bit_cast(bf16x8, u);
        }
    } else
#pragma unroll
    for (int qi = 0; qi < NQ; ++qi) {
      float mx = fmaxf(fmaxf(s[0][qi][0], s[0][qi][1]), fmaxf(s[0][qi][2], s[0][qi][3]));
#pragma unroll
      for (int kt = 1; kt < 4; ++kt) mx = fmaxf(mx, fmaxf(fmaxf(s[kt][qi][0], s[kt][qi][1]), fmaxf(s[kt][qi][2], s[kt][qi][3])));
      mx = xq_max(mx);
      const float cc = pre ? 1.f : c2;
      const float mnew = fmaxf(m[qi], mx * cc);
      const float alpha = __builtin_amdgcn_exp2f(m[qi] - mnew);
      m[qi] = mnew;
      float ps = 0.f;
#pragma unroll
      for (int kt = 0; kt < 4; ++kt)
#pragma unroll
        for (int j = 0; j < 4; ++j) {
          float pv = __builtin_amdgcn_exp2f(s[kt][qi][j] * cc - mnew);
          s[kt][qi][j] = pv;
          ps += pv;
        }
      lsum[qi] = lsum[qi] * alpha + ps;
#pragma unroll
      for (int dt = 0; dt < 4; ++dt)
#pragma unroll
        for (int j = 0; j < 4; ++j) o[dt][qi][j] *= alpha;
#pragma unroll
      for (int kk = 0; kk < 2; ++kk) {
        uint4 u = make_uint4(pack2(s[2 * kk][qi][0], s[2 * kk][qi][1]), pack2(s[2 * kk][qi][2], s[2 * kk][qi][3]),
                             pack2(s[2 * kk + 1][qi][0], s[2 * kk + 1][qi][1]), pack2(s[2 * kk + 1][qi][2], s[2 * kk + 1][qi][3]));
        pb[qi][kk] = __builtin_bit_cast(bf16x8, u);
      }
    }
#pragma unroll
    for (int kk = 0; kk < 2; ++kk)
#pragma unroll
      for (int dt = 0; dt < 4; ++dt) {
        uint4 vv = make_uint4(vfa[kk][dt].x, vfa[kk][dt].y, vfb[kk][dt].x, vfb[kk][dt].y);
        bf16x8 av = __builtin_bit_cast(bf16x8, vv);
#pragma unroll
        for (int qi = 0; qi < NQ; ++qi) o[dt][qi] = __builtin_amdgcn_mfma_f32_16x16x32_bf16(av, pb[qi][kk], o[dt][qi], 0, 0, 0);
      }
    if (++buf == NS) buf = 0;
  }
  raw_barrier();
#pragma unroll
  for (int qi = 0; qi < NQ; ++qi) {
    float l = xq_sum(lsum[qi]);
    const float inv = 1.f / l;
    const int row = wave * 16 * NQ + qi * 16 + l15;
#pragma unroll
    for (int dt = 0; dt < 4; ++dt)
      *(uint2*)(Op + (size_t)row * ldo + dt * 16 + quad * 4) =
          make_uint2(pack2(o[dt][qi][0] * inv, o[dt][qi][1] * inv), pack2(o[dt][qi][2] * inv, o[dt][qi][3] * inv));
  }
}

__device__ void scan_item(const Params& p, int l, int bl, int h, int dir, int half, unsigned char* smem, const int tid, const int abl) {
  float* R = (float*)smem;
  float* V = R + 2048;
  float* KK = V + 2048;
  float* KD = KK + 2048;
  float* W = KD + 2048;
  float* T1 = W + 2048;
  float* Y = T1 + 2048;
  float* BONW = Y + 2048;
  u16* XW = (u16*)(BONW + 128);
  u16* XA = XW + 32 * 72;
  const int lane = tid & 63, wave = tid >> 6, l15 = lane & 15, quad = lane >> 4;
  const u16* P = (const u16*)(p.ws + OFF_P);
  u16* Yd = (u16*)(p.ws + (dir ? OFF_YB : OFF_YF));
  float* BON = (float*)(p.ws + OFF_BON);
  const u16* Wl = (const u16*)(p.ws + OFF_W) + (size_t)l * W_TOTAL;
  const float* mu = p.in[15] + l * 1920;
  const int nn = wave * 16 + l15;
  const float w0 = p.in[16][(l * 2 + dir) * 512 + h * 64 + nn];
  const float a0 = p.in[18][(l * 2 + dir) * 512 + h * 64 + nn];
  const float ka = p.in[22][l * 512 + h * 64 + nn];
  const float rk = p.in[23][l * 512 + h * 64 + nn];
  bf16x8 wdec[2], waaa[2];
#pragma unroll
  for (int ks = 0; ks < 2; ++ks) {
    wdec[ks] = *(const bf16x8*)(Wl + W_DEC + ((size_t)dir * 512 + h * 64 + nn) * 64 + ks * 32 + quad * 8);
    waaa[ks] = *(const bf16x8*)(Wl + W_AAA + ((size_t)dir * 512 + h * 64 + nn) * 64 + ks * 32 + quad * 8);
  }
  const int st_t = tid >> 3, part = tid & 7, n0 = part * 8;
  const int sl = lane & 7, srow = half * 32 + wave * 8 + (lane >> 3);
  v2f S2[4];
#pragma unroll
  for (int i = 0; i < 4; ++i) S2[i] = (v2f){0.f, 0.f};
  float* MU = (float*)(XA + 32 * 72);
  float* KKC = MU + 320;
  for (int i = tid; i < 384; i += 256) {
    int g = i >> 6, n = i & 63;
    float v;
    if (g == 0) v = mu[h * 64 + n];
    else if (g == 1) v = mu[1024 + h * 64 + n];
    else if (g == 2) v = mu[512 + h * 64 + n];
    else if (g == 3) v = mu[1536 + dir * 64 + n];
    else if (g == 4) v = mu[1664 + dir * 64 + n];
    else v = p.in[21][l * 512 + h * 64 + n];
    MU[i] = v;
  }
  uint4 raw[15];
  auto issue_raw = [&](int cidx) {
    const int seg = cidx >= 8;
    const int cc = seg ? cidx - 8 : cidx, nch = seg ? 64 : 8, len = seg ? 2048 : 256;
    const int tb = bl * TL + (seg ? 256 : 0);
    const int c = dir ? (nch - 1 - cc) : cc;
    const int pos = c * 32 + st_t;
    const bool hasp = pos > 0, hasn = pos < len - 1;
    const u16* rowp = P + (size_t)(tb + pos) * NP + n0;
    const int cols[5] = {PC_R + h * 64, PC_V + h * 64, PC_K + h * 64, PC_WLO + dir * 64, PC_ALO + dir * 64};
#pragma unroll
    for (int g = 0; g < 5; ++g) {
      raw[3 * g] = *(const uint4*)(rowp + cols[g]);
      raw[3 * g + 1] = make_uint4(0, 0, 0, 0);
      raw[3 * g + 2] = make_uint4(0, 0, 0, 0);
      if (hasp) raw[3 * g + 1] = *(const uint4*)(rowp + cols[g] - NP);
      if (hasn) raw[3 * g + 2] = *(const uint4*)(rowp + cols[g] + NP);
    }
  };
  issue_raw(0);
  __syncthreads();

  for (int cidx = 0; cidx < 72; ++cidx) {
    {
      const int seg = cidx >= 8;
      const int cc = seg ? cidx - 8 : cidx, nch = seg ? 64 : 8;
      const int tb = bl * TL + (seg ? 256 : 0);
      const int c = dir ? (nch - 1 - cc) : cc;
      const int pos0 = c * 32;
      {
#define SHIFT8(G, z)                                                                              \
  {                                                                                               \
    const uint4 c4 = raw[3 * (G)], p4 = raw[3 * (G) + 1], n4 = raw[3 * (G) + 2];                  \
    const float4 m0 = *(const float4*)(MU + (G)*64 + n0), m1 = *(const float4*)(MU + (G)*64 + n0 + 4); \
    const float mm[8] = {m0.x, m0.y, m0.z, m0.w, m1.x, m1.y, m1.z, m1.w};                          \
    const uint32_t cu[4] = {c4.x, c4.y, c4.z, c4.w}, pu[4] = {p4.x, p4.y, p4.z, p4.w}, nu[4] = {n4.x, n4.y, n4.z, n4.w}; \
    _Pragma("unroll") for (int i = 0; i < 4; ++i) {                                               \
      float c0 = lo2f(cu[i]), c1 = hi2f(cu[i]);                                                   \
      z[2 * i] = c0 + (0.5f * (lo2f(pu[i]) + lo2f(nu[i])) - c0) * mm[2 * i];                      \
      z[2 * i + 1] = c1 + (0.5f * (hi2f(pu[i]) + hi2f(nu[i])) - c1) * mm[2 * i + 1];              \
    }                                                                                             \
  }
        float z[8];
        SHIFT8(0, z);
        *(float4*)(R + st_t * 64 + n0) = make_float4(z[0], z[1], z[2], z[3]);
        *(float4*)(R + st_t * 64 + n0 + 4) = make_float4(z[4], z[5], z[6], z[7]);
        SHIFT8(1, z);
        *(float4*)(V + st_t * 64 + n0) = make_float4(z[0], z[1], z[2], z[3]);
        *(float4*)(V + st_t * 64 + n0 + 4) = make_float4(z[4], z[5], z[6], z[7]);
        SHIFT8(2, z);
        {
          const float4 k0 = *(const float4*)(KKC + n0), k1 = *(const float4*)(KKC + n0 + 4);
          const float kc[8] = {k0.x, k0.y, k0.z, k0.w, k1.x, k1.y, k1.z, k1.w};
          float q[8], ss = 0.f;
#pragma unroll
          for (int i = 0; i < 8; ++i) { q[i] = z[i] * kc[i]; ss += q[i] * q[i]; }
          *(float4*)(KD + st_t * 64 + n0) = make_float4(z[0], z[1], z[2], z[3]);
          *(float4*)(KD + st_t * 64 + n0 + 4) = make_float4(z[4], z[5], z[6], z[7]);
          ss = row8_sum(ss);
          const float inv = 1.f / fmaxf(sqrtf(ss), 1e-12f);
          *(float4*)(KK + st_t * 64 + n0) = make_float4(q[0] * inv, q[1] * inv, q[2] * inv, q[3] * inv);
          *(float4*)(KK + st_t * 64 + n0 + 4) = make_float4(q[4] * inv, q[5] * inv, q[6] * inv, q[7] * inv);
        }
        SHIFT8(3, z);
        {
          float th[8];
#pragma unroll
          for (int i = 0; i < 8; ++i) th[i] = 1.f - 2.f / (1.f + __expf(2.f * z[i]));
          *(uint4*)(XW + st_t * 72 + n0) = make_uint4(pack2(th[0], th[1]), pack2(th[2], th[3]), pack2(th[4], th[5]), pack2(th[6], th[7]));
        }
        SHIFT8(4, z);
        *(uint4*)(XA + st_t * 72 + n0) = make_uint4(pack2(z[0], z[1]), pack2(z[2], z[3]), pack2(z[4], z[5]), pack2(z[6], z[7]));
#undef SHIFT8
      }
      raw_barrier();
#pragma unroll
      for (int mt = 0; mt < 2; ++mt) {
        f32x4 aw = (f32x4){0.f, 0.f, 0.f, 0.f}, aa = (f32x4){0.f, 0.f, 0.f, 0.f};
#pragma unroll
        for (int ks = 0; ks < 2; ++ks) {
          bf16x8 xw = *(const bf16x8*)(XW + (mt * 16 + l15) * 72 + ks * 32 + quad * 8);
          bf16x8 xa = *(const bf16x8*)(XA + (mt * 16 + l15) * 72 + ks * 32 + quad * 8);
          aw = __builtin_amdgcn_mfma_f32_16x16x32_bf16(xw, wdec[ks], aw, 0, 0, 0);
          aa = __builtin_amdgcn_mfma_f32_16x16x32_bf16(xa, waaa[ks], aa, 0, 0, 0);
        }
#pragma unroll
        for (int j = 0; j < 4; ++j) {
          const int t = mt * 16 + quad * 4 + j;
          const float wv = __expf(-0.6065306597126334f / (1.f + __expf(-(w0 + aw[j]))));
          const float av = 1.f / (1.f + __expf(-(a0 + aa[j])));
          W[t * 64 + nn] = wv;
          T1[t * 64 + nn] = KK[t * 64 + nn] * av;
          const float kd = KD[t * 64 + nn] * (1.f + (av - 1.f) * ka);
          KD[t * 64 + nn] = kd;
          const float bon = row16_sum(R[t * 64 + nn] * kd * rk);
          if (l15 == 0) BONW[wave * 32 + t] = bon;
        }
      }
      if (cidx + 1 < 72) issue_raw(cidx + 1);
      raw_barrier();
      {
        float4 Akk0, Akk1, At0, At1, Ad0, Ad1, Aw0, Aw1, Ar0, Ar1, Bkk0, Bkk1, Bt0, Bt1, Bd0, Bd1, Bw0, Bw1, Br0, Br1;
        float Av, Bv;
#define SCAN_LOAD(X, I)                                                  \
  {                                                                      \
    const int o_ = (I) * 64 + sl * 8;                                    \
    X##kk0 = *(const float4*)(KK + o_); X##kk1 = *(const float4*)(KK + o_ + 4); \
    X##t0 = *(const float4*)(T1 + o_);  X##t1 = *(const float4*)(T1 + o_ + 4);  \
    X##d0 = *(const float4*)(KD + o_);  X##d1 = *(const float4*)(KD + o_ + 4);  \
    X##w0 = *(const float4*)(W + o_);   X##w1 = *(const float4*)(W + o_ + 4);   \
    X##r0 = *(const float4*)(R + o_);   X##r1 = *(const float4*)(R + o_ + 4);   \
    X##v = V[(I) * 64 + srow];                                           \
  }
#define SCAN_EL(C, KDv, T1v, Wv, Rv)                                      \
  {                                                                      \
    const v2f kd_ = KDv, t1_ = T1v, w_ = Wv, r_ = Rv;                    \
    S2[C] = S2[C] * w_ + (vv0 * kd_ + nsa0 * t1_);                       \
    if ((C) & 1) y1 += S2[C] * r_; else y0 += S2[C] * r_;                \
  }
#define SCAN_STEP(X, I)                                                  \
  {                                                                      \
    const v2f k0 = (v2f){X##kk0.x, X##kk0.y}, k1 = (v2f){X##kk0.z, X##kk0.w}, k2 = (v2f){X##kk1.x, X##kk1.y}, k3 = (v2f){X##kk1.z, X##kk1.w}; \
    v2f a0 = S2[0] * k0, a0b = S2[1] * k1;                               \
    a0 += S2[2] * k2; a0b += S2[3] * k3;                                 \
    a0 += a0b;                                                           \
    const float sa0 = row8_sum(a0.x + a0.y);                             \
    const v2f vv0 = (v2f){X##v, X##v}, nsa0 = (v2f){-sa0, -sa0};         \
    v2f y0 = (v2f){0.f, 0.f}, y1 = (v2f){0.f, 0.f};                      \
    SCAN_EL(0, ((v2f){X##d0.x, X##d0.y}), ((v2f){X##t0.x, X##t0.y}), ((v2f){X##w0.x, X##w0.y}), ((v2f){X##r0.x, X##r0.y})) \
    SCAN_EL(1, ((v2f){X##d0.z, X##d0.w}), ((v2f){X##t0.z, X##t0.w}), ((v2f){X##w0.z, X##w0.w}), ((v2f){X##r0.z, X##r0.w})) \
    SCAN_EL(2, ((v2f){X##d1.x, X##d1.y}), ((v2f){X##t1.x, X##t1.y}), ((v2f){X##w1.x, X##w1.y}), ((v2f){X##r1.x, X##r1.y})) \
    SCAN_EL(3, ((v2f){X##d1.z, X##d1.w}), ((v2f){X##t1.z, X##t1.w}), ((v2f){X##w1.z, X##w1.w}), ((v2f){X##r1.z, X##r1.w})) \
    y0 += y1;                                                            \
    const float ys0 = row8_sum(y0.x + y0.y);                             \
    if (sl == 0) Y[(I) * 64 + srow] = ys0;                               \
  }
        SCAN_LOAD(A, dir ? 31 : 0);
        for (int s = 0; s < ((abl & 32) ? 0 : 32); s += 2) {
          const int i0 = dir ? (31 - s) : s, i1 = dir ? (30 - s) : (s + 1);
          SCAN_LOAD(B, i1);
          SCAN_STEP(A, i0);
          if (s + 2 < 32) { SCAN_LOAD(A, dir ? (29 - s) : (s + 2)); }
          SCAN_STEP(B, i1);
        }
#undef SCAN_LOAD
#undef SCAN_EL
#undef SCAN_STEP
      }
      raw_barrier();
      {
        const float* yp = Y + st_t * 64 + half * 32 + part * 4;
        const size_t tok = (size_t)(tb + pos0 + st_t);
        *(uint2*)(Yd + tok * 512 + h * 64 + half * 32 + part * 4) = make_uint2(pack2(yp[0], yp[1]), pack2(yp[2], yp[3]));
        if (part == 0 && half == 0) BON[tok * 16 + h * 2 + dir] = BONW[st_t] + BONW[32 + st_t] + BONW[64 + st_t] + BONW[96 + st_t];
      }
    }
  }
  __syncthreads();
}

__device__ void phase_mixers(const Params& p, int chunk, int l, bool with_ctx, int* counter, unsigned char* smem, u16* dum, int kmask) {
  int& s_item = *(int*)(smem + SMEM_BYTES + 16);
  u16* sm = (u16*)smem;
  u16* P = (u16*)(p.ws + OFF_P);
  const u16* KA = (const u16*)(p.ws + OFF_KA);
  const u16* VtA = (const u16*)(p.ws + OFF_VTA);
  const u16* QB = (const u16*)(p.ws + OFF_QB);
  const u16* KB = (const u16*)(p.ws + OFF_KB);
  const u16* VtB = (const u16*)(p.ws + OFF_VTB);
  const u16* VtD = (const u16*)(p.ws + OFF_VTD);
  const float* ropeB = (const float*)(p.ws + OFF_ROPE) + 64 * 16 * 2;
  const int n_scan = BC * 8 * 2 * 2;
  const int n_al = BC * 8 * 16;
  const int n_nat = BC * 8 * 32;
  const int n_cx = BC * 8 * 2;
  const int total = n_scan + 2 * n_al + n_nat + (with_ctx ? 3 * n_cx : 0);
  const float scaleB = 0.10206207261596575f;
  while (true) {
    const int tid = otid();
    if (tid == 0) s_item = atomicAdd(counter, 1);
    __syncthreads();
    int it = s_item;
    __syncthreads();
    if (it >= total) break;
    if (it < n_scan) {
      if (!(kmask & 1)) continue;
      int half = it & 1, dir = (it >> 1) & 1, h = (it >> 2) & 7, bl = it >> 5;
      __builtin_amdgcn_s_setprio(3);
      scan_item(p, l, bl, h, dir, half, smem, otid(), dum ? PR_ABL : 0);
      __builtin_amdgcn_s_setprio(0);
      continue;
    }
    it -= n_scan;
    int kind, h, bl, ntl;
    size_t tok0;
    bool rq = false;
    int qtok0 = 0, natr = 0;
    if (it < 2 * n_al) {
      kind = (it >= n_al) ? 1 : 0;
      int i2 = it - kind * n_al;
      int qt = i2 & 15; h = (i2 >> 4) & 7; bl = i2 >> 7;
      tok0 = (size_t)bl * TL + 256 + qt * 128; ntl = 36; rq = true; qtok0 = qt * 128;
    } else if (it < 2 * n_al + n_nat) {
      int i2 = it - 2 * n_al;
      kind = 3; natr = i2 & 31; h = (i2 >> 5) & 7; bl = i2 >> 8;
      tok0 = (size_t)bl * TL + 256 + natr * 64; ntl = 12;
    } else {
      int i2 = it - 2 * n_al - n_nat;
      kind = i2 / n_cx; i2 -= kind * n_cx;
      int qt = i2 & 1; h = (i2 >> 1) & 7; bl = i2 >> 4;
      tok0 = (size_t)bl * TL + qt * 128; ntl = 4;
    }
    {
      const int cls = (ntl == 36) ? (kind == 0 ? 2 : 4) : (ntl == 12 ? 8 : 16);
      if (!(kmask & cls)) continue;
    }
    if (kind == 1) {
      flash_item<96, 2, 0>(QB + tok0 * 768 + h * 96, 768, KB + (size_t)(bl * 8 + h) * TL * 96, 96, VtB + (size_t)(bl * 8 + h) * 64 * TL,
                           ntl, dum ? (dum + tok0 * 1536 + 512 + h * 64) : (P + tok0 * NP + O_B + h * 64), dum ? 1536 : NP, scaleB, rq, qtok0, ropeB, 0, nullptr, smem, otid(), dum ? PR_ABL : 0);
    } else if (kind == 3) {
      u16* q = P + tok0 * NP + PD_Q + h * 64;
      flash_item<64, 1, 1>(q, NP, P + (size_t)bl * TL * NP + PD_K + h * 64, NP, VtD + (size_t)(bl * 8 + h) * 64 * TL, ntl, dum ? (dum + tok0 * 1536 + 1024 + h * 64) : q, dum ? 1536 : NP, 0.125f,
                           false, 0, ropeB, natr, p.in[26] + (size_t)(l * 8 + h) * 15 * 31, smem, otid(), dum ? PR_ABL : 0);
    } else {
      u16* q = P + tok0 * NP + (kind == 0 ? PA_Q : PD_Q) + h * 64;
      const u16* kp = (kind == 0) ? (KA + (size_t)(bl * 2 + (h >> 2)) * TL * 64) : (P + (size_t)bl * TL * NP + PD_K + h * 64);
      const u16* vp = (kind == 0) ? (VtA + (size_t)(bl * 2 + (h >> 2)) * 64 * TL) : (VtD + (size_t)(bl * 8 + h) * 64 * TL);
      flash_item<64, 2, 0>(q, NP, kp, (kind == 0) ? 64 : NP, vp, ntl, dum ? (dum + tok0 * 1536 + (kind == 0 ? 0 : 1024) + h * 64) : q, dum ? 1536 : NP, 0.125f, false, 0, ropeB, 0, nullptr, smem, otid(), dum ? PR_ABL : 0);
    }
  }
}

__device__ void phase_cout(const Params& p, int l, bool latonly) {
  const int tid = otid();
  const int lane = tid & 63, wave = tid >> 6;
  u16* P = (u16*)(p.ws + OFF_P);
  const u16* YF = (const u16*)(p.ws + OFF_YF);
  const u16* YB = (const u16*)(p.ws + OFF_YB);
  const u16* G = (const u16*)(p.ws + OFF_G);
  const float* BON = (const float*)(p.ws + OFF_BON);
  const float* gnw = p.in[24] + l * 512;
  const float* gnb = p.in[25] + l * 512;
  const float* mu = p.in[15] + l * 1920 + 1024;
  for (int tok = blockIdx.x * 4 + wave; tok < TC; tok += gridDim.x * 4) {
    const int bl = tok / TL, j = tok - bl * TL;
    const bool islat = j >= 256;
    if (latonly && !islat) continue;
    const int jj = j - 256;
    const bool hasp = islat ? (jj > 0) : (j > 0);
    const bool hasn = islat ? (jj < 2047) : (j < 255);
    u16* pr = P + (size_t)tok * NP;
    for (int h = 0; h < 8; ++h) {
      const int col = h * 64 + lane;
      float y = bf2f(YF[(size_t)tok * 512 + col]) + bf2f(YB[(size_t)tok * 512 + col]);
      float mean = wave_sum(y) * (1.f / 64.f);
      float d = y - mean;
      float var = wave_sum(d * d) * (1.f / 64.f);
      float yn = d * rsqrtf(var + 64e-5f) * gnw[col] + gnb[col];
      float vc = bf2f(pr[PC_V + col]);
      float vp = hasp ? bf2f(pr[PC_V + col - NP]) : 0.f;
      float vn = hasn ? bf2f(pr[PC_V + col + NP]) : 0.f;
      float vs = vc + (0.5f * (vp + vn) - vc) * mu[col];
      float bon = BON[(size_t)tok * 16 + h * 2] + BON[(size_t)tok * 16 + h * 2 + 1];
      float oc = (yn + bon * vs) * bf2f(G[(size_t)tok * 512 + col]);
      pr[O_C + col] = f2bf(oc);
    }
  }
}

#ifndef PR_GEMM1
#define PR_GEMM1 0
#endif
#ifndef PR_MERGE
#define PR_MERGE 0
#endif
#ifndef PR_KIND
#define PR_KIND -1
#endif
__device__ void phase_probe(const Params& p, int l, int kind, unsigned char* smem) {
  u16* sm = (u16*)smem;
  u16* P = (u16*)(p.ws + OFF_P);
  u16* DUM = (u16*)(p.ws + OFF_YM);
  const float* ropeB = (const float*)(p.ws + OFF_ROPE) + 64 * 16 * 2;
  const int total = (kind == 0) ? 128 : (kind == 3 ? 2048 : 1024);
  for (int it = blockIdx.x; it < total; it += gridDim.x) {
    if (kind == 0) {
      int dir = it & 1, h = (it >> 1) & 7, bl = it >> 4;
      scan_item(p, l, bl, h, dir, 0, smem, otid(), 0);
      scan_item(p, l, bl, h, dir, 1, smem, otid(), 0);
    } else if (kind == 1) {
      int qt = it & 15, h = (it >> 4) & 7, bl = it >> 7;
      size_t tok0 = (size_t)bl * TL + 256 + qt * 128;
      flash_item<64, 2, 0>(P + tok0 * NP + PA_Q + h * 64, NP, (const u16*)(p.ws + OFF_KA) + (size_t)(bl * 2 + (h >> 2)) * TL * 64, 64,
                           (const u16*)(p.ws + OFF_VTA) + (size_t)(bl * 2 + (h >> 2)) * 64 * TL, 36, DUM + tok0 * 1024 + h * 64, 1024,
                           0.125f, false, 0, ropeB, 0, nullptr, smem, otid(), 0);
    } else if (kind == 2) {
      int qt = it & 15, h = (it >> 4) & 7, bl = it >> 7;
      size_t tok0 = (size_t)bl * TL + 256 + qt * 128;
      flash_item<96, 2, 0>((const u16*)(p.ws + OFF_QB) + tok0 * 768 + h * 96, 768, (const u16*)(p.ws + OFF_KB) + (size_t)(bl * 8 + h) * TL * 96,
                           96, (const u16*)(p.ws + OFF_VTB) + (size_t)(bl * 8 + h) * 64 * TL, 36, P + tok0 * NP + O_B + h * 64, NP,
                           0.10206207261596575f, true, qt * 128, ropeB, 0, nullptr, smem, otid(), 0);
    } else {
      int r = it & 31, h = (it >> 5) & 7, bl = it >> 8;
      size_t tok0 = (size_t)bl * TL + 256 + r * 64;
      flash_item<64, 1, 1>(P + tok0 * NP + PD_Q + h * 64, NP, P + (size_t)bl * TL * NP + PD_K + h * 64, NP,
                           (const u16*)(p.ws + OFF_VTD) + (size_t)(bl * 8 + h) * 64 * TL, 12, DUM + tok0 * 1024 + h * 64, 1024, 0.125f,
                           false, 0, ropeB, r, p.in[26] + (size_t)(l * 8 + h) * 15 * 31, smem, otid(), 0);
    }
  }
}

#define XB_TMO      128
#define XB_XCNT(j)  (256  + 64 * (j))
#define XB_XSUB(j)  (1280 + 64 * (j))
#define XB_XGEN(j)  (2304 + 64 * (j))
#define XB_TOP      3328
#define XB_TOPGEN   3392
#define XCD_BAR_WORDS 3456
#define XB_SPIN_CAP (1u << 18)
#define LAS __attribute__((address_space(3)))
DI unsigned xb_ld(unsigned* p) { return __hip_atomic_load(p, __ATOMIC_RELAXED, __HIP_MEMORY_SCOPE_AGENT); }
DI unsigned xb_add(unsigned* p, unsigned v) { return __hip_atomic_fetch_add(p, v, __ATOMIC_RELAXED, __HIP_MEMORY_SCOPE_AGENT); }
DI unsigned xb_xcc_id() { return (unsigned)__builtin_amdgcn_s_getreg((3 << 11) | 20) & 0xFu; }
#define XB_SPIN(cond, bar) do { unsigned _sp = 0; while (cond) { __builtin_amdgcn_s_sleep(1); \
    if ((++_sp & 255u) == 0u) { if (xb_ld(&(bar)[XB_TMO])) break; if (_sp > XB_SPIN_CAP) { atomicAdd(&(bar)[XB_TMO], 1u); break; } } } } while (0)
struct XcdBarrier { unsigned* bar; unsigned x; volatile LAS unsigned* st; };
DI XcdBarrier xcd_barrier_post(unsigned* bar, volatile LAS unsigned* st) {
  XcdBarrier b; b.bar = bar; b.x = xb_xcc_id(); b.st = st;
  if (threadIdx.x == 0) (void)xb_add(&bar[XB_XCNT(b.x)], 1u);
  return b;
}
DI void xcd_barrier_complete(unsigned* bar, unsigned x, unsigned& nloc, unsigned& nx) {
  const unsigned G = gridDim.x * gridDim.y * gridDim.z;
  unsigned sum, cnt, mine, sp = 0u;
  for (;;) {
    sum = 0u; cnt = 0u; mine = 0u;
#pragma unroll
    for (unsigned j = 0; j < 16; ++j) { const unsigned c = xb_ld(&bar[XB_XCNT(j)]); sum += c; cnt += (c > 0u) ? 1u : 0u; mine = (j == x) ? c : mine; }
    if (sum == G) break;
    __builtin_amdgcn_s_sleep(1);
    if ((++sp & 255u) == 0u) { if (xb_ld(&bar[XB_TMO])) break; if (sp > XB_SPIN_CAP) { atomicAdd(&bar[XB_TMO], 1u); break; } }
  }
  nloc = mine > 0u ? mine : 1u; nx = cnt > 0u ? cnt : 1u;
}
DI void xcd_barrier(const XcdBarrier& b) {
  asm volatile("s_waitcnt vmcnt(0)" ::: "memory");
  __syncthreads();
  if (threadIdx.x == 0) {
    unsigned* bar = b.bar;
    __builtin_amdgcn_s_waitcnt(0);
    unsigned nloc = b.st[0], nx = b.st[1];
    if (nloc == 0u) { xcd_barrier_complete(bar, b.x, nloc, nx); b.st[0] = nloc; b.st[1] = nx; }
    const unsigned old = xb_add(&bar[XB_XSUB(b.x)], 1u);
    const unsigned gen = old / nloc;
    if (old + 1u == (gen + 1u) * nloc) {
      __builtin_amdgcn_fence(__ATOMIC_RELEASE, "agent");
      asm volatile("s_waitcnt vmcnt(0)" ::: "memory");
      const unsigned og = xb_add(&bar[XB_TOP], 1u);
      const unsigned tg = og / nx;
      if (og + 1u == (tg + 1u) * nx) xb_add(&bar[XB_TOPGEN], 1u);
      else XB_SPIN(xb_ld(&bar[XB_TOPGEN]) == tg, bar);
      __builtin_amdgcn_fence(__ATOMIC_ACQUIRE, "agent");
      xb_add(&bar[XB_XGEN(b.x)], 1u);
      asm volatile("s_waitcnt vmcnt(0)" ::: "memory");
    } else {
      XB_SPIN(xb_ld(&bar[XB_XGEN(b.x)]) == gen, bar);
      __builtin_amdgcn_fence(__ATOMIC_ACQUIRE, "agent");
      asm volatile("s_waitcnt vmcnt(0)" ::: "memory");
    }
  }
  __syncthreads();
}

__global__ void __launch_bounds__(256, 2) fwd_megakernel(Params p) {
  extern __shared__ __attribute__((aligned(16))) unsigned char smem[];
  cg::grid_group grid = cg::this_grid();
  u16* sm = (u16*)smem;
  unsigned* xb_words = (unsigned*)(smem + SMEM_BYTES);
  if (threadIdx.x < 4) xb_words[threadIdx.x] = 0u;
  __syncthreads();
  const XcdBarrier xb = xcd_barrier_post((unsigned*)(p.ws + OFF_BAR), (volatile LAS unsigned*)xb_words);
  phase0(p, smem);
  grid.sync();
  u16* H = (u16*)(p.ws + OFF_H);
  u16* P = (u16*)(p.ws + OFF_P);
  int* ctr = (int*)(p.ws + OFF_CTR);
  for (int chunk = 0; chunk < NCHUNK; ++chunk) {
    for (int l = 0; l < 2; ++l) {
      const bool last = (l == 1);
      const u16* W = (const u16*)(p.ws + OFF_W) + (size_t)l * W_TOTAL;
      const float* mod = (const float*)(p.ws + OFF_MOD) + (size_t)l * 17 * 6144;
      phase_norm(p, chunk, l, 0, false);
      xcd_barrier(xb);
      for (int rep = 0; rep <= PR_GEMM1; ++rep) {
        gemm_phase<8, 4, true>(H, 1024, W + W_IN, 1024, NP, false, EpiStore{P, NP}, smem);
        xcd_barrier(xb);
      }
      phase_prep(p, l, sm);
      xcd_barrier(xb);
      gemm_phase<4, 4, true>(P + PB_CQ, NP, W + W_QUP, 384, 768, false, EpiStore{(u16*)(p.ws + OFF_QB), 768}, smem);
      gemm_phase<4, 4, false>(P + PB_CKV, NP, W + W_KVUP, 256, 1024, false, EpiKV{(u16*)(p.ws + OFF_KB), (u16*)(p.ws + OFF_VTB)}, smem);
      gemm_phase<4, 4, true>((const u16*)(p.ws + OFF_GL), 128, W + W_GATE, 128, 512, false, EpiStore{(u16*)(p.ws + OFF_G), 512}, smem);
      xcd_barrier(xb);
      if (PR_KIND >= 0) {
        phase_probe(p, l, PR_KIND, smem);
        xcd_barrier(xb);
      }
#ifdef PR_MIX
      if (chunk == 0) { phase_mixers(p, chunk, l, !last, ctr + 8 + l, smem, (u16*)(p.out + (size_t)BC * 2048 * 1024), PR_MIX); xcd_barrier(xb); }
#endif
      phase_mixers(p, chunk, l, !last, ctr + chunk * 2 + l, smem, nullptr, 31);
      xcd_barrier(xb);
      phase_cout(p, l, last);
      xcd_barrier(xb);
      for (int rep = 0; rep <= PR_MERGE; ++rep) {
        phase_merge(p, l, last, smem);
        xcd_barrier(xb);
      }
      gemm_phase<4, 4, true>((const u16*)(p.ws + OFF_YM), 1024, W + W_OUT, 1024, 1024, last, EpiResid{p, chunk, mod, 2048, l == 0}, smem);
      xcd_barrier(xb);
      phase_norm(p, chunk, l, 1, last);
      xcd_barrier(xb);
      gemm_phase<8, 4, true>(H, 1024, W + W_1, 1024, 4096, last, EpiRelu2{P}, smem);
      xcd_barrier(xb);
      gemm_phase<4, 4, true>(P, 4096, W + W_2, 4096, 1024, last, EpiResid{p, chunk, mod, 5120, false}, smem);
      xcd_barrier(xb);
    }
    phase_final(p, chunk);
    xcd_barrier(xb);
  }
}

extern "C" void kernel_launch(void* const* d_in, const int* in_sizes, int n_in, void* d_out, int out_size, void* d_ws,
                              size_t ws_size, hipStream_t stream) {
  static int grid_blocks = 0;
  if (!grid_blocks) {
    int dev = 0, cus = 0, per_cu = 0;
    hipGetDevice(&dev);
    hipDeviceGetAttribute(&cus, hipDeviceAttributeMultiprocessorCount, dev);
    hipFuncSetAttribute((const void*)fwd_megakernel, hipFuncAttributeMaxDynamicSharedMemorySize, SMEM_DYN);
    hipOccupancyMaxActiveBlocksPerMultiprocessor(&per_cu, fwd_megakernel, 256, SMEM_DYN);
    if (per_cu > 2) per_cu = 2;
    if (per_cu < 1) per_cu = 1;
    grid_blocks = cus * per_cu;
  }
  if (ws_size < OFF_END) fprintf(stderr, "workspace too small: %zu < %zu\n", ws_size, (size_t)OFF_END);
  Params p{};
  for (int i = 0; i < 32; ++i) p.in[i] = (const float*)d_in[i];
  p.out = (float*)d_out;
  p.ws = (unsigned char*)d_ws;
  hipMemsetAsync(d_ws, 0, 1048576, stream);
  void* args[] = {&p};
  hipError_t e = hipLaunchCooperativeKernel((void*)fwd_megakernel, dim3(grid_blocks), dim3(256), args, SMEM_DYN, stream);
  if (e != hipSuccess) fprintf(stderr, "cooperative launch failed: %s (grid %d)\n", hipGetErrorString(e), grid_blocks);
}
```

```cpp
#include <hip/hip_runtime.h>
#include <hip/hip_cooperative_groups.h>
#include <stdint.h>
#include <cstdio>
namespace cg = cooperative_groups;

typedef unsigned short u16;
typedef __attribute__((ext_vector_type(8))) short bf16x8;
typedef __attribute__((ext_vector_type(4))) float f32x4;
typedef __attribute__((ext_vector_type(2))) float v2f;
#define DI __device__ __forceinline__

#ifndef PR_ABL
#define PR_ABL 0
#endif
constexpr int SMEM_BYTES = 73728;
constexpr int SMEM_DYN = SMEM_BYTES + 64;
constexpr int DM = 1024, TL = 2304;
constexpr int BC = 8, NCHUNK = 2, TC = BC * TL;
constexpr int NP = 4992;
constexpr int PA_Q = 0, PA_K = 512, PA_V = 640, PB_CQ = 768, PB_CKV = 1152, PB_KR = 1408;
constexpr int PC_R = 1440, PC_K = 1952, PC_V = 2464, PC_WLO = 2976, PC_ALO = 3104, PC_GLO = 3232;
constexpr int PD_Q = 3360, PD_K = 3872, PD_V = 4384;
constexpr int O_A = 0, O_B = 768, O_C = 1440, O_D = 3360;

constexpr int W_IN = 0, W_G = 5111808, W_QUP = 9306112, W_KVUP = 9601024, W_GATE = 9863168, W_DEC = 9928704,
              W_AAA = 9994240, W_BR = 10059776, W_OUT = 12156928, W_1 = 13205504, W_2 = 17399808, W_TOTAL = 21594112;

constexpr size_t OFF_MOD = 0;
constexpr size_t OFF_CTR = 835584;
constexpr size_t OFF_BAR = 851968;
constexpr size_t OFF_ROPE = 1048576;
constexpr size_t OFF_W = 2097152;
constexpr size_t OFF_H = OFF_W + (size_t)2 * W_TOTAL * 2;
constexpr size_t OFF_P = OFF_H + (size_t)TC * 1024 * 2;
constexpr size_t OFF_KA = OFF_P + (size_t)TC * NP * 2;
constexpr size_t OFF_VTA = OFF_KA + (size_t)BC * 2 * TL * 64 * 2;
constexpr size_t OFF_QB = OFF_VTA + (size_t)BC * 2 * TL * 64 * 2;
constexpr size_t OFF_KB = OFF_QB + (size_t)TC * 768 * 2;
constexpr size_t OFF_VTB = OFF_KB + (size_t)TC * 768 * 2;
constexpr size_t OFF_VTD = OFF_VTB + (size_t)TC * 512 * 2;
constexpr size_t OFF_GL = OFF_VTD + (size_t)TC * 512 * 2;
constexpr size_t OFF_G = OFF_GL + (size_t)TC * 128 * 2;
constexpr size_t OFF_YF = OFF_G + (size_t)TC * 512 * 2;
constexpr size_t OFF_YB = OFF_YF + (size_t)TC * 512 * 2;
constexpr size_t OFF_BON = OFF_YB + (size_t)TC * 512 * 2;
constexpr size_t OFF_XC = OFF_BON + (size_t)TC * 16 * 4;
constexpr size_t OFF_END = OFF_XC + (size_t)BC * 256 * 1024 * 4;
constexpr size_t OFF_YM = OFF_QB;

struct Params {
  const float* in[32];
  float* out;
  unsigned char* ws;
};

DI u16 f2bf(float f) { uint32_t u = __float_as_uint(f); u += 0x7fffu + ((u >> 16) & 1u); return (u16)(u >> 16); }
DI float bf2f(u16 h) { return __uint_as_float(((uint32_t)h) << 16); }
typedef __bf16 bf2_t __attribute__((ext_vector_type(2)));
DI uint32_t pack2(float a, float b) { v2f v = {a, b}; bf2_t r = __builtin_convertvector(v, bf2_t); return __builtin_bit_cast(uint32_t, r); }
DI float lo2f(uint32_t u) { return __uint_as_float(u << 16); }
DI float hi2f(uint32_t u) { return __uint_as_float(u & 0xffff0000u); }
DI float dpp_f(float v, const int ctrl_is_unused) { return v; }
#define DPP_ADD(v, ctrl) ((v) + __int_as_float(__builtin_amdgcn_update_dpp(0, __float_as_int(v), (ctrl), 0xF, 0xF, true)))
DI float row8_sum(float v) {
  v = DPP_ADD(v, 0xB1); v = DPP_ADD(v, 0x4E); v = DPP_ADD(v, 0x141);
  return v;
}
DI float row16_sum(float v) {
  v = DPP_ADD(v, 0xB1); v = DPP_ADD(v, 0x4E); v = DPP_ADD(v, 0x141); v = DPP_ADD(v, 0x140);
  return v;
}
DI float xq_sum(float v) {
  auto r = __builtin_amdgcn_permlane16_swap(__float_as_uint(v), __float_as_uint(v), false, false);
  v = __uint_as_float(r[0]) + __uint_as_float(r[1]);
  auto r2 = __builtin_amdgcn_permlane32_swap(__float_as_uint(v), __float_as_uint(v), false, false);
  return __uint_as_float(r2[0]) + __uint_as_float(r2[1]);
}
DI float xq_max(float v) {
  auto r = __builtin_amdgcn_permlane16_swap(__float_as_uint(v), __float_as_uint(v), false, false);
  v = fmaxf(__uint_as_float(r[0]), __uint_as_float(r[1]));
  auto r2 = __builtin_amdgcn_permlane32_swap(__float_as_uint(v), __float_as_uint(v), false, false);
  return fmaxf(__uint_as_float(r2[0]), __uint_as_float(r2[1]));
}
DI float wave_sum(float v) { return xq_sum(row16_sum(v)); }
DI float quad_sum(float v) {
  v += __int_as_float(__builtin_amdgcn_update_dpp(0, __float_as_int(v), 0xB1, 0xF, 0xF, true));
  v += __int_as_float(__builtin_amdgcn_update_dpp(0, __float_as_int(v), 0x4E, 0xF, 0xF, true));
  return v;
}
DI int otid() { int t = threadIdx.x; asm volatile("" : "+v"(t)); return t; }
DI float sigmoidf_(float x) { return 1.f / (1.f + __expf(-x)); }

DI float* x1_row(const Params& p, int chunk, int row) {
  int bl = row / TL, j = row - bl * TL;
  if (j < 256) return (float*)(p.ws + OFF_XC) + ((size_t)(bl * 256 + j)) * DM;
  return p.out + ((size_t)((chunk * BC + bl) * 2048 + (j - 256))) * DM;
}
DI const float* xin_row(const Params& p, int chunk, int row) {
  int bl = row / TL, j = row - bl * TL;
  int b = chunk * BC + bl;
  if (j < 256) return p.in[2] + ((size_t)(b * 256 + j)) * DM;
  return p.in[0] + ((size_t)(b * 2048 + (j - 256))) * DM;
}
DI int mod_row(int chunk, int row) {
  int bl = row / TL, j = row - bl * TL;
  return (j < 256) ? 16 : (chunk * BC + bl);
}

__constant__ int CONVTAB[16][8] = {
  {8, 1024 * 8992, 0, 1024, 8992, 0, 4896, W_IN},
  {8, 1024 * 8992, 0, 1024, 8992, 4896, 4096, W_G},
  {13, 384 * 768, 0, 384, 768, 0, 768, W_QUP},
  {14, 256 * 1024, 0, 256, 1024, 0, 1024, W_KVUP},
  {20, 128 * 512, 0, 128, 512, 0, 512, W_GATE},
  {17, 2 * 64 * 512, 0, 64, 512, 0, 512, W_DEC},
  {17, 2 * 64 * 512, 64 * 512, 64, 512, 0, 512, W_DEC + 512 * 64},
  {19, 2 * 64 * 512, 0, 64, 512, 0, 512, W_AAA},
  {19, 2 * 64 * 512, 64 * 512, 64, 512, 0, 512, W_AAA + 512 * 64},
  {27, 4 * 512 * 1024, 0, 512, 1024, 0, 1024, W_BR},
  {27, 4 * 512 * 1024, 512 * 1024, 512, 1024, 0, 1024, W_BR + 1024 * 512},
  {27, 4 * 512 * 1024, 2 * 512 * 1024, 512, 1024, 0, 1024, W_BR + 2 * 1024 * 512},
  {27, 4 * 512 * 1024, 3 * 512 * 1024, 512, 1024, 0, 1024, W_BR + 3 * 1024 * 512},
  {28, 1024 * 1024, 0, 1024, 1024, 0, 1024, W_OUT},
  {29, 1024 * 4096, 0, 1024, 4096, 0, 4096, W_1},
  {30, 4096 * 1024, 0, 4096, 1024, 0, 1024, W_2},
};
constexpr int CONV_TILES_PER_LAYER = 1232 + 1024 + 72 + 64 + 16 + 8 + 8 + 8 + 8 + 128 * 4 + 256 + 1024 + 1024;

__device__ void conv_tile(const float* __restrict__ src, int ld, int k0, int n0, int ncols, u16* __restrict__ dst, int K,
                          float* tile, const int tid) {
  {
    const int c4 = (tid & 15) * 4;
#pragma unroll
    for (int i = 0; i < 4; ++i) {
      int r = (tid >> 4) + 16 * i;
      float4 v = make_float4(0.f, 0.f, 0.f, 0.f);
      if (n0 + c4 < ncols) v = *(const float4*)(src + (size_t)(k0 + r) * ld + n0 + c4);
      tile[r * 65 + c4 + 0] = v.x; tile[r * 65 + c4 + 1] = v.y; tile[r * 65 + c4 + 2] = v.z; tile[r * 65 + c4 + 3] = v.w;
    }
  }
  __syncthreads();
  {
    const int n = tid >> 2, kc = (tid & 3) * 16;
    if (n0 + n < ncols) {
      uint32_t w[8];
#pragma unroll
      for (int i = 0; i < 8; ++i) w[i] = pack2(tile[(kc + 2 * i) * 65 + n], tile[(kc + 2 * i + 1) * 65 + n]);
      uint4* d = (uint4*)(dst + (size_t)(n0 + n) * K + k0 + kc);
      d[0] = make_uint4(w[0], w[1], w[2], w[3]);
      d[1] = make_uint4(w[4], w[5], w[6], w[7]);
    }
  }
  __syncthreads();
}

__device__ void phase0(const Params& p, unsigned char* smem) {
  float* fsm = (float*)smem;
  const int tid = otid();
  const int n_conv = 2 * CONV_TILES_PER_LAYER;
  const int n_pad = 2 * 48;
  const int n_ada = 2 * 16 * 24;
  const int total = n_conv + n_pad + n_ada + 1;
  u16* wbase = (u16*)(p.ws + OFF_W);
  for (int it = blockIdx.x; it < total; it += gridDim.x) {
    if (it < n_conv) {
      int l = it / CONV_TILES_PER_LAYER, r = it - l * CONV_TILES_PER_LAYER;
      int job = 0;
      for (; job < 16; ++job) {
        int nt = (CONVTAB[job][3] >> 6) * ((CONVTAB[job][6] + 63) >> 6);
        if (r < nt) break;
        r -= nt;
      }
      const int K = CONVTAB[job][3], ld = CONVTAB[job][4], col0 = CONVTAB[job][5], ncols = CONVTAB[job][6];
      const int nkt = K >> 6;
      const int kt = r % nkt, ntile = r / nkt;
      const float* src = p.in[CONVTAB[job][0]] + (size_t)l * CONVTAB[job][1] + CONVTAB[job][2] + col0;
      u16* dst = wbase + (size_t)l * W_TOTAL + CONVTAB[job][7];
      conv_tile(src, ld, kt * 64, ntile * 64, ncols, dst, K, fsm, tid);
    } else if (it < n_conv + n_pad) {
      int r = it - n_conv;
      int l = r / 48, q = r - l * 48;
      u16* dst = wbase + (size_t)l * W_TOTAL + W_IN + (size_t)(4896 + q * 2) * 1024;
      *(uint4*)(dst + tid * 8) = make_uint4(0, 0, 0, 0);
    } else if (it < n_conv + n_pad + n_ada) {
      int r = it - n_conv - n_pad;
      int l = r / 384; r -= l * 384;
      int kc = r / 24, nb = r - kc * 24;
      for (int idx = tid; idx < 17 * 64; idx += 256) {
        int rr = idx >> 6, k = idx & 63;
        float cv = (rr < 16) ? p.in[1][rr * 1024 + kc * 64 + k] : p.in[3][kc * 64 + k];
        fsm[idx] = cv / (1.f + expf(-cv));
      }
      __syncthreads();
      const int n = nb * 256 + tid;
      float acc[17];
#pragma unroll
      for (int i = 0; i < 17; ++i) acc[i] = 0.f;
      const float* wp = p.in[4] + ((size_t)l * 1024 + kc * 64) * 6144 + n;
#pragma unroll 4
      for (int k = 0; k < 64; ++k) {
        float w = wp[(size_t)k * 6144];
#pragma unroll
        for (int i = 0; i < 17; ++i) acc[i] += fsm[i * 64 + k] * w;
      }
      float bias = (kc == 0) ? p.in[5][l * 6144 + n] : 0.f;
      float* mod = (float*)(p.ws + OFF_MOD);
#pragma unroll
      for (int i = 0; i < 17; ++i) atomicAdd(&mod[(size_t)(l * 17 + i) * 6144 + n], acc[i] + bias);
      __syncthreads();
    } else {
      float* ra = (float*)(p.ws + OFF_ROPE);
      float* rb = ra + 64 * 16 * 2;
      for (int idx = tid; idx < 64 * 16; idx += 256) {
        int pos = idx >> 4, i = idx & 15;
        float inv = powf(10000.f, -(float)i / 16.f);
        float ang = (float)pos * inv;
        ra[idx * 2] = cosf(ang); ra[idx * 2 + 1] = sinf(ang);
      }
      for (int idx = tid; idx < 64 * 8; idx += 256) {
        int pos = idx >> 3, i = idx & 7;
        float inv = powf(10000.f, -(float)i / 8.f);
        float ang = (float)pos * inv;
        rb[idx * 2] = cosf(ang); rb[idx * 2 + 1] = sinf(ang);
      }
    }
  }
}

__device__ void phase_norm(const Params& p, int chunk, int l, int which, bool latonly) {
  const int tid = otid();
  const int lane = tid & 63, wave = tid >> 6;
  const float* g = p.in[which == 0 ? 6 : 7] + l * 1024;
  const float* mod = (const float*)(p.ws + OFF_MOD) + (size_t)l * 17 * 6144;
  u16* H = (u16*)(p.ws + OFF_H);
  for (int row = blockIdx.x * 4 + wave; row < TC; row += gridDim.x * 4) {
    int j = row % TL;
    if (latonly && j < 256) continue;
    const float* src = (which == 0 && l == 0) ? xin_row(p, chunk, row) : (const float*)x1_row(p, chunk, row);
    const float* mr = mod + (size_t)mod_row(chunk, row) * 6144 + which * 3072;
    float4 v[4];
    float ss = 0.f;
#pragma unroll
    for (int i = 0; i < 4; ++i) {
      v[i] = *(const float4*)(src + i * 256 + lane * 4);
      ss += v[i].x * v[i].x + v[i].y * v[i].y + v[i].z * v[i].z + v[i].w * v[i].w;
    }
    ss = wave_sum(ss);
    float rs = rsqrtf(ss * (1.f / 1024.f) + 1e-6f);
#pragma unroll
    for (int i = 0; i < 4; ++i) {
      int c = i * 256 + lane * 4;
      float4 gg = *(const float4*)(g + c);
      float4 sh = *(const float4*)(mr + c);
      float4 sc = *(const float4*)(mr + 1024 + c);
      float a0 = v[i].x * rs * gg.x * (1.f + sc.x) + sh.x;
      float a1 = v[i].y * rs * gg.y * (1.f + sc.y) + sh.y;
      float a2 = v[i].z * rs * gg.z * (1.f + sc.z) + sh.z;
      float a3 = v[i].w * rs * gg.w * (1.f + sc.w) + sh.w;
      *(uint2*)(H + (size_t)row * 1024 + c) = make_uint2(pack2(a0, a1), pack2(a2, a3));
    }
  }
}

__device__ void phase_final(const Params& p, int chunk) {
  const int tid = otid();
  const int lane = tid & 63, wave = tid >> 6;
  const float* g = p.in[31];
  for (int r = blockIdx.x * 4 + wave; r < BC * 2048; r += gridDim.x * 4) {
    float* px = p.out + ((size_t)chunk * BC * 2048 + r) * DM;
    float4 v[4];
    float ss = 0.f;
#pragma unroll
    for (int i = 0; i < 4; ++i) {
      v[i] = *(const float4*)(px + i * 256 + lane * 4);
      ss += v[i].x * v[i].x + v[i].y * v[i].y + v[i].z * v[i].z + v[i].w * v[i].w;
    }
    ss = wave_sum(ss);
    float rs = rsqrtf(ss * (1.f / 1024.f) + 1e-6f);
#pragma unroll
    for (int i = 0; i < 4; ++i) {
      int c = i * 256 + lane * 4;
      float4 gg = *(const float4*)(g + c);
      *(float4*)(px + c) = make_float4(v[i].x * rs * gg.x, v[i].y * rs * gg.y, v[i].z * rs * gg.z, v[i].w * rs * gg.w);
    }
  }
}

#define GEMM_WAIT_VM(n) asm volatile("s_waitcnt vmcnt(" #n ")" ::: "memory")
DI void raw_barrier() { asm volatile("s_waitcnt lgkmcnt(0)" ::: "memory"); __builtin_amdgcn_s_barrier(); }
template <int MI, int NI, bool TR>
DI void gemm_dma(const u16* __restrict__ A, int lda, const u16* __restrict__ Bt, int ldb, int K, f32x4 (&acc)[MI][NI],
                 unsigned char* smem, const int tid) {
  constexpr int BM = 32 * MI, BN = 32 * NI;
  constexpr int SB = (BM + BN) * 64;
  constexpr int NS = (73728 / SB) >= 4 ? 4 : 3;
  constexpr int LA = BM / 64, LB = BN / 64, LPT = LA + LB;
  static_assert(LPT == 3 || LPT == 4 || LPT == 6, "unexpected tile");
  const int lane = tid & 63, wave = tid >> 6, l15 = lane & 15, quad = lane >> 4;
  const int wm = wave >> 1, wn = wave & 1;
  const int drow = tid >> 2;
  const int g4 = (0x1230 >> (((drow >> 2) & 3) * 4)) & 3;
  const int dc = (tid & 3) ^ g4;
  const u16* Asrc = A + (size_t)drow * lda + dc * 8;
  const u16* Bsrc = Bt + (size_t)drow * ldb + dc * 8;
  unsigned char* dstw = smem + __builtin_amdgcn_readfirstlane(tid >> 6) * 1024;
  auto issue = [&](int kt, int buf) {
    const int ko = kt * 32;
#pragma unroll
    for (int j = 0; j < LA; ++j)
      __builtin_amdgcn_global_load_lds((const unsigned*)(Asrc + (size_t)(j * 64) * lda + ko), (unsigned*)(dstw + buf * SB + j * 4096), 16, 0, 0);
#pragma unroll
    for (int j = 0; j < LB; ++j)
      __builtin_amdgcn_global_load_lds((const unsigned*)(Bsrc + (size_t)(j * 64) * ldb + ko), (unsigned*)(dstw + buf * SB + (LA + j) * 4096), 16, 0, 0);
  };
  const int rg4 = (0x1230 >> ((l15 >> 2) * 4)) & 3;
  const int aoff = (wm * 16 * MI + l15) * 64 + ((quad ^ rg4) * 16);
  const int boff = BM * 64 + (wn * 16 * NI + l15) * 64 + ((quad ^ rg4) * 16);
  const int nk = K >> 5;
  GEMM_WAIT_VM(0);
#pragma unroll
  for (int s_ = 0; s_ < NS - 1; ++s_)
    if (s_ < nk) issue(s_, s_);
  int buf = 0;
  for (int kt = 0; kt < nk; ++kt) {
    const int rem = nk - 1 - kt;
    if (NS == 4) {
      if (rem >= 2) { if (LPT == 3) GEMM_WAIT_VM(6); else if (LPT == 4) GEMM_WAIT_VM(8); else GEMM_WAIT_VM(12); }
      else if (rem == 1) { if (LPT == 3) GEMM_WAIT_VM(3); else if (LPT == 4) GEMM_WAIT_VM(4); else GEMM_WAIT_VM(6); }
      else GEMM_WAIT_VM(0);
    } else {
      if (rem >= 1) { if (LPT == 3) GEMM_WAIT_VM(3); else if (LPT == 4) GEMM_WAIT_VM(4); else GEMM_WAIT_VM(6); }
      else GEMM_WAIT_VM(0);
    }
    raw_barrier();
    if (kt + NS - 1 < nk) { int nb = buf + NS - 1; if (nb >= NS) nb -= NS; issue(kt + NS - 1, nb); }
    const unsigned char* st = smem + buf * SB;
    bf16x8 af[MI], bfr[NI];
#pragma unroll
    for (int mi = 0; mi < MI; ++mi) af[mi] = *(const bf16x8*)(st + aoff + mi * 1024);
#pragma unroll
    for (int ni = 0; ni < NI; ++ni) bfr[ni] = *(const bf16x8*)(st + boff + ni * 1024);
    __builtin_amdgcn_s_setprio(1);
#pragma unroll
    for (int mi = 0; mi < MI; ++mi)
#pragma unroll
      for (int ni = 0; ni < NI; ++ni)
        acc[mi][ni] = TR ? __builtin_amdgcn_mfma_f32_16x16x32_bf16(bfr[ni], af[mi], acc[mi][ni], 0, 0, 0)
                         : __builtin_amdgcn_mfma_f32_16x16x32_bf16(af[mi], bfr[ni], acc[mi][ni], 0, 0, 0);
    __builtin_amdgcn_s_setprio(0);
    if (++buf == NS) buf = 0;
  }
  raw_barrier();
}

DI bool tile_map(int t, int nMg, int nNt, bool latonly, int MT, int& mt, int& nt) {
  int x = t & 7, rest = t >> 3;
  int ni = rest & 7, q = rest >> 3;
  int mg = q % nMg, ng = q / nMg;
  nt = ng * 8 + ni;
  if (nt >= nNt) return false;
  int mti = mg * 8 + x;
  if (MT == 128) mt = latonly ? ((mti >> 4) * 18 + 2 + (mti & 15)) : mti;
  else mt = latonly ? ((mti >> 3) * 9 + 1 + (mti & 7)) : mti;
  return true;
}

template <int MI, int NI, bool TR, class Epi>
__device__ void gemm_phase(const u16* A, int lda, const u16* Bt, int K, int N, bool latonly, Epi epi, unsigned char* smem) {
  constexpr int BM = 32 * MI, BN = 32 * NI;
  const int nMg = (BM == 128) ? (latonly ? 16 : 18) : (latonly ? 8 : 9);
  const int nNt = N / BN;
  const int total = 64 * nMg * ((nNt + 7) >> 3);
  const int tid = otid();
  const int lane = tid & 63, wave = tid >> 6, l15 = lane & 15, quad = lane >> 4;
  const int wm = wave >> 1, wn = wave & 1;
  for (int t = blockIdx.x; t < total; t += gridDim.x) {
    int mt, nt;
    if (!tile_map(t, nMg, nNt, latonly, BM, mt, nt)) continue;
    const int m0 = mt * BM, n0 = nt * BN;
    f32x4 acc[MI][NI];
#pragma unroll
    for (int mi = 0; mi < MI; ++mi)
#pragma unroll
      for (int ni = 0; ni < NI; ++ni) acc[mi][ni] = (f32x4){0.f, 0.f, 0.f, 0.f};
    gemm_dma<MI, NI, TR>(A + (size_t)m0 * lda, lda, Bt + (size_t)n0 * K, K, K, acc, smem, tid);
#pragma unroll
    for (int mi = 0; mi < MI; ++mi)
#pragma unroll
      for (int ni = 0; ni < NI; ++ni) {
        if (TR) epi(m0 + wm * 16 * MI + mi * 16 + l15, n0 + wn * 16 * NI + ni * 16 + quad * 4, acc[mi][ni]);
        else epi(m0 + wm * 16 * MI + mi * 16 + quad * 4, n0 + wn * 16 * NI + ni * 16 + l15, acc[mi][ni]);
      }
  }
}

struct EpiStore {
  u16* C; int ldc;
  DI void operator()(int r, int c0, f32x4 v) const {
    *(uint2*)(C + (size_t)r * ldc + c0) = make_uint2(pack2(v[0], v[1]), pack2(v[2], v[3]));
  }
};
struct EpiKV {
  u16* KB; u16* VtB;
  DI void operator()(int r0, int c, f32x4 v) const {
    int bl = r0 / TL, j0 = r0 - bl * TL;
    int head = c >> 7, w = c & 127;
    if (w < 64) {
#pragma unroll
      for (int j = 0; j < 4; ++j) KB[((size_t)(bl * 8 + head) * TL + j0 + j) * 96 + w] = f2bf(v[j]);
    } else {
      *(uint2*)(VtB + ((size_t)(bl * 8 + head) * 64 + (w - 64)) * TL + j0) = make_uint2(pack2(v[0], v[1]), pack2(v[2], v[3]));
    }
  }
};
struct EpiRelu2 {
  u16* C;
  DI void operator()(int r, int c0, f32x4 v) const {
    float t0 = fmaxf(v[0], 0.f), t1 = fmaxf(v[1], 0.f), t2 = fmaxf(v[2], 0.f), t3 = fmaxf(v[3], 0.f);
    *(uint2*)(C + (size_t)r * 4096 + c0) = make_uint2(pack2(t0 * t0, t1 * t1), pack2(t2 * t2, t3 * t3));
  }
};
struct EpiResid {
  Params p; int chunk; const float* mod; int gofs; bool from_input;
  DI void operator()(int r, int c0, f32x4 v) const {
    const float4 gt = *(const float4*)(mod + (size_t)mod_row(chunk, r) * 6144 + gofs + c0);
    float* dst = x1_row(p, chunk, r) + c0;
    const float4 xin = from_input ? *(const float4*)(xin_row(p, chunk, r) + c0) : *(const float4*)dst;
    *(float4*)dst = make_float4(xin.x + gt.x * v[0], xin.y + gt.y * v[1], xin.z + gt.z * v[2], xin.w + gt.w * v[3]);
  }
};

__device__ void phase_merge(const Params& p, int l, bool latonly, unsigned char* smem) {
  const u16* H = (const u16*)(p.ws + OFF_H);
  const u16* P = (const u16*)(p.ws + OFF_P);
  const u16* W = (const u16*)(p.ws + OFF_W) + (size_t)l * W_TOTAL;
  u16* YM = (u16*)(p.ws + OFF_YM);
  const int nMg = latonly ? 16 : 18;
  const int nNt = 8;
  const int total = 64 * nMg;
  const int tid = otid();
  const int lane = tid & 63, wave = tid >> 6, l15 = lane & 15, quad = lane >> 4;
  const int wm = wave >> 1, wn = wave & 1;
  for (int t = blockIdx.x; t < total; t += gridDim.x) {
    int mt, nt;
    if (!tile_map(t, nMg, nNt, latonly, 128, mt, nt)) continue;
    const int m0 = mt * 128, n0 = nt * 128;
    uint2 yp[4][4];
#pragma unroll
    for (int mi = 0; mi < 4; ++mi)
#pragma unroll
      for (int ni = 0; ni < 4; ++ni) yp[mi][ni] = make_uint2(0u, 0u);
    for (int i = 0; i < 4; ++i) {
      const int ocol = (i == 0) ? O_A : (i == 1) ? O_B : (i == 2) ? O_C : O_D;
      uint2 gp[4][4];
      {
        f32x4 g[4][4];
#pragma unroll
        for (int mi = 0; mi < 4; ++mi)
#pragma unroll
          for (int ni = 0; ni < 4; ++ni) g[mi][ni] = (f32x4){0.f, 0.f, 0.f, 0.f};
        gemm_dma<4, 4, true>(H + (size_t)m0 * 1024, 1024, W + W_G + (size_t)(i * 1024 + n0) * 1024, 1024, 1024, g, smem, tid);
#pragma unroll
        for (int mi = 0; mi < 4; ++mi)
#pragma unroll
          for (int ni = 0; ni < 4; ++ni)
            gp[mi][ni] = make_uint2(pack2(sigmoidf_(g[mi][ni][0]), sigmoidf_(g[mi][ni][1])), pack2(sigmoidf_(g[mi][ni][2]), sigmoidf_(g[mi][ni][3])));
      }
      f32x4 b[4][4];
#pragma unroll
      for (int mi = 0; mi < 4; ++mi)
#pragma unroll
        for (int ni = 0; ni < 4; ++ni) b[mi][ni] = (f32x4){0.f, 0.f, 0.f, 0.f};
      gemm_dma<4, 4, true>(P + (size_t)m0 * NP + ocol, NP, W + W_BR + (size_t)(i * 1024 + n0) * 512, 512, 512, b, smem, tid);
#pragma unroll
      for (int mi = 0; mi < 4; ++mi)
#pragma unroll
        for (int ni = 0; ni < 4; ++ni) {
          const float y0 = lo2f(yp[mi][ni].x) + lo2f(gp[mi][ni].x) * b[mi][ni][0];
          const float y1 = hi2f(yp[mi][ni].x) + hi2f(gp[mi][ni].x) * b[mi][ni][1];
          const float y2 = lo2f(yp[mi][ni].y) + lo2f(gp[mi][ni].y) * b[mi][ni][2];
          const float y3 = hi2f(yp[mi][ni].y) + hi2f(gp[mi][ni].y) * b[mi][ni][3];
          yp[mi][ni] = make_uint2(pack2(y0, y1), pack2(y2, y3));
        }
    }
#pragma unroll
    for (int mi = 0; mi < 4; ++mi)
#pragma unroll
      for (int ni = 0; ni < 4; ++ni)
        *(uint2*)(YM + (size_t)(m0 + wm * 64 + mi * 16 + l15) * 1024 + n0 + wn * 64 + ni * 16 + quad * 4) = yp[mi][ni];
  }
}

__device__ void transpose64(const u16* __restrict__ src, int lds_, u16* __restrict__ dst, int ldd, u16* tile, const int tid) {
  {
    const int r = tid >> 2, c = (tid & 3) * 16;
    uint4 a = *(const uint4*)(src + (size_t)r * lds_ + c);
    uint4 b = *(const uint4*)(src + (size_t)r * lds_ + c + 8);
    uint32_t* t32 = (uint32_t*)(tile + r * 66 + c);
    t32[0] = a.x; t32[1] = a.y; t32[2] = a.z; t32[3] = a.w; t32[4] = b.x; t32[5] = b.y; t32[6] = b.z; t32[7] = b.w;
  }
  __syncthreads();
  {
    const int d = tid >> 2, tc = (tid & 3) * 16;
    uint32_t w[8];
#pragma unroll
    for (int i = 0; i < 8; ++i) w[i] = (uint32_t)tile[(tc + 2 * i) * 66 + d] | ((uint32_t)tile[(tc + 2 * i + 1) * 66 + d] << 16);
    uint4* o = (uint4*)(dst + (size_t)d * ldd + tc);
    o[0] = make_uint4(w[0], w[1], w[2], w[3]);
    o[1] = make_uint4(w[4], w[5], w[6], w[7]);
  }
  __syncthreads();
}

__device__ void phase_prep(const Params& p, int l, u16* sm) {
  const int tid = otid();
  const int lane = tid & 63, wave = tid >> 6;
  u16* P = (u16*)(p.ws + OFF_P);
  u16* KA = (u16*)(p.ws + OFF_KA);
  u16* VtA = (u16*)(p.ws + OFF_VTA);
  u16* KB = (u16*)(p.ws + OFF_KB);
  u16* VtD = (u16*)(p.ws + OFF_VTD);
  u16* GL = (u16*)(p.ws + OFF_GL);
  const float* ropeA = (const float*)(p.ws + OFF_ROPE);
  const float* ropeB = ropeA + 64 * 16 * 2;
  const float aqg = p.in[9][l * 64 + lane], akg = p.in[10][l * 64 + lane];
  const float* bqg = p.in[11] + l * 384;
  const float* bkvg = p.in[12] + l * 256;
  const float* mu = p.in[15] + l * 1920;
  for (int tok = blockIdx.x * 4 + wave; tok < TC; tok += gridDim.x * 4) {
    const int bl = tok / TL, j = tok - bl * TL;
    const bool islat = j >= 256;
    const int jj = j - 256;
    const int grow = (jj >> 6) & 31, gcol = jj & 63;
    u16* pr = P + (size_t)tok * NP;
    float ca = 1.f, sa = 0.f;
    if (islat) {
      int pos = (lane < 32) ? grow : gcol;
      ca = ropeA[(pos * 16 + (lane & 15)) * 2];
      sa = ropeA[(pos * 16 + (lane & 15)) * 2 + 1];
    }
    for (int h = 0; h < 10; ++h) {
      float x = bf2f(pr[h * 64 + lane]);
      float ss = wave_sum(x * x);
      float y = x * rsqrtf(ss * (1.f / 64.f) + 1e-6f) * (h < 8 ? aqg : akg);
      float yp = __shfl_xor(y, 16);
      float o = ((lane & 16) == 0) ? (y * ca - yp * sa) : (yp * sa + y * ca);
      if (h < 8) pr[h * 64 + lane] = f2bf(o);
      else KA[((size_t)(bl * 2 + (h - 8)) * TL + j) * 64 + lane] = f2bf(o);
    }
    {
      float x[6], ss = 0.f;
#pragma unroll
      for (int i = 0; i < 6; ++i) { x[i] = bf2f(pr[PB_CQ + lane + 64 * i]); ss += x[i] * x[i]; }
      ss = wave_sum(ss);
      float rs = rsqrtf(ss * (1.f / 384.f) + 1e-6f);
#pragma unroll
      for (int i = 0; i < 6; ++i) pr[PB_CQ + lane + 64 * i] = f2bf(x[i] * rs * bqg[lane + 64 * i]);
    }
    {
      float x[4], ss = 0.f;
#pragma unroll
      for (int i = 0; i < 4; ++i) { x[i] = bf2f(pr[PB_CKV + lane + 64 * i]); ss += x[i] * x[i]; }
      ss = wave_sum(ss);
      float rs = rsqrtf(ss * (1.f / 256.f) + 1e-6f);
#pragma unroll
      for (int i = 0; i < 4; ++i) pr[PB_CKV + lane + 64 * i] = f2bf(x[i] * rs * bkvg[lane + 64 * i]);
    }
    {
      float x = bf2f(pr[PB_KR + (lane & 31)]);
      float xp = __shfl_xor(x, 8);
      float o = x;
      if (islat) {
        int pos = ((lane & 31) < 16) ? grow : gcol;
        float c = ropeB[(pos * 8 + (lane & 7)) * 2], s = ropeB[(pos * 8 + (lane & 7)) * 2 + 1];
        o = ((lane & 8) == 0) ? (x * c - xp * s) : (xp * s + x * c);
      }
      if (lane < 32) {
        u16 ob = f2bf(o);
#pragma unroll
        for (int h = 0; h < 8; ++h) KB[((size_t)(bl * 8 + h) * TL + j) * 96 + 64 + lane] = ob;
      }
    }
    {
      const bool hasp = islat ? (jj > 0) : (j > 0);
      const bool hasn = islat ? (jj < 2047) : (j < 255);
#pragma unroll
      for (int i = 0; i < 2; ++i) {
        int c = lane + 64 * i;
        float cur = bf2f(pr[PC_GLO + c]);
        float pv = hasp ? bf2f(pr[PC_GLO + c - NP]) : 0.f;
        float nv = hasn ? bf2f(pr[PC_GLO + c + NP]) : 0.f;
        float z = cur + (0.5f * (pv + nv) - cur) * mu[1792 + c];
        GL[(size_t)tok * 128 + c] = f2bf(sigmoidf_(z));
      }
    }
  }
  for (int it = blockIdx.x; it < (TC / 64) * 10; it += gridDim.x) {
    int tg = it / 10, hh = it - tg * 10;
    int tok0 = tg * 64, bl = tok0 / TL, j0 = tok0 - bl * TL;
    if (hh < 2) transpose64(P + (size_t)tok0 * NP + PA_V + hh * 64, NP, VtA + ((size_t)(bl * 2 + hh) * 64) * TL + j0, TL, sm, tid);
    else transpose64(P + (size_t)tok0 * NP + PD_V + (hh - 2) * 64, NP, VtD + ((size_t)(bl * 8 + hh - 2) * 64) * TL + j0, TL, sm, tid);
  }
}

template <int DQK, int NQ, int MODE>
__device__ void flash_item(const u16* __restrict__ Qp, int ldq, const u16* __restrict__ Kp, int ldk, const u16* __restrict__ Vtp,
                           int ntiles, u16* __restrict__ Op, int ldo, float scale, bool ropeq, int qtok0,
                           const float* __restrict__ ropeB, int nat_r, const float* __restrict__ bias_g, unsigned char* smem, const int tid, const int abl) {
  constexpr int KS = DQK / 32;
  constexpr int DCH = DQK / 8;
  constexpr int KB_ = 64 * DQK * 2;
  constexpr int SBF = KB_ + 8192;
  constexpr int NS = (DQK == 64) ? 4 : 3;
  constexpr int LK = (64 * DCH) / 256, LPT = LK + 2;
  float* sBias = (float*)(smem + NS * SBF);
  const int lane = tid & 63, wave = tid >> 6, l15 = lane & 15, quad = lane >> 4;
  const float L2E = 1.4426950408889634f;
  int r0 = 0;
  if (MODE == 1) {
    r0 = min(max(nat_r - 4, 0), 24);
    for (int i = tid; i < 15 * 31; i += 256) sBias[i] = bias_g[i];
  }
  bf16x8 qf[NQ][KS];
#pragma unroll
  for (int qi = 0; qi < NQ; ++qi) {
    const int row = wave * 16 * NQ + qi * 16 + l15;
#pragma unroll
    for (int ks = 0; ks < KS; ++ks) qf[qi][ks] = *(const bf16x8*)(Qp + (size_t)row * ldq + ks * 32 + quad * 8);
    if (DQK == 96 && ropeq) {
      bf16x8 own = qf[qi][KS - 1];
      bf16x8 par = *(const bf16x8*)(Qp + (size_t)row * ldq + 64 + (quad ^ 1) * 8);
      const int qt = qtok0 + row;
      const int pos = (quad < 2) ? ((qt >> 6) & 31) : (qt & 63);
      bf16x8 res;
#pragma unroll
      for (int i = 0; i < 8; ++i) {
        float c = ropeB[(pos * 8 + i) * 2], s = ropeB[(pos * 8 + i) * 2 + 1];
        float xo = bf2f((u16)own[i]), xp = bf2f((u16)par[i]);
        float o = ((quad & 1) == 0) ? (xo * c - xp * s) : (xp * s + xo * c);
        res[i] = (short)f2bf(o);
      }
      qf[qi][KS - 1] = res;
    }
  }
  auto koff = [&](int t) -> int { return (MODE == 1) ? ((t < 8) ? (256 + (r0 + t) * 64) : ((t - 8) * 64)) : t * 64; };
  unsigned char* dstw = smem + __builtin_amdgcn_readfirstlane(tid >> 6) * 1024;
  auto issue = [&](int t, int buf) {
    const int ko = koff(t);
#pragma unroll
    for (int i = 0; i < LK; ++i) {
      const int L = tid + 256 * i;
      int row, c;
      if (DQK == 64) { row = L >> 3; c = (L & 7) ^ (row & 7); }
      else { row = L / 12; const int pp = L - row * 12; c = (pp & ~3) | ((pp & 3) ^ ((0x1230 >> (((row >> 2) & 3) * 4)) & 3)); }
      __builtin_amdgcn_global_load_lds((const unsigned*)(Kp + (size_t)(ko + row) * ldk + c * 8), (unsigned*)(dstw + buf * SBF + i * 4096), 16, 0, 0);
    }
#pragma unroll
    for (int i = 0; i < 2; ++i) {
      const int L = tid + 256 * i;
      const int d = L >> 3, c = (L & 7) ^ (d & 7);
      __builtin_amdgcn_global_load_lds((const unsigned*)(Vtp + (size_t)d * TL + ko + c * 8), (unsigned*)(dstw + buf * SBF + KB_ + i * 4096), 16, 0, 0);
    }
  };
  int koffs[KS];
#pragma unroll
  for (int ks = 0; ks < KS; ++ks) {
    const int c = ks * 4 + quad;
    if (DQK == 64) koffs[ks] = l15 * 128 + ((c ^ (l15 & 7)) * 16);
    else koffs[ks] = l15 * 192 + (((c & ~3) | ((c & 3) ^ ((0x1230 >> ((l15 >> 2) * 4)) & 3))) * 16);
  }
  int voffs[2][2];
#pragma unroll
  for (int kk = 0; kk < 2; ++kk)
#pragma unroll
    for (int ab = 0; ab < 2; ++ab) {
      const int keyb = ((2 * kk + ab) * 16 + quad * 4) * 2;
      const int c = keyb >> 4;
      voffs[kk][ab] = l15 * 128 + ((c ^ (l15 & 7)) * 16) + (keyb & 15);
    }
  f32x4 o[4][NQ];
  float m[NQ], lsum[NQ];
#pragma unroll
  for (int qi = 0; qi < NQ; ++qi) {
    m[qi] = -INFINITY; lsum[qi] = 0.f;
#pragma unroll
    for (int dt = 0; dt < 4; ++dt) o[dt][qi] = (f32x4){0.f, 0.f, 0.f, 0.f};
  }
  const int qc = wave * 16 + l15;
  const int st = min(max(qc - 8, 0), 48);
  GEMM_WAIT_VM(0);
#pragma unroll
  for (int s_ = 0; s_ < NS - 1; ++s_)
    if (s_ < ntiles) issue(s_, s_);
  int buf = 0;
  for (int t = 0; t < ntiles; ++t) {
    if (!(abl & 4)) {
      const int rem = ntiles - 1 - t;
      if (NS == 4) {
        if (rem >= 2) GEMM_WAIT_VM(8); else if (rem == 1) GEMM_WAIT_VM(4); else GEMM_WAIT_VM(0);
      } else {
        if (rem >= 1) GEMM_WAIT_VM(5); else GEMM_WAIT_VM(0);
      }
    }
    if (!(abl & 8)) raw_barrier();
    if (!(abl & 4) && t + NS - 1 < ntiles) { int nb = buf + NS - 1; if (nb >= NS) nb -= NS; issue(t + NS - 1, nb); }
    const unsigned char* k_s = smem + buf * SBF;
    const unsigned char* v_s = k_s + KB_;
    f32x4 s[4][NQ];
    {
      bf16x8 kf[4][KS];
#pragma unroll
      for (int kt = 0; kt < 4; ++kt)
#pragma unroll
        for (int ks = 0; ks < KS; ++ks) kf[kt][ks] = *(const bf16x8*)(k_s + kt * 16 * DQK * 2 + koffs[ks]);
      __builtin_amdgcn_sched_barrier(0);
#pragma unroll
      for (int kt = 0; kt < 4; ++kt) {
#pragma unroll
        for (int qi = 0; qi < NQ; ++qi) s[kt][qi] = (f32x4){0.f, 0.f, 0.f, 0.f};
#pragma unroll
        for (int ks = 0; ks < KS; ++ks)
#pragma unroll
          for (int qi = 0; qi < NQ; ++qi) s[kt][qi] = __builtin_amdgcn_mfma_f32_16x16x32_bf16(kf[kt][ks], qf[qi][ks], s[kt][qi], 0, 0, 0);
      }
    }
    uint2 vfa[2][4], vfb[2][4];
#pragma unroll
    for (int kk = 0; kk < 2; ++kk)
#pragma unroll
      for (int dt = 0; dt < 4; ++dt) {
        vfa[kk][dt] = *(const uint2*)(v_s + dt * 2048 + voffs[kk][0]);
        vfb[kk][dt] = *(const uint2*)(v_s + dt * 2048 + voffs[kk][1]);
      }
    __builtin_amdgcn_sched_barrier(0);
    const float c2 = scale * L2E;
    if (MODE == 1 && t < 8) {
      const int drow = r0 + t - nat_r + 7;
#pragma unroll
      for (int kt = 0; kt < 4; ++kt)
#pragma unroll
        for (int j = 0; j < 4; ++j) {
          int kc = kt * 16 + quad * 4 + j;
          bool valid = (kc >= st) && (kc < st + 16);
          int bi = drow * 31 + (kc - qc + 15);
          bi = valid ? bi : 0;
          float bv = sBias[bi];
          s[kt][0][j] = valid ? (s[kt][0][j] * c2 + bv * L2E) : -INFINITY;
        }
    }
    const bool pre = (MODE == 1 && t < 8);
    bf16x8 pb[NQ][2];
    if (abl & 1) {
#pragma unroll
      for (int qi = 0; qi < NQ; ++qi)
#pragma unroll
        for (int kk = 0; kk < 2; ++kk) {
          uint4 u = make_uint4(pack2(s[2 * kk][qi][0], s[2 * kk][qi][1]), pack2(s[2 * kk][qi][2], s[2 * kk][qi][3]),
                               pack2(s[2 * kk + 1][qi][0], s[2 * kk + 1][qi][1]), pack2(s[2 * kk + 1][qi][2], s[2 * kk + 1][qi][3]));
          pb[qi][kk] = __builtin_bit_cast(bf16x8, u);
        }
    } else
#pragma unroll
    for (int qi = 0; qi < NQ; ++qi) {
      float mx = fmaxf(fmaxf(s[0][qi][0], s[0][qi][1]), fmaxf(s[0][qi][2], s[0][qi][3]));
#pragma unroll
      for (int kt = 1; kt < 4; ++kt) mx = fmaxf(mx, fmaxf(fmaxf(s[kt][qi][0], s[kt][qi][1]), fmaxf(s[kt][qi][2], s[kt][qi][3])));
      mx = xq_max(mx);
      const float cc = pre ? 1.f : c2;
      const float mnew = fmaxf(m[qi], mx * cc);
      const float alpha = __builtin_amdgcn_exp2f(m[qi] - mnew);
      m[qi] = mnew;
      float ps = 0.f;
#pragma unroll
      for (int kt = 0; kt < 4; ++kt)
#pragma unroll
        for (int j = 0; j < 4; ++j) {
          float pv = __builtin_amdgcn_exp2f(s[kt][qi][j] * cc - mnew);
          s[kt][qi][j] = pv;
          ps += pv;
        }
      lsum[qi] = lsum[qi] * alpha + ps;
#pragma unroll
      for (int dt = 0; dt < 4; ++dt)
#pragma unroll
        for (int j = 0; j < 4; ++j) o[dt][qi][j] *= alpha;
#pragma unroll
      for (int kk = 0; kk < 2; ++kk) {
        uint4 u = make_uint4(pack2(s[2 * kk][qi][0], s[2 * kk][qi][1]), pack2(s[2 * kk][qi][2], s[2 * kk][qi][3]),
                             pack2(s[2 * kk + 1][qi][0], s[2 * kk + 1][qi][1]), pack2(s[2 * kk + 1][qi][2], s[2 * kk + 1][qi][3]));
        pb[qi][kk] = __builtin_bit_cast(bf16x8, u);
      }
    }
#pragma unroll
    for (int kk = 0; kk < 2; ++kk)
#pragma unroll
      for (int dt = 0; dt < 4; ++dt) {
        uint4 vv = make_uint4(vfa[kk][dt].x, vfa[kk][dt].y, vfb[kk][dt].x, vfb[kk][dt].y);
        bf16x8 av = __builtin_bit_cast(bf16x8, vv);
#pragma unroll
        for (int qi = 0; qi < NQ; ++qi) o[dt][qi] = __builtin_amdgcn_mfma_f32_16x16x32_bf16(av, pb[qi][kk], o[dt][qi], 0, 0, 0);
      }
    if (++buf == NS) buf = 0;
  }
  raw_barrier();
#pragma unroll
  for (int qi = 0; qi < NQ; ++qi) {
    float l = xq_sum(lsum[qi]);
    const float inv = 1.f / l;
    const int row = wave * 16 * NQ + qi * 16 + l15;
#pragma unroll
    for (int dt = 0; dt < 4; ++dt)
      *(uint2*)(Op + (size_t)row * ldo + dt * 16 + quad * 4) =
          make_uint2(pack2(o[dt][qi][0] * inv, o[dt][qi][1] * inv), pack2(o[dt][qi][2] * inv, o[dt][qi][3] * inv));
  }
}

__device__ void scan_item(const Params& p, int l, int bl, int h, int dir, int half, unsigned char* smem, const int tid, const int abl) {
  float* R = (float*)smem;
  float* V = R + 2048;
  float* KK = V + 2048;
  float* KD = KK + 2048;
  float* W = KD + 2048;
  float* T1 = W + 2048;
  float* Y = T1 + 2048;
  float* BONW = Y + 2048;
  u16* XW = (u16*)(BONW + 128);
  u16* XA = XW + 32 * 72;
  const int lane = tid & 63, wave = tid >> 6, l15 = lane & 15, quad = lane >> 4;
  const u16* P = (const u16*)(p.ws + OFF_P);
  u16* Yd = (u16*)(p.ws + (dir ? OFF_YB : OFF_YF));
  float* BON = (float*)(p.ws + OFF_BON);
  const u16* Wl = (const u16*)(p.ws + OFF_W) + (size_t)l * W_TOTAL;
  const float* mu = p.in[15] + l * 1920;
  const int nn = wave * 16 + l15;
  const float w0 = p.in[16][(l * 2 + dir) * 512 + h * 64 + nn];
  const float a0 = p.in[18][(l * 2 + dir) * 512 + h * 64 + nn];
  const float ka = p.in[22][l * 512 + h * 64 + nn];
  const float rk = p.in[23][l * 512 + h * 64 + nn];
  bf16x8 wdec[2], waaa[2];
#pragma unroll
  for (int ks = 0; ks < 2; ++ks) {
    wdec[ks] = *(const bf16x8*)(Wl + W_DEC + ((size_t)dir * 512 + h * 64 + nn) * 64 + ks * 32 + quad * 8);
    waaa[ks] = *(const bf16x8*)(Wl + W_AAA + ((size_t)dir * 512 + h * 64 + nn) * 64 + ks * 32 + quad * 8);
  }
  const int st_t = tid >> 3, part = tid & 7, n0 = part * 8;
  const int sl = lane & 7, srow = half * 32 + wave * 8 + (lane >> 3);
  v2f S2[4];
#pragma unroll
  for (int i = 0; i < 4; ++i) S2[i] = (v2f){0.f, 0.f};
  float* MU = (float*)(XA + 32 * 72);
  float* KKC = MU + 320;
  for (int i = tid; i < 384; i += 256) {
    int g = i >> 6, n = i & 63;
    float v;
    if (g == 0) v = mu[h * 64 + n];
    else if (g == 1) v = mu[1024 + h * 64 + n];
    else if (g == 2) v = mu[512 + h * 64 + n];
    else if (g == 3) v = mu[1536 + dir * 64 + n];
    else if (g == 4) v = mu[1664 + dir * 64 + n];
    else v = p.in[21][l * 512 + h * 64 + n];
    MU[i] = v;
  }
  uint4 raw[15];
  auto issue_raw = [&](int cidx) {
    const int seg = cidx >= 8;
    const int cc = seg ? cidx - 8 : cidx, nch = seg ? 64 : 8, len = seg ? 2048 : 256;
    const int tb = bl * TL + (seg ? 256 : 0);
    const int c = dir ? (nch - 1 - cc) : cc;
    const int pos = c * 32 + st_t;
    const bool hasp = pos > 0, hasn = pos < len - 1;
    const u16* rowp = P + (size_t)(tb + pos) * NP + n0;
    const int cols[5] = {PC_R + h * 64, PC_V + h * 64, PC_K + h * 64, PC_WLO + dir * 64, PC_ALO + dir * 64};
#pragma unroll
    for (int g = 0; g < 5; ++g) {
      raw[3 * g] = *(const uint4*)(rowp + cols[g]);
      raw[3 * g + 1] = make_uint4(0, 0, 0, 0);
      raw[3 * g + 2] = make_uint4(0, 0, 0, 0);
      if (hasp) raw[3 * g + 1] = *(const uint4*)(rowp + cols[g] - NP);
      if (hasn) raw[3 * g + 2] = *(const uint4*)(rowp + cols[g] + NP);
    }
  };
  issue_raw(0);
  __syncthreads();

  for (int cidx = 0; cidx < 72; ++cidx) {
    {
      const int seg = cidx >= 8;
      const int cc = seg ? cidx - 8 : cidx, nch = seg ? 64 : 8;
      const int tb = bl * TL + (seg ? 256 : 0);
      const int c = dir ? (nch - 1 - cc) : cc;
      const int pos0 = c * 32;
      {
#define SHIFT8(G, z)                                                                              \
  {                                                                                               \
    const uint4 c4 = raw[3 * (G)], p4 = raw[3 * (G) + 1], n4 = raw[3 * (G) + 2];                  \
    const float4 m0 = *(const float4*)(MU + (G)*64 + n0), m1 = *(const float4*)(MU + (G)*64 + n0 + 4); \
    const float mm[8] = {m0.x, m0.y, m0.z, m0.w, m1.x, m1.y, m1.z, m1.w};                          \
    const uint32_t cu[4] = {c4.x, c4.y, c4.z, c4.w}, pu[4] = {p4.x, p4.y, p4.z, p4.w}, nu[4] = {n4.x, n4.y, n4.z, n4.w}; \
    _Pragma("unroll") for (int i = 0; i < 4; ++i) {                                               \
      float c0 = lo2f(cu[i]), c1 = hi2f(cu[i]);                                                   \
      z[2 * i] = c0 + (0.5f * (lo2f(pu[i]) + lo2f(nu[i])) - c0) * mm[2 * i];                      \
      z[2 * i + 1] = c1 + (0.5f * (hi2f(pu[i]) + hi2f(nu[i])) - c1) * mm[2 * i + 1];              \
    }                                                                                             \
  }
        float z[8];
        SHIFT8(0, z);
        *(float4*)(R + st_t * 64 + n0) = make_float4(z[0], z[1], z[2], z[3]);
        *(float4*)(R + st_t * 64 + n0 + 4) = make_float4(z[4], z[5], z[6], z[7]);
        SHIFT8(1, z);
        *(float4*)(V + st_t * 64 + n0) = make_float4(z[0], z[1], z[2], z[3]);
        *(float4*)(V + st_t * 64 + n0 + 4) = make_float4(z[4], z[5], z[6], z[7]);
        SHIFT8(2, z);
        {
          const float4 k0 = *(const float4*)(KKC + n0), k1 = *(const float4*)(KKC + n0 + 4);
          const float kc[8] = {k0.x, k0.y, k0.z, k0.w, k1.x, k1.y, k1.z, k1.w};
          float q[8], ss = 0.f;
#pragma unroll
          for (int i = 0; i < 8; ++i) { q[i] = z[i] * kc[i]; ss += q[i] * q[i]; }
          *(float4*)(KD + st_t * 64 + n0) = make_float4(z[0], z[1], z[2], z[3]);
          *(float4*)(KD + st_t * 64 + n0 + 4) = make_float4(z[4], z[5], z[6], z[7]);
          ss = row8_sum(ss);
          const float inv = 1.f / fmaxf(sqrtf(ss), 1e-12f);
          *(float4*)(KK + st_t * 64 + n0) = make_float4(q[0] * inv, q[1] * inv, q[2] * inv, q[3] * inv);
          *(float4*)(KK + st_t * 64 + n0 + 4) = make_float4(q[4] * inv, q[5] * inv, q[6] * inv, q[7] * inv);
        }
        SHIFT8(3, z);
        {
          float th[8];
#pragma unroll
          for (int i = 0; i < 8; ++i) th[i] = 1.f - 2.f / (1.f + __expf(2.f * z[i]));
          *(uint4*)(XW + st_t * 72 + n0) = make_uint4(pack2(th[0], th[1]), pack2(th[2], th[3]), pack2(th[4], th[5]), pack2(th[6], th[7]));
        }
        SHIFT8(4, z);
        *(uint4*)(XA + st_t * 72 + n0) = make_uint4(pack2(z[0], z[1]), pack2(z[2], z[3]), pack2(z[4], z[5]), pack2(z[6], z[7]));
#undef SHIFT8
      }
      raw_barrier();
#pragma unroll
      for (int mt = 0; mt < 2; ++mt) {
        f32x4 aw = (f32x4){0.f, 0.f, 0.f, 0.f}, aa = (f32x4){0.f, 0.f, 0.f, 0.f};
#pragma unroll
        for (int ks = 0; ks < 2; ++ks) {
          bf16x8 xw = *(const bf16x8*)(XW + (mt * 16 + l15) * 72 + ks * 32 + quad * 8);
          bf16x8 xa = *(const bf16x8*)(XA + (mt * 16 + l15) * 72 + ks * 32 + quad * 8);
          aw = __builtin_amdgcn_mfma_f32_16x16x32_bf16(xw, wdec[ks], aw, 0, 0, 0);
          aa = __builtin_amdgcn_mfma_f32_16x16x32_bf16(xa, waaa[ks], aa, 0, 0, 0);
        }
#pragma unroll
        for (int j = 0; j < 4; ++j) {
          const int t = mt * 16 + quad * 4 + j;
          const float wv = __expf(-0.6065306597126334f / (1.f + __expf(-(w0 + aw[j]))));
          const float av = 1.f / (1.f + __expf(-(a0 + aa[j])));
          W[t * 64 + nn] = wv;
          T1[t * 64 + nn] = KK[t * 64 + nn] * av;
          const float kd = KD[t * 64 + nn] * (1.f + (av - 1.f) * ka);
          KD[t * 64 + nn] = kd;
          const float bon = row16_sum(R[t * 64 + nn] * kd * rk);
          if (l15 == 0) BONW[wave * 32 + t] = bon;
        }
      }
      if (cidx + 1 < 72) issue_raw(cidx + 1);
      raw_barrier();
      {
        float4 Akk0, Akk1, At0, At1, Ad0, Ad1, Aw0, Aw1, Ar0, Ar1, Bkk0, Bkk1, Bt0, Bt1, Bd0, Bd1, Bw0, Bw1, Br0, Br1;
        float Av, Bv;
#define SCAN_LOAD(X, I)                                                  \
  {                                                                      \
    const int o_ = (I) * 64 + sl * 8;                                    \
    X##kk0 = *(const float4*)(KK + o_); X##kk1 = *(const float4*)(KK + o_ + 4); \
    X##t0 = *(const float4*)(T1 + o_);  X##t1 = *(const float4*)(T1 + o_ + 4);  \
    X##d0 = *(const float4*)(KD + o_);  X##d1 = *(const float4*)(KD + o_ + 4);  \
    X##w0 = *(const float4*)(W + o_);   X##w1 = *(const float4*)(W + o_ + 4);   \
    X##r0 = *(const float4*)(R + o_);   X##r1 = *(const float4*)(R + o_ + 4);   \
    X##v = V[(I) * 64 + srow];                                           \
  }
#define SCAN_EL(C, KDv, T1v, Wv, Rv)                                      \
  {                                                                      \
    const v2f kd_ = KDv, t1_ = T1v, w_ = Wv, r_ = Rv;                    \
    S2[C] = S2[C] * w_ + (vv0 * kd_ + nsa0 * t1_);                       \
    if ((C) & 1) y1 += S2[C] * r_; else y0 += S2[C] * r_;                \
  }
#define SCAN_STEP(X, I)                                                  \
  {                                                                      \
    const v2f k0 = (v2f){X##kk0.x, X##kk0.y}, k1 = (v2f){X##kk0.z, X##kk0.w}, k2 = (v2f){X##kk1.x, X##kk1.y}, k3 = (v2f){X##kk1.z, X##kk1.w}; \
    v2f a0 = S2[0] * k0, a0b = S2[1] * k1;                               \
    a0 += S2[2] * k2; a0b += S2[3] * k3;                                 \
    a0 += a0b;                                                           \
    const float sa0 = row8_sum(a0.x + a0.y);                             \
    const v2f vv0 = (v2f){X##v, X##v}, nsa0 = (v2f){-sa0, -sa0};         \
    v2f y0 = (v2f){0.f, 0.f}, y1 = (v2f){0.f, 0.f};                      \
    SCAN_EL(0, ((v2f){X##d0.x, X##d0.y}), ((v2f){X##t0.x, X##t0.y}), ((v2f){X##w0.x, X##w0.y}), ((v2f){X##r0.x, X##r0.y})) \
    SCAN_EL(1, ((v2f){X##d0.z, X##d0.w}), ((v2f){X##t0.z, X##t0.w}), ((v2f){X##w0.z, X##w0.w}), ((v2f){X##r0.z, X##r0.w})) \
    SCAN_EL(2, ((v2f){X##d1.x, X##d1.y}), ((v2f){X##t1.x, X##t1.y}), ((v2f){X##w1.x, X##w1.y}), ((v2f){X##r1.x, X##r1.y})) \
    SCAN_EL(3, ((v2f){X##d1.z, X##d1.w}), ((v2f){X##t1.z, X##t1.w}), ((v2f){X##w1.z, X##w1.w}), ((v2f){X##r1.z, X##r1.w})) \
    y0 += y1;                                                            \
    const float ys0 = row8_sum(y0.x + y0.y);                             \
    if (sl == 0) Y[(I) * 64 + srow] = ys0;                               \
  }
        SCAN_LOAD(A, dir ? 31 : 0);
        for (int s = 0; s < ((abl & 32) ? 0 : 32); s += 2) {
          const int i0 = dir ? (31 - s) : s, i1 = dir ? (30 - s) : (s + 1);
          SCAN_LOAD(B, i1);
          SCAN_STEP(A, i0);
          if (s + 2 < 32) { SCAN_LOAD(A, dir ? (29 - s) : (s + 2)); }
          SCAN_STEP(B, i1);
        }
#undef SCAN_LOAD
#undef SCAN_EL
#undef SCAN_STEP
      }
      raw_barrier();
      {
        const float* yp = Y + st_t * 64 + half * 32 + part * 4;
        const size_t tok = (size_t)(tb + pos0 + st_t);
        *(uint2*)(Yd + tok * 512 + h * 64 + half * 32 + part * 4) = make_uint2(pack2(yp[0], yp[1]), pack2(yp[2], yp[3]));
        if (part == 0 && half == 0) BON[tok * 16 + h * 2 + dir] = BONW[st_t] + BONW[32 + st_t] + BONW[64 + st_t] + BONW[96 + st_t];
      }
    }
  }
  __syncthreads();
}

__device__ void phase_mixers(const Params& p, int chunk, int l, bool with_ctx, int* counter, unsigned char* smem, u16* dum, int kmask) {
  int& s_item = *(int*)(smem + SMEM_BYTES + 16);
  u16* sm = (u16*)smem;
  u16* P = (u16*)(p.ws + OFF_P);
  const u16* KA = (const u16*)(p.ws + OFF_KA);
  const u16* VtA = (const u16*)(p.ws + OFF_VTA);
  const u16* QB = (const u16*)(p.ws + OFF_QB);
  const u16* KB = (const u16*)(p.ws + OFF_KB);
  const u16* VtB = (const u16*)(p.ws + OFF_VTB);
  const u16* VtD = (const u16*)(p.ws + OFF_VTD);
  const float* ropeB = (const float*)(p.ws + OFF_ROPE) + 64 * 16 * 2;
  const int n_scan = BC * 8 * 2 * 2;
  const int n_al = BC * 8 * 16;
  const int n_nat = BC * 8 * 32;
  const int n_cx = BC * 8 * 2;
  const int total = n_scan + 2 * n_al + n_nat + (with_ctx ? 3 * n_cx : 0);
  const float scaleB = 0.10206207261596575f;
  while (true) {
    const int tid = otid();
    if (tid == 0) s_item = atomicAdd(counter, 1);
    __syncthreads();
    int it = s_item;
    __syncthreads();
    if (it >= total) break;
    if (it < n_scan) {
      if (!(kmask & 1)) continue;
      int half = it & 1, dir = (it >> 1) & 1, h = (it >> 2) & 7, bl = it >> 5;
      __builtin_amdgcn_s_setprio(3);
      scan_item(p, l, bl, h, dir, half, smem, otid(), dum ? PR_ABL : 0);
      __builtin_amdgcn_s_setprio(0);
      continue;
    }
    it -= n_scan;
    int kind, h, bl, ntl;
    size_t tok0;
    bool rq = false;
    int qtok0 = 0, natr = 0;
    if (it < 2 * n_al) {
      kind = (it >= n_al) ? 1 : 0;
      int i2 = it - kind * n_al;
      int qt = i2 & 15; h = (i2 >> 4) & 7; bl = i2 >> 7;
      tok0 = (size_t)bl * TL + 256 + qt * 128; ntl = 36; rq = true; qtok0 = qt * 128;
    } else if (it < 2 * n_al + n_nat) {
      int i2 = it - 2 * n_al;
      kind = 3; natr = i2 & 31; h = (i2 >> 5) & 7; bl = i2 >> 8;
      tok0 = (size_t)bl * TL + 256 + natr * 64; ntl = 12;
    } else {
      int i2 = it - 2 * n_al - n_nat;
      kind = i2 / n_cx; i2 -= kind * n_cx;
      int qt = i2 & 1; h = (i2 >> 1) & 7; bl = i2 >> 4;
      tok0 = (size_t)bl * TL + qt * 128; ntl = 4;
    }
    {
      const int cls = (ntl == 36) ? (kind == 0 ? 2 : 4) : (ntl == 12 ? 8 : 16);
      if (!(kmask & cls)) continue;
    }
    if (kind == 1) {
      flash_item<96, 2, 0>(QB + tok0 * 768 + h * 96, 768, KB + (size_t)(bl * 8 + h) * TL * 96, 96, VtB + (size_t)(bl * 8 + h) * 64 * TL,
                           ntl, dum ? (dum + tok0 * 1536 + 512 + h * 64) : (P + tok0 * NP + O_B + h * 64), dum ? 1536 : NP, scaleB, rq, qtok0, ropeB, 0, nullptr, smem, otid(), dum ? PR_ABL : 0);
    } else if (kind == 3) {
      u16* q = P + tok0 * NP + PD_Q + h * 64;
      flash_item<64, 1, 1>(q, NP, P + (size_t)bl * TL * NP + PD_K + h * 64, NP, VtD + (size_t)(bl * 8 + h) * 64 * TL, ntl, dum ? (dum + tok0 * 1536 + 1024 + h * 64) : q, dum ? 1536 : NP, 0.125f,
                           false, 0, ropeB, natr, p.in[26] + (size_t)(l * 8 + h) * 15 * 31, smem, otid(), dum ? PR_ABL : 0);
    } else {
      u16* q = P + tok0 * NP + (kind == 0 ? PA_Q : PD_Q) + h * 64;
      const u16* kp = (kind == 0) ? (KA + (size_t)(bl * 2 + (h >> 2)) * TL * 64) : (P + (size_t)bl * TL * NP + PD_K + h * 64);
      const u16* vp = (kind == 0) ? (VtA + (size_t)(bl * 2 + (h >> 2)) * 64 * TL) : (VtD + (size_t)(bl * 8 + h) * 64 * TL);
      flash_item<64, 2, 0>(q, NP, kp, (kind == 0) ? 64 : NP, vp, ntl, dum ? (dum + tok0 * 1536 + (kind == 0 ? 0 : 1024) + h * 64) : q, dum ? 1536 : NP, 0.125f, false, 0, ropeB, 0, nullptr, smem, otid(), dum ? PR_ABL : 0);
    }
  }
}

__device__ void phase_cout(const Params& p, int l, bool latonly) {
  const int tid = otid();
  const int lane = tid & 63, wave = tid >> 6;
  u16* P = (u16*)(p.ws + OFF_P);
  const u16* YF = (const u16*)(p.ws + OFF_YF);
  const u16* YB = (const u16*)(p.ws + OFF_YB);
  const u16* G = (const u16*)(p.ws + OFF_G);
  const float* BON = (const float*)(p.ws + OFF_BON);
  const float* gnw = p.in[24] + l * 512;
  const float* gnb = p.in[25] + l * 512;
  const float* mu = p.in[15] + l * 1920 + 1024;
  for (int tok = blockIdx.x * 4 + wave; tok < TC; tok += gridDim.x * 4) {
    const int bl = tok / TL, j = tok - bl * TL;
    const bool islat = j >= 256;
    if (latonly && !islat) continue;
    const int jj = j - 256;
    const bool hasp = islat ? (jj > 0) : (j > 0);
    const bool hasn = islat ? (jj < 2047) : (j < 255);
    u16* pr = P + (size_t)tok * NP;
    for (int h = 0; h < 8; ++h) {
      const int col = h * 64 + lane;
      float y = bf2f(YF[(size_t)tok * 512 + col]) + bf2f(YB[(size_t)tok * 512 + col]);
      float mean = wave_sum(y) * (1.f / 64.f);
      float d = y - mean;
      float var = wave_sum(d * d) * (1.f / 64.f);
      float yn = d * rsqrtf(var + 64e-5f) * gnw[col] + gnb[col];
      float vc = bf2f(pr[PC_V + col]);
      float vp = hasp ? bf2f(pr[PC_V + col - NP]) : 0.f;
      float vn = hasn ? bf2f(pr[PC_V + col + NP]) : 0.f;
      float vs = vc + (0.5f * (vp + vn) - vc) * mu[col];
      float bon = BON[(size_t)tok * 16 + h * 2] + BON[(size_t)tok * 16 + h * 2 + 1];
      float oc = (yn + bon * vs) * bf2f(G[(size_t)tok * 512 + col]);
      pr[O_C + col] = f2bf(oc);
    }
  }
}

#ifndef PR_GEMM1
#define PR_GEMM1 0
#endif
#ifndef PR_MERGE
#define PR_MERGE 0
#endif
#ifndef PR_KIND
#define PR_KIND -1
#endif
__device__ void phase_probe(const Params& p, int l, int kind, unsigned char* smem) {
  u16* sm = (u16*)smem;
  u16* P = (u16*)(p.ws + OFF_P);
  u16* DUM = (u16*)(p.ws + OFF_YM);
  const float* ropeB = (const float*)(p.ws + OFF_ROPE) + 64 * 16 * 2;
  const int total = (kind == 0) ? 128 : (kind == 3 ? 2048 : 1024);
  for (int it = blockIdx.x; it < total; it += gridDim.x) {
    if (kind == 0) {
      int dir = it & 1, h = (it >> 1) & 7, bl = it >> 4;
      scan_item(p, l, bl, h, dir, 0, smem, otid(), 0);
      scan_item(p, l, bl, h, dir, 1, smem, otid(), 0);
    } else if (kind == 1) {
      int qt = it & 15, h = (it >> 4) & 7, bl = it >> 7;
      size_t tok0 = (size_t)bl * TL + 256 + qt * 128;
      flash_item<64, 2, 0>(P + tok0 * NP + PA_Q + h * 64, NP, (const u16*)(p.ws + OFF_KA) + (size_t)(bl * 2 + (h >> 2)) * TL * 64, 64,
                           (const u16*)(p.ws + OFF_VTA) + (size_t)(bl * 2 + (h >> 2)) * 64 * TL, 36, DUM + tok0 * 1024 + h * 64, 1024,
                           0.125f, false, 0, ropeB, 0, nullptr, smem, otid(), 0);
    } else if (kind == 2) {
      int qt = it & 15, h = (it >> 4) & 7, bl = it >> 7;
      size_t tok0 = (size_t)bl * TL + 256 + qt * 128;
      flash_item<96, 2, 0>((const u16*)(p.ws + OFF_QB) + tok0 * 768 + h * 96, 768, (const u16*)(p.ws + OFF_KB) + (size_t)(bl * 8 + h) * TL * 96,
                           96, (const u16*)(p.ws + OFF_VTB) + (size_t)(bl * 8 + h) * 64 * TL, 36, P + tok0 * NP + O_B + h * 64, NP,
                           0.10206207261596575f, true, qt * 128, ropeB, 0, nullptr, smem, otid(), 0);
    } else {
      int r = it & 31, h = (it >> 5) & 7, bl = it >> 8;
      size_t tok0 = (size_t)bl * TL + 256 + r * 64;
      flash_item<64, 1, 1>(P + tok0 * NP + PD_Q + h * 64, NP, P + (size_t)bl * TL * NP + PD_K + h * 64, NP,
                           (const u16*)(p.ws + OFF_VTD) + (size_t)(bl * 8 + h) * 64 * TL, 12, DUM + tok0 * 1024 + h * 64, 1024, 0.125f,
                           false, 0, ropeB, r, p.in[26] + (size_t)(l * 8 + h) * 15 * 31, smem, otid(), 0);
    }
  }
}

#define XB_TMO      128
#define XB_XCNT(j)  (256  + 64 * (j))
#define XB_XSUB(j)  (1280 + 64 * (j))
#define XB_XGEN(j)  (2304 + 64 * (j))
#define XB_TOP      3328
#define XB_TOPGEN   3392
#define XCD_BAR_WORDS 3456
#define XB_SPIN_CAP (1u << 18)
#define LAS __attribute__((address_space(3)))
DI unsigned xb_ld(unsigned* p) { return __hip_atomic_load(p, __ATOMIC_RELAXED, __HIP_MEMORY_SCOPE_AGENT); }
DI unsigned xb_add(unsigned* p, unsigned v) { return __hip_atomic_fetch_add(p, v, __ATOMIC_RELAXED, __HIP_MEMORY_SCOPE_AGENT); }
DI unsigned xb_xcc_id() { return (unsigned)__builtin_amdgcn_s_getreg((3 << 11) | 20) & 0xFu; }
#define XB_SPIN(cond, bar) do { unsigned _sp = 0; while (cond) { __builtin_amdgcn_s_sleep(1); \
    if ((++_sp & 255u) == 0u) { if (xb_ld(&(bar)[XB_TMO])) break; if (_sp > XB_SPIN_CAP) { atomicAdd(&(bar)[XB_TMO], 1u); break; } } } } while (0)
struct XcdBarrier { unsigned* bar; unsigned x; volatile LAS unsigned* st; };
DI XcdBarrier xcd_barrier_post(unsigned* bar, volatile LAS unsigned* st) {
  XcdBarrier b; b.bar = bar; b.x = xb_xcc_id(); b.st = st;
  if (threadIdx.x == 0) (void)xb_add(&bar[XB_XCNT(b.x)], 1u);
  return b;
}
DI void xcd_barrier_complete(unsigned* bar, unsigned x, unsigned& nloc, unsigned& nx) {
  const unsigned G = gridDim.x * gridDim.y * gridDim.z;
  unsigned sum, cnt, mine, sp = 0u;
  for (;;) {
    sum = 0u; cnt = 0u; mine = 0u;
#pragma unroll
    for (unsigned j = 0; j < 16; ++j) { const unsigned c = xb_ld(&bar[XB_XCNT(j)]); sum += c; cnt += (c > 0u) ? 1u : 0u; mine = (j == x) ? c : mine; }
    if (sum == G) break;
    __builtin_amdgcn_s_sleep(1);
    if ((++sp & 255u) == 0u) { if (xb_ld(&bar[XB_TMO])) break; if (sp > XB_SPIN_CAP) { atomicAdd(&bar[XB_TMO], 1u); break; } }
  }
  nloc = mine > 0u ? mine : 1u; nx = cnt > 0u ? cnt : 1u;
}
DI void xcd_barrier(const XcdBarrier& b) {
  asm volatile("s_waitcnt vmcnt(0)" ::: "memory");
  __syncthreads();
  if (threadIdx.x == 0) {
    unsigned* bar = b.bar;
    __builtin_amdgcn_s_waitcnt(0);
    unsigned nloc = b.st[0], nx = b.st[1];
    if (nloc == 0u) { xcd_barrier_complete(bar, b.x, nloc, nx); b.st[0] = nloc; b.st[1] = nx; }
    const unsigned old = xb_add(&bar[XB_XSUB(b.x)], 1u);
    const unsigned gen = old / nloc;
    if (old + 1u == (gen + 1u) * nloc) {
      __builtin_amdgcn_fence(__ATOMIC_RELEASE, "agent");
      asm volatile("s_waitcnt vmcnt(0)" ::: "memory");
      const unsigned og = xb_add(&bar[XB_TOP], 1u);
      const unsigned tg = og / nx;
      if (og + 1u == (tg + 1u) * nx) xb_add(&bar[XB_TOPGEN], 1u);
      else XB_SPIN(xb_ld(&bar[XB_TOPGEN]) == tg, bar);
      __builtin_amdgcn_fence(__ATOMIC_ACQUIRE, "agent");
      xb_add(&bar[XB_XGEN(b.x)], 1u);
      asm volatile("s_waitcnt vmcnt(0)" ::: "memory");
    } else {
      XB_SPIN(xb_ld(&bar[XB_XGEN(b.x)]) == gen, bar);
      __builtin_amdgcn_fence(__ATOMIC_ACQUIRE, "agent");
      asm volatile("s_waitcnt vmcnt(0)" ::: "memory");
    }
  }
  __syncthreads();
}

__global__ void __launch_bounds__(256, 2) fwd_megakernel(Params p) {
  extern __shared__ __attribute__((aligned(16))) unsigned char smem[];
  cg::grid_group grid = cg::this_grid();
  u16* sm = (u16*)smem;
  unsigned* xb_words = (unsigned*)(smem + SMEM_BYTES);
  if (threadIdx.x < 4) xb_words[threadIdx.x] = 0u;
  __syncthreads();
  const XcdBarrier xb = xcd_barrier_post((unsigned*)(p.ws + OFF_BAR), (volatile LAS unsigned*)xb_words);
  phase0(p, smem);
  grid.sync();
  u16* H = (u16*)(p.ws + OFF_H);
  u16* P = (u16*)(p.ws + OFF_P);
  int* ctr = (int*)(p.ws + OFF_CTR);
  for (int chunk = 0; chunk < NCHUNK; ++chunk) {
    for (int l = 0; l < 2; ++l) {
      const bool last = (l == 1);
      const u16* W = (const u16*)(p.ws + OFF_W) + (size_t)l * W_TOTAL;
      const float* mod = (const float*)(p.ws + OFF_MOD) + (size_t)l * 17 * 6144;
      phase_norm(p, chunk, l, 0, false);
      xcd_barrier(xb);
      for (int rep = 0; rep <= PR_GEMM1; ++rep) {
        gemm_phase<8, 4, true>(H, 1024, W + W_IN, 1024, NP, false, EpiStore{P, NP}, smem);
        xcd_barrier(xb);
      }
      phase_prep(p, l, sm);
      xcd_barrier(xb);
      gemm_phase<4, 4, true>(P + PB_CQ, NP, W + W_QUP, 384, 768, false, EpiStore{(u16*)(p.ws + OFF_QB), 768}, smem);
      gemm_phase<4, 4, false>(P + PB_CKV, NP, W + W_KVUP, 256, 1024, false, EpiKV{(u16*)(p.ws + OFF_KB), (u16*)(p.ws + OFF_VTB)}, smem);
      gemm_phase<4, 4, true>((const u16*)(p.ws + OFF_GL), 128, W + W_GATE, 128, 512, false, EpiStore{(u16*)(p.ws + OFF_G), 512}, smem);
      xcd_barrier(xb);
      if (PR_KIND >= 0) {
        phase_probe(p, l, PR_KIND, smem);
        xcd_barrier(xb);
      }
#ifdef PR_MIX
      if (chunk == 0) { phase_mixers(p, chunk, l, !last, ctr + 8 + l, smem, (u16*)(p.out + (size_t)BC * 2048 * 1024), PR_MIX); xcd_barrier(xb); }
#endif
      phase_mixers(p, chunk, l, !last, ctr + chunk * 2 + l, smem, nullptr, 31);
      xcd_barrier(xb);
      phase_cout(p, l, last);
      xcd_barrier(xb);
      for (int rep = 0; rep <= PR_MERGE; ++rep) {
        phase_merge(p, l, last, smem);
        xcd_barrier(xb);
      }
      gemm_phase<4, 4, true>((const u16*)(p.ws + OFF_YM), 1024, W + W_OUT, 1024, 1024, last, EpiResid{p, chunk, mod, 2048, l == 0}, smem);
      xcd_barrier(xb);
      phase_norm(p, chunk, l, 1, last);
      xcd_barrier(xb);
      gemm_phase<8, 4, true>(H, 1024, W + W_1, 1024, 4096, last, EpiRelu2{P}, smem);
      xcd_barrier(xb);
      gemm_phase<4, 4, true>(P, 4096, W + W_2, 4096, 1024, last, EpiResid{p, chunk, mod, 5120, false}, smem);
      xcd_barrier(xb);
    }
    phase_final(p, chunk);
    xcd_barrier(xb);
  }
}

extern "C" void kernel_launch(void* const* d_in, const int* in_sizes, int n_in, void* d_out, int out_size, void* d_ws,
                              size_t ws_size, hipStream_t stream) {
  static int grid_blocks = 0;
  if (!grid_blocks) {
    int dev = 0, cus = 0, per_cu = 0;
    hipGetDevice(&dev);
    hipDeviceGetAttribute(&cus, hipDeviceAttributeMultiprocessorCount, dev);
    hipFuncSetAttribute((const void*)fwd_megakernel, hipFuncAttributeMaxDynamicSharedMemorySize, SMEM_DYN);
    hipOccupancyMaxActiveBlocksPerMultiprocessor(&per_cu, fwd_megakernel, 256, SMEM_DYN);
    if (per_cu > 2) per_cu = 2;
    if (per_cu < 1) per_cu = 1;
    grid_blocks = cus * per_cu;
  }
  if (ws_size < OFF_END) fprintf(stderr, "workspace too small: %zu < %zu\n", ws_size, (size_t)OFF_END);
  Params p{};
  for (int i = 0; i < 32; ++i) p.in[i] = (const float*)d_in[i];
  p.out = (float*)d_out;
  p.ws = (unsigned char*)d_ws;
  hipMemsetAsync(d_ws, 0, 1048576, stream);
  void* args[] = {&p};
  hipError_t e = hipLaunchCooperativeKernel((void*)fwd_megakernel, dim3(grid_blocks), dim3(256), args, SMEM_DYN, stream);
  if (e != hipSuccess) fprintf(stderr, "cooperative launch failed: %s (grid %d)\n", hipGetErrorString(e), grid_blocks);
}
```

```cpp
#include <hip/hip_runtime.h>
#include <hip/hip_cooperative_groups.h>
#include <stdint.h>
#include <cstdio>
namespace cg = cooperative_groups;

typedef unsigned short u16;
typedef __attribute__((ext_vector_type(8))) short bf16x8;
typedef __attribute__((ext_vector_type(4))) float f32x4;
typedef __attribute__((ext_vector_type(2))) float v2f;
#define DI __device__ __forceinline__

#ifndef PR_ABL
#define PR_ABL 0
#endif
constexpr int SMEM_BYTES = 73728;
constexpr int SMEM_DYN = SMEM_BYTES + 64;
constexpr int DM = 1024, TL = 2304;
constexpr int BC = 8, NCHUNK = 2, TC = BC * TL;
constexpr int NP = 4992;
constexpr int PA_Q = 0, PA_K = 512, PA_V = 640, PB_CQ = 768, PB_CKV = 1152, PB_KR = 1408;
constexpr int PC_R = 1440, PC_K = 1952, PC_V = 2464, PC_WLO = 2976, PC_ALO = 3104, PC_GLO = 3232;
constexpr int PD_Q = 3360, PD_K = 3872, PD_V = 4384;
constexpr int O_A = 0, O_B = 768, O_C = 1440, O_D = 3360;

constexpr int W_IN = 0, W_G = 5111808, W_QUP = 9306112, W_KVUP = 9601024, W_GATE = 9863168, W_DEC = 9928704,
              W_AAA = 9994240, W_BR = 10059776, W_OUT = 12156928, W_1 = 13205504, W_2 = 17399808, W_TOTAL = 21594112;

constexpr size_t OFF_MOD = 0;
constexpr size_t OFF_CTR = 835584;
constexpr size_t OFF_BAR = 851968;
constexpr size_t OFF_ROPE = 1048576;
constexpr size_t OFF_W = 2097152;
constexpr size_t OFF_H = OFF_W + (size_t)2 * W_TOTAL * 2;
constexpr size_t OFF_P = OFF_H + (size_t)TC * 1024 * 2;
constexpr size_t OFF_KA = OFF_P + (size_t)TC * NP * 2;
constexpr size_t OFF_VTA = OFF_KA + (size_t)BC * 2 * TL * 64 * 2;
constexpr size_t OFF_QB = OFF_VTA + (size_t)BC * 2 * TL * 64 * 2;
constexpr size_t OFF_KB = OFF_QB + (size_t)TC * 768 * 2;
constexpr size_t OFF_VTB = OFF_KB + (size_t)TC * 768 * 2;
constexpr size_t OFF_VTD = OFF_VTB + (size_t)TC * 512 * 2;
constexpr size_t OFF_GL = OFF_VTD + (size_t)TC * 512 * 2;
constexpr size_t OFF_G = OFF_GL + (size_t)TC * 128 * 2;
constexpr size_t OFF_YF = OFF_G + (size_t)TC * 512 * 2;
constexpr size_t OFF_YB = OFF_YF + (size_t)TC * 512 * 2;
constexpr size_t OFF_BON = OFF_YB + (size_t)TC * 512 * 2;
constexpr size_t OFF_XC = OFF_BON + (size_t)TC * 16 * 4;
constexpr size_t OFF_END = OFF_XC + (size_t)BC * 256 * 1024 * 4;
constexpr size_t OFF_YM = OFF_QB;

struct Params {
  const float* in[32];
  float* out;
  unsigned char* ws;
};

DI u16 f2bf(float f) { uint32_t u = __float_as_uint(f); u += 0x7fffu + ((u >> 16) & 1u); return (u16)(u >> 16); }
DI float bf2f(u16 h) { return __uint_as_float(((uint32_t)h) << 16); }
typedef __bf16 bf2_t __attribute__((ext_vector_type(2)));
DI uint32_t pack2(float a, float b) { v2f v = {a, b}; bf2_t r = __builtin_convertvector(v, bf2_t); return __builtin_bit_cast(uint32_t, r); }
DI float lo2f(uint32_t u) { return __uint_as_float(u << 16); }
DI float hi2f(uint32_t u) { return __uint_as_float(u & 0xffff0000u); }
DI float dpp_f(float v, const int ctrl_is_unused) { return v; }
#define DPP_ADD(v, ctrl) ((v) + __int_as_float(__builtin_amdgcn_update_dpp(0, __float_as_int(v), (ctrl), 0xF, 0xF, true)))
DI float row8_sum(float v) {
  v = DPP_ADD(v, 0xB1); v = DPP_ADD(v, 0x4E); v = DPP_ADD(v, 0x141);
  return v;
}
DI float row16_sum(float v) {
  v = DPP_ADD(v, 0xB1); v = DPP_ADD(v, 0x4E); v = DPP_ADD(v, 0x141); v = DPP_ADD(v, 0x140);
  return v;
}
DI float xq_sum(float v) {
  auto r = __builtin_amdgcn_permlane16_swap(__float_as_uint(v), __float_as_uint(v), false, false);
  v = __uint_as_float(r[0]) + __uint_as_float(r[1]);
  auto r2 = __builtin_amdgcn_permlane32_swap(__float_as_uint(v), __float_as_uint(v), false, false);
  return __uint_as_float(r2[0]) + __uint_as_float(r2[1]);
}
DI float xq_max(float v) {
  auto r = __builtin_amdgcn_permlane16_swap(__float_as_uint(v), __float_as_uint(v), false, false);
  v = fmaxf(__uint_as_float(r[0]), __uint_as_float(r[1]));
  auto r2 = __builtin_amdgcn_permlane32_swap(__float_as_uint(v), __float_as_uint(v), false, false);
  return fmaxf(__uint_as_float(r2[0]), __uint_as_float(r2[1]));
}
DI float wave_sum(float v) { return xq_sum(row16_sum(v)); }
DI float quad_sum(float v) {
  v += __int_as_float(__builtin_amdgcn_update_dpp(0, __float_as_int(v), 0xB1, 0xF, 0xF, true));
  v += __int_as_float(__builtin_amdgcn_update_dpp(0, __float_as_int(v), 0x4E, 0xF, 0xF, true));
  return v;
}
DI int otid() { int t = threadIdx.x; asm volatile("" : "+v"(t)); return t; }
DI float sigmoidf_(float x) { return 1.f / (1.f + __expf(-x)); }

DI float* x1_row(const Params& p, int chunk, int row) {
  int bl = row / TL, j = row - bl * TL;
  if (j < 256) return (float*)(p.ws + OFF_XC) + ((size_t)(bl * 256 + j)) * DM;
  return p.out + ((size_t)((chunk * BC + bl) * 2048 + (j - 256))) * DM;
}
DI const float* xin_row(const Params& p, int chunk, int row) {
  int bl = row / TL, j = row - bl * TL;
  int b = chunk * BC + bl;
  if (j < 256) return p.in[2] + ((size_t)(b * 256 + j)) * DM;
  return p.in[0] + ((size_t)(b * 2048 + (j - 256))) * DM;
}
DI int mod_row(int chunk, int row) {
  int bl = row / TL, j = row - bl * TL;
  return (j < 256) ? 16 : (chunk * BC + bl);
}

__constant__ int CONVTAB[16][8] = {
  {8, 1024 * 8992, 0, 1024, 8992, 0, 4896, W_IN},
  {8, 1024 * 8992, 0, 1024, 8992, 4896, 4096, W_G},
  {13, 384 * 768, 0, 384, 768, 0, 768, W_QUP},
  {14, 256 * 1024, 0, 256, 1024, 0, 1024, W_KVUP},
  {20, 128 * 512, 0, 128, 512, 0, 512, W_GATE},
  {17, 2 * 64 * 512, 0, 64, 512, 0, 512, W_DEC},
  {17, 2 * 64 * 512, 64 * 512, 64, 512, 0, 512, W_DEC + 512 * 64},
  {19, 2 * 64 * 512, 0, 64, 512, 0, 512, W_AAA},
  {19, 2 * 64 * 512, 64 * 512, 64, 512, 0, 512, W_AAA + 512 * 64},
  {27, 4 * 512 * 1024, 0, 512, 1024, 0, 1024, W_BR},
  {27, 4 * 512 * 1024, 512 * 1024, 512, 1024, 0, 1024, W_BR + 1024 * 512},
  {27, 4 * 512 * 1024, 2 * 512 * 1024, 512, 1024, 0, 1024, W_BR + 2 * 1024 * 512},
  {27, 4 * 512 * 1024, 3 * 512 * 1024, 512, 1024, 0, 1024, W_BR + 3 * 1024 * 512},
  {28, 1024 * 1024, 0, 1024, 1024, 0, 1024, W_OUT},
  {29, 1024 * 4096, 0, 1024, 4096, 0, 4096, W_1},
  {30, 4096 * 1024, 0, 4096, 1024, 0, 1024, W_2},
};
constexpr int CONV_TILES_PER_LAYER = 1232 + 1024 + 72 + 64 + 16 + 8 + 8 + 8 + 8 + 128 * 4 + 256 + 1024 + 1024;

__device__ void conv_tile(const float* __restrict__ src, int ld, int k0, int n0, int ncols, u16* __restrict__ dst, int K,
                          float* tile, const int tid) {
  {
    const int c4 = (tid & 15) * 4;
#pragma unroll
    for (int i = 0; i < 4; ++i) {
      int r = (tid >> 4) + 16 * i;
      float4 v = make_float4(0.f, 0.f, 0.f, 0.f);
      if (n0 + c4 < ncols) v = *(const float4*)(src + (size_t)(k0 + r) * ld + n0 + c4);
      tile[r * 65 + c4 + 0] = v.x; tile[r * 65 + c4 + 1] = v.y; tile[r * 65 + c4 + 2] = v.z; tile[r * 65 + c4 + 3] = v.w;
    }
  }
  __syncthreads();
  {
    const int n = tid >> 2, kc = (tid & 3) * 16;
    if (n0 + n < ncols) {
      uint32_t w[8];
#pragma unroll
      for (int i = 0; i < 8; ++i) w[i] = pack2(tile[(kc + 2 * i) * 65 + n], tile[(kc + 2 * i + 1) * 65 + n]);
      uint4* d = (uint4*)(dst + (size_t)(n0 + n) * K + k0 + kc);
      d[0] = make_uint4(w[0], w[1], w[2], w[3]);
      d[1] = make_uint4(w[4], w[5], w[6], w[7]);
    }
  }
  __syncthreads();
}

__device__ void phase0(const Params& p, unsigned char* smem) {
  float* fsm = (float*)smem;
  const int tid = otid();
  const int n_conv = 2 * CONV_TILES_PER_LAYER;
  const int n_pad = 2 * 48;
  const int n_ada = 2 * 16 * 24;
  const int total = n_conv + n_pad + n_ada + 1;
  u16* wbase = (u16*)(p.ws + OFF_W);
  for (int it = blockIdx.x; it < total; it += gridDim.x) {
    if (it < n_conv) {
      int l = it / CONV_TILES_PER_LAYER, r = it - l * CONV_TILES_PER_LAYER;
      int job = 0;
      for (; job < 16; ++job) {
        int nt = (CONVTAB[job][3] >> 6) * ((CONVTAB[job][6] + 63) >> 6);
        if (r < nt) break;
        r -= nt;
      }
      const int K = CONVTAB[job][3], ld = CONVTAB[job][4], col0 = CONVTAB[job][5], ncols = CONVTAB[job][6];
      const int nkt = K >> 6;
      const int kt = r % nkt, ntile = r / nkt;
      const float* src = p.in[CONVTAB[job][0]] + (size_t)l * CONVTAB[job][1] + CONVTAB[job][2] + col0;
      u16* dst = wbase + (size_t)l * W_TOTAL + CONVTAB[job][7];
      conv_tile(src, ld, kt * 64, ntile * 64, ncols, dst, K, fsm, tid);
    } else if (it < n_conv + n_pad) {
      int r = it - n_conv;
      int l = r / 48, q = r - l * 48;
      u16* dst = wbase + (size_t)l * W_TOTAL + W_IN + (size_t)(4896 + q * 2) * 1024;
      *(uint4*)(dst + tid * 8) = make_uint4(0, 0, 0, 0);
    } else if (it < n_conv + n_pad + n_ada) {
      int r = it - n_conv - n_pad;
      int l = r / 384; r -= l * 384;
      int kc = r / 24, nb = r - kc * 24;
      for (int idx = tid; idx < 17 * 64; idx += 256) {
        int rr = idx >> 6, k = idx & 63;
        float cv = (rr < 16) ? p.in[1][rr * 1024 + kc * 64 + k] : p.in[3][kc * 64 + k];
        fsm[idx] = cv / (1.f + expf(-cv));
      }
      __syncthreads();
      const int n = nb * 256 + tid;
      float acc[17];
#pragma unroll
      for (int i = 0; i < 17; ++i) acc[i] = 0.f;
      const float* wp = p.in[4] + ((size_t)l * 1024 + kc * 64) * 6144 + n;
#pragma unroll 4
      for (int k = 0; k < 64; ++k) {
        float w = wp[(size_t)k * 6144];
#pragma unroll
        for (int i = 0; i < 17; ++i) acc[i] += fsm[i * 64 + k] * w;
      }
      float bias = (kc == 0) ? p.in[5][l * 6144 + n] : 0.f;
      float* mod = (float*)(p.ws + OFF_MOD);
#pragma unroll
      for (int i = 0; i < 17; ++i) atomicAdd(&mod[(size_t)(l * 17 + i) * 6144 + n], acc[i] + bias);
      __syncthreads();
    } else {
      float* ra = (float*)(p.ws + OFF_ROPE);
      float* rb = ra + 64 * 16 * 2;
      for (int idx = tid; idx < 64 * 16; idx += 256) {
        int pos = idx >> 4, i = idx & 15;
        float inv = powf(10000.f, -(float)i / 16.f);
        float ang = (float)pos * inv;
        ra[idx * 2] = cosf(ang); ra[idx * 2 + 1] = sinf(ang);
      }
      for (int idx = tid; idx < 64 * 8; idx += 256) {
        int pos = idx >> 3, i = idx & 7;
        float inv = powf(10000.f, -(float)i / 8.f);
        float ang = (float)pos * inv;
        rb[idx * 2] = cosf(ang); rb[idx * 2 + 1] = sinf(ang);
      }
    }
  }
}

__device__ void phase_norm(const Params& p, int chunk, int l, int which, bool latonly) {
  const int tid = otid();
  const int lane = tid & 63, wave = tid >> 6;
  const float* g = p.in[which == 0 ? 6 : 7] + l * 1024;
  const float* mod = (const float*)(p.ws + OFF_MOD) + (size_t)l * 17 * 6144;
  u16* H = (u16*)(p.ws + OFF_H);
  for (int row = blockIdx.x * 4 + wave; row < TC; row += gridDim.x * 4) {
    int j = row % TL;
    if (latonly && j < 256) continue;
    const float* src = (which == 0 && l == 0) ? xin_row(p, chunk, row) : (const float*)x1_row(p, chunk, row);
    const float* mr = mod + (size_t)mod_row(chunk, row) * 6144 + which * 3072;
    float4 v[4];
    float ss = 0.f;
#pragma unroll
    for (int i = 0; i < 4; ++i) {
      v[i] = *(const float4*)(src + i * 256 + lane * 4);
      ss += v[i].x * v[i].x + v[i].y * v[i].y + v[i].z * v[i].z + v[i].w * v[i].w;
    }
    ss = wave_sum(ss);
    float rs = rsqrtf(ss * (1.f / 1024.f) + 1e-6f);
#pragma unroll
    for (int i = 0; i < 4; ++i) {
      int c = i * 256 + lane * 4;
      float4 gg = *(const float4*)(g + c);
      float4 sh = *(const float4*)(mr + c);
      float4 sc = *(const float4*)(mr + 1024 + c);
      float a0 = v[i].x * rs * gg.x * (1.f + sc.x) + sh.x;
      float a1 = v[i].y * rs * gg.y * (1.f + sc.y) + sh.y;
      float a2 = v[i].z * rs * gg.z * (1.f + sc.z) + sh.z;
      float a3 = v[i].w * rs * gg.w * (1.f + sc.w) + sh.w;
      *(uint2*)(H + (size_t)row * 1024 + c) = make_uint2(pack2(a0, a1), pack2(a2, a3));
    }
  }
}

__device__ void phase_final(const Params& p, int chunk) {
  const int tid = otid();
  const int lane = tid & 63, wave = tid >> 6;
  const float* g = p.in[31];
  for (int r = blockIdx.x * 4 + wave; r < BC * 2048; r += gridDim.x * 4) {
    float* px = p.out + ((size_t)chunk * BC * 2048 + r) * DM;
    float4 v[4];
    float ss = 0.f;
#pragma unroll
    for (int i = 0; i < 4; ++i) {
      v[i] = *(const float4*)(px + i * 256 + lane * 4);
      ss += v[i].x * v[i].x + v[i].y * v[i].y + v[i].z * v[i].z + v[i].w * v[i].w;
    }
    ss = wave_sum(ss);
    float rs = rsqrtf(ss * (1.f / 1024.f) + 1e-6f);
#pragma unroll
    for (int i = 0; i < 4; ++i) {
      int c = i * 256 + lane * 4;
      float4 gg = *(const float4*)(g + c);
      *(float4*)(px + c) = make_float4(v[i].x * rs * gg.x, v[i].y * rs * gg.y, v[i].z * rs * gg.z, v[i].w * rs * gg.w);
    }
  }
}

#define GEMM_WAIT_VM(n) asm volatile("s_waitcnt vmcnt(" #n ")" ::: "memory")
DI void raw_barrier() { asm volatile("s_waitcnt lgkmcnt(0)" ::: "memory"); __builtin_amdgcn_s_barrier(); }
template <int MI, int NI, bool TR>
DI void gemm_dma(const u16* __restrict__ A, int lda, const u16* __restrict__ Bt, int ldb, int K, f32x4 (&acc)[MI][NI],
                 unsigned char* smem, const int tid) {
  constexpr int BM = 32 * MI, BN = 32 * NI;
  constexpr int SB = (BM + BN) * 64;
  constexpr int NS = (73728 / SB) >= 4 ? 4 : 3;
  constexpr int LA = BM / 64, LB = BN / 64, LPT = LA + LB;
  static_assert(LPT == 3 || LPT == 4 || LPT == 6, "unexpected tile");
  const int lane = tid & 63, wave = tid >> 6, l15 = lane & 15, quad = lane >> 4;
  const int wm = wave >> 1, wn = wave & 1;
  const int drow = tid >> 2;
  const int g4 = (0x1230 >> (((drow >> 2) & 3) * 4)) & 3;
  const int dc = (tid & 3) ^ g4;
  const u16* Asrc = A + (size_t)drow * lda + dc * 8;
  const u16* Bsrc = Bt + (size_t)drow * ldb + dc * 8;
  unsigned char* dstw = smem + __builtin_amdgcn_readfirstlane(tid >> 6) * 1024;
  auto issue = [&](int kt, int buf) {
    const int ko = kt * 32;
#pragma unroll
    for (int j = 0; j < LA; ++j)
      __builtin_amdgcn_global_load_lds((const unsigned*)(Asrc + (size_t)(j * 64) * lda + ko), (unsigned*)(dstw + buf * SB + j * 4096), 16, 0, 0);
#pragma unroll
    for (int j = 0; j < LB; ++j)
      __builtin_amdgcn_global_load_lds((const unsigned*)(Bsrc + (size_t)(j * 64) * ldb + ko), (unsigned*)(dstw + buf * SB + (LA + j) * 4096), 16, 0, 0);
  };
  const int rg4 = (0x1230 >> ((l15 >> 2) * 4)) & 3;
  const int aoff = (wm * 16 * MI + l15) * 64 + ((quad ^ rg4) * 16);
  const int boff = BM * 64 + (wn * 16 * NI + l15) * 64 + ((quad ^ rg4) * 16);
  const int nk = K >> 5;
  GEMM_WAIT_VM(0);
#pragma unroll
  for (int s_ = 0; s_ < NS - 1; ++s_)
    if (s_ < nk) issue(s_, s_);
  int buf = 0;
  for (int kt = 0; kt < nk; ++kt) {
    const int rem = nk - 1 - kt;
    if (NS == 4) {
      if (rem >= 2) { if (LPT == 3) GEMM_WAIT_VM(6); else if (LPT == 4) GEMM_WAIT_VM(8); else GEMM_WAIT_VM(12); }
      else if (rem == 1) { if (LPT == 3) GEMM_WAIT_VM(3); else if (LPT == 4) GEMM_WAIT_VM(4); else GEMM_WAIT_VM(6); }
      else GEMM_WAIT_VM(0);
    } else {
      if (rem >= 1) { if (LPT == 3) GEMM_WAIT_VM(3); else if (LPT == 4) GEMM_WAIT_VM(4); else GEMM_WAIT_VM(6); }
      else GEMM_WAIT_VM(0);
    }
    raw_barrier();
    if (kt + NS - 1 < nk) { int nb = buf + NS - 1; if (nb >= NS) nb -= NS; issue(kt + NS - 1, nb); }
    const unsigned char* st = smem + buf * SB;
    bf16x8 af[MI], bfr[NI];
#pragma unroll
    for (int mi = 0; mi < MI; ++mi) af[mi] = *(const bf16x8*)(st + aoff + mi * 1024);
#pragma unroll
    for (int ni = 0; ni < NI; ++ni) bfr[ni] = *(const bf16x8*)(st + boff + ni * 1024);
    __builtin_amdgcn_s_setprio(1);
#pragma unroll
    for (int mi = 0; mi < MI; ++mi)
#pragma unroll
      for (int ni = 0; ni < NI; ++ni)
        acc[mi][ni] = TR ? __builtin_amdgcn_mfma_f32_16x16x32_bf16(bfr[ni], af[mi], acc[mi][ni], 0, 0, 0)
                         : __builtin_amdgcn_mfma_f32_16x16x32_bf16(af[mi], bfr[ni], acc[mi][ni], 0, 0, 0);
    __builtin_amdgcn_s_setprio(0);
    if (++buf == NS) buf = 0;
  }
  raw_barrier();
}

DI bool tile_map(int t, int nMg, int nNt, bool latonly, int MT, int& mt, int& nt) {
  int x = t & 7, rest = t >> 3;
  int ni = rest & 7, q = rest >> 3;
  int mg = q % nMg, ng = q / nMg;
  nt = ng * 8 + ni;
  if (nt >= nNt) return false;
  int mti = mg * 8 + x;
  if (MT == 128) mt = latonly ? ((mti >> 4) * 18 + 2 + (mti & 15)) : mti;
  else mt = latonly ? ((mti >> 3) * 9 + 1 + (mti & 7)) : mti;
  return true;
}

template <int MI, int NI, bool TR, class Epi>
__device__ void gemm_phase(const u16* A, int lda, const u16* Bt, int K, int N, bool latonly, Epi epi, unsigned char* smem) {
  constexpr int BM = 32 * MI, BN = 32 * NI;
  const int nMg = (BM == 128) ? (latonly ? 16 : 18) : (latonly ? 8 : 9);
  const int nNt = N / BN;
  const int total = 64 * nMg * ((nNt + 7) >> 3);
  const int tid = otid();
  const int lane = tid & 63, wave = tid >> 6, l15 = lane & 15, quad = lane >> 4;
  const int wm = wave >> 1, wn = wave & 1;
  for (int t = blockIdx.x; t < total; t += gridDim.x) {
    int mt, nt;
    if (!tile_map(t, nMg, nNt, latonly, BM, mt, nt)) continue;
    const int m0 = mt * BM, n0 = nt * BN;
    f32x4 acc[MI][NI];
#pragma unroll
    for (int mi = 0; mi < MI; ++mi)
#pragma unroll
      for (int ni = 0; ni < NI; ++ni) acc[mi][ni] = (f32x4){0.f, 0.f, 0.f, 0.f};
    gemm_dma<MI, NI, TR>(A + (size_t)m0 * lda, lda, Bt + (size_t)n0 * K, K, K, acc, smem, tid);
    if constexpr (Epi::BATCH) {
#pragma unroll
      for (int mi = 0; mi < MI; ++mi) epi.template row<NI>(m0 + wm * 16 * MI + mi * 16 + l15, n0 + wn * 16 * NI + quad * 4, acc[mi]);
    } else {
#pragma unroll
      for (int mi = 0; mi < MI; ++mi)
#pragma unroll
        for (int ni = 0; ni < NI; ++ni) {
          if (TR) epi(m0 + wm * 16 * MI + mi * 16 + l15, n0 + wn * 16 * NI + ni * 16 + quad * 4, acc[mi][ni]);
          else epi(m0 + wm * 16 * MI + mi * 16 + quad * 4, n0 + wn * 16 * NI + ni * 16 + l15, acc[mi][ni]);
        }
    }
  }
}

struct EpiStore {
  u16* C; int ldc;
  static constexpr bool BATCH = false;
  DI void operator()(int r, int c0, f32x4 v) const {
    *(uint2*)(C + (size_t)r * ldc + c0) = make_uint2(pack2(v[0], v[1]), pack2(v[2], v[3]));
  }
};
struct EpiKV {
  u16* KB; u16* VtB;
  static constexpr bool BATCH = false;
  DI void operator()(int r0, int c, f32x4 v) const {
    int bl = r0 / TL, j0 = r0 - bl * TL;
    int head = c >> 7, w = c & 127;
    if (w < 64) {
#pragma unroll
      for (int j = 0; j < 4; ++j) KB[((size_t)(bl * 8 + head) * TL + j0 + j) * 96 + w] = f2bf(v[j]);
    } else {
      *(uint2*)(VtB + ((size_t)(bl * 8 + head) * 64 + (w - 64)) * TL + j0) = make_uint2(pack2(v[0], v[1]), pack2(v[2], v[3]));
    }
  }
};
struct EpiRelu2 {
  u16* C;
  static constexpr bool BATCH = false;
  DI void operator()(int r, int c0, f32x4 v) const {
    float t0 = fmaxf(v[0], 0.f), t1 = fmaxf(v[1], 0.f), t2 = fmaxf(v[2], 0.f), t3 = fmaxf(v[3], 0.f);
    *(uint2*)(C + (size_t)r * 4096 + c0) = make_uint2(pack2(t0 * t0, t1 * t1), pack2(t2 * t2, t3 * t3));
  }
};
struct EpiResid {
  Params p; int chunk; const float* mod; int gofs; bool from_input;
  static constexpr bool BATCH = true;
  template <int NI>
  DI void row(int r, int c0, const f32x4 (&v)[NI]) const {
    const float* gtp = mod + (size_t)mod_row(chunk, r) * 6144 + gofs + c0;
    float* dst = x1_row(p, chunk, r) + c0;
    const float* src = from_input ? (xin_row(p, chunk, r) + c0) : (const float*)dst;
    float4 gt[NI], xin[NI];
#pragma unroll
    for (int ni = 0; ni < NI; ++ni) { gt[ni] = *(const float4*)(gtp + ni * 16); xin[ni] = *(const float4*)(src + ni * 16); }
#pragma unroll
    for (int ni = 0; ni < NI; ++ni)
      *(float4*)(dst + ni * 16) = make_float4(xin[ni].x + gt[ni].x * v[ni][0], xin[ni].y + gt[ni].y * v[ni][1],
                                              xin[ni].z + gt[ni].z * v[ni][2], xin[ni].w + gt[ni].w * v[ni][3]);
  }
};

__device__ void phase_merge(const Params& p, int l, bool latonly, unsigned char* smem) {
  const u16* H = (const u16*)(p.ws + OFF_H);
  const u16* P = (const u16*)(p.ws + OFF_P);
  const u16* W = (const u16*)(p.ws + OFF_W) + (size_t)l * W_TOTAL;
  u16* YM = (u16*)(p.ws + OFF_YM);
  const int nMg = latonly ? 16 : 18;
  const int nNt = 8;
  const int total = 64 * nMg;
  const int tid = otid();
  const int lane = tid & 63, wave = tid >> 6, l15 = lane & 15, quad = lane >> 4;
  const int wm = wave >> 1, wn = wave & 1;
  for (int t = blockIdx.x; t < total; t += gridDim.x) {
    int mt, nt;
    if (!tile_map(t, nMg, nNt, latonly, 128, mt, nt)) continue;
    const int m0 = mt * 128, n0 = nt * 128;
    uint2 yp[4][4];
#pragma unroll
    for (int mi = 0; mi < 4; ++mi)
#pragma unroll
      for (int ni = 0; ni < 4; ++ni) yp[mi][ni] = make_uint2(0u, 0u);
    for (int i = 0; i < 4; ++i) {
      const int ocol = (i == 0) ? O_A : (i == 1) ? O_B : (i == 2) ? O_C : O_D;
      uint2 gp[4][4];
      {
        f32x4 g[4][4];
#pragma unroll
        for (int mi = 0; mi < 4; ++mi)
#pragma unroll
          for (int ni = 0; ni < 4; ++ni) g[mi][ni] = (f32x4){0.f, 0.f, 0.f, 0.f};
        gemm_dma<4, 4, true>(H + (size_t)m0 * 1024, 1024, W + W_G + (size_t)(i * 1024 + n0) * 1024, 1024, 1024, g, smem, tid);
#pragma unroll
        for (int mi = 0; mi < 4; ++mi)
#pragma unroll
          for (int ni = 0; ni < 4; ++ni)
            gp[mi][ni] = make_uint2(pack2(sigmoidf_(g[mi][ni][0]), sigmoidf_(g[mi][ni][1])), pack2(sigmoidf_(g[mi][ni][2]), sigmoidf_(g[mi][ni][3])));
      }
      f32x4 b[4][4];
#pragma unroll
      for (int mi = 0; mi < 4; ++mi)
#pragma unroll
        for (int ni = 0; ni < 4; ++ni) b[mi][ni] = (f32x4){0.f, 0.f, 0.f, 0.f};
      gemm_dma<4, 4, true>(P + (size_t)m0 * NP + ocol, NP, W + W_BR + (size_t)(i * 1024 + n0) * 512, 512, 512, b, smem, tid);
#pragma unroll
      for (int mi = 0; mi < 4; ++mi)
#pragma unroll
        for (int ni = 0; ni < 4; ++ni) {
          const float y0 = lo2f(yp[mi][ni].x) + lo2f(gp[mi][ni].x) * b[mi][ni][0];
          const float y1 = hi2f(yp[mi][ni].x) + hi2f(gp[mi][ni].x) * b[mi][ni][1];
          const float y2 = lo2f(yp[mi][ni].y) + lo2f(gp[mi][ni].y) * b[mi][ni][2];
          const float y3 = hi2f(yp[mi][ni].y) + hi2f(gp[mi][ni].y) * b[mi][ni][3];
          yp[mi][ni] = make_uint2(pack2(y0, y1), pack2(y2, y3));
        }
    }
#pragma unroll
    for (int mi = 0; mi < 4; ++mi)
#pragma unroll
      for (int ni = 0; ni < 4; ++ni)
        *(uint2*)(YM + (size_t)(m0 + wm * 64 + mi * 16 + l15) * 1024 + n0 + wn * 64 + ni * 16 + quad * 4) = yp[mi][ni];
  }
}

__device__ void transpose64(const u16* __restrict__ src, int lds_, u16* __restrict__ dst, int ldd, u16* tile, const int tid) {
  {
    const int r = tid >> 2, c = (tid & 3) * 16;
    uint4 a = *(const uint4*)(src + (size_t)r * lds_ + c);
    uint4 b = *(const uint4*)(src + (size_t)r * lds_ + c + 8);
    uint32_t* t32 = (uint32_t*)(tile + r * 66 + c);
    t32[0] = a.x; t32[1] = a.y; t32[2] = a.z; t32[3] = a.w; t32[4] = b.x; t32[5] = b.y; t32[6] = b.z; t32[7] = b.w;
  }
  __syncthreads();
  {
    const int d = tid >> 2, tc = (tid & 3) * 16;
    uint32_t w[8];
#pragma unroll
    for (int i = 0; i < 8; ++i) w[i] = (uint32_t)tile[(tc + 2 * i) * 66 + d] | ((uint32_t)tile[(tc + 2 * i + 1) * 66 + d] << 16);
    uint4* o = (uint4*)(dst + (size_t)d * ldd + tc);
    o[0] = make_uint4(w[0], w[1], w[2], w[3]);
    o[1] = make_uint4(w[4], w[5], w[6], w[7]);
  }
  __syncthreads();
}

__device__ void phase_prep(const Params& p, int l, u16* sm) {
  const int tid = otid();
  const int lane = tid & 63, wave = tid >> 6;
  u16* P = (u16*)(p.ws + OFF_P);
  u16* KA = (u16*)(p.ws + OFF_KA);
  u16* VtA = (u16*)(p.ws + OFF_VTA);
  u16* KB = (u16*)(p.ws + OFF_KB);
  u16* VtD = (u16*)(p.ws + OFF_VTD);
  u16* GL = (u16*)(p.ws + OFF_GL);
  const float* ropeA = (const float*)(p.ws + OFF_ROPE);
  const float* ropeB = ropeA + 64 * 16 * 2;
  const float aqg = p.in[9][l * 64 + lane], akg = p.in[10][l * 64 + lane];
  const float* bqg = p.in[11] + l * 384;
  const float* bkvg = p.in[12] + l * 256;
  const float* mu = p.in[15] + l * 1920;
  for (int tok = blockIdx.x * 4 + wave; tok < TC; tok += gridDim.x * 4) {
    const int bl = tok / TL, j = tok - bl * TL;
    const bool islat = j >= 256;
    const int jj = j - 256;
    const int grow = (jj >> 6) & 31, gcol = jj & 63;
    u16* pr = P + (size_t)tok * NP;
    const bool hasp = islat ? (jj > 0) : (j > 0);
    const bool hasn = islat ? (jj < 2047) : (j < 255);
    u16 xa[10], xq[6], xkv[4], xkr, gcur[2], gprv[2], gnxt[2];
#pragma unroll
    for (int h = 0; h < 10; ++h) xa[h] = pr[h * 64 + lane];
#pragma unroll
    for (int i = 0; i < 6; ++i) xq[i] = pr[PB_CQ + lane + 64 * i];
#pragma unroll
    for (int i = 0; i < 4; ++i) xkv[i] = pr[PB_CKV + lane + 64 * i];
    xkr = pr[PB_KR + (lane & 31)];
#pragma unroll
    for (int i = 0; i < 2; ++i) {
      const int c = lane + 64 * i;
      gcur[i] = pr[PC_GLO + c];
      gprv[i] = hasp ? pr[PC_GLO + c - NP] : (u16)0;
      gnxt[i] = hasn ? pr[PC_GLO + c + NP] : (u16)0;
    }
    float ca = 1.f, sa = 0.f, cb = 1.f, sb = 0.f;
    if (islat) {
      const int pos = (lane < 32) ? grow : gcol;
      ca = ropeA[(pos * 16 + (lane & 15)) * 2];
      sa = ropeA[(pos * 16 + (lane & 15)) * 2 + 1];
      const int posb = ((lane & 31) < 16) ? grow : gcol;
      cb = ropeB[(posb * 8 + (lane & 7)) * 2];
      sb = ropeB[(posb * 8 + (lane & 7)) * 2 + 1];
    }
#pragma unroll
    for (int h = 0; h < 10; ++h) {
      const float x = bf2f(xa[h]);
      const float ss = wave_sum(x * x);
      const float y = x * rsqrtf(ss * (1.f / 64.f) + 1e-6f) * (h < 8 ? aqg : akg);
      const float yp = __shfl_xor(y, 16);
      const float o = ((lane & 16) == 0) ? (y * ca - yp * sa) : (yp * sa + y * ca);
      if (h < 8) pr[h * 64 + lane] = f2bf(o);
      else KA[((size_t)(bl * 2 + (h - 8)) * TL + j) * 64 + lane] = f2bf(o);
    }
    {
      float x[6], ss = 0.f;
#pragma unroll
      for (int i = 0; i < 6; ++i) { x[i] = bf2f(xq[i]); ss += x[i] * x[i]; }
      ss = wave_sum(ss);
      const float rs = rsqrtf(ss * (1.f / 384.f) + 1e-6f);
#pragma unroll
      for (int i = 0; i < 6; ++i) pr[PB_CQ + lane + 64 * i] = f2bf(x[i] * rs * bqg[lane + 64 * i]);
    }
    {
      float x[4], ss = 0.f;
#pragma unroll
      for (int i = 0; i < 4; ++i) { x[i] = bf2f(xkv[i]); ss += x[i] * x[i]; }
      ss = wave_sum(ss);
      const float rs = rsqrtf(ss * (1.f / 256.f) + 1e-6f);
#pragma unroll
      for (int i = 0; i < 4; ++i) pr[PB_CKV + lane + 64 * i] = f2bf(x[i] * rs * bkvg[lane + 64 * i]);
    }
    {
      const float x = bf2f(xkr);
      const float xp = __shfl_xor(x, 8);
      const float o = ((lane & 8) == 0) ? (x * cb - xp * sb) : (xp * sb + x * cb);
      if (lane < 32) {
        const u16 ob = f2bf(o);
#pragma unroll
        for (int h = 0; h < 8; ++h) KB[((size_t)(bl * 8 + h) * TL + j) * 96 + 64 + lane] = ob;
      }
    }
#pragma unroll
    for (int i = 0; i < 2; ++i) {
      const int c = lane + 64 * i;
      const float cur = bf2f(gcur[i]);
      const float z = cur + (0.5f * (bf2f(gprv[i]) + bf2f(gnxt[i])) - cur) * mu[1792 + c];
      GL[(size_t)tok * 128 + c] = f2bf(sigmoidf_(z));
    }
  }
  for (int it = blockIdx.x; it < (TC / 64) * 10; it += gridDim.x) {
    int tg = it / 10, hh = it - tg * 10;
    int tok0 = tg * 64, bl = tok0 / TL, j0 = tok0 - bl * TL;
    if (hh < 2) transpose64(P + (size_t)tok0 * NP + PA_V + hh * 64, NP, VtA + ((size_t)(bl * 2 + hh) * 64) * TL + j0, TL, sm, tid);
    else transpose64(P + (size_t)tok0 * NP + PD_V + (hh - 2) * 64, NP, VtD + ((size_t)(bl * 8 + hh - 2) * 64) * TL + j0, TL, sm, tid);
  }
}

template <int DQK, int NQ, int MODE>
__device__ void flash_item(const u16* __restrict__ Qp, int ldq, const u16* __restrict__ Kp, int ldk, const u16* __restrict__ Vtp,
                           int ntiles, u16* __restrict__ Op, int ldo, float scale, bool ropeq, int qtok0,
                           const float* __restrict__ ropeB, int nat_r, const float* __restrict__ bias_g, unsigned char* smem, const int tid, const int abl) {
  constexpr int KS = DQK / 32;
  constexpr int DCH = DQK / 8;
  constexpr int KB_ = 64 * DQK * 2;
  constexpr int SBF = KB_ + 8192;
  constexpr int NS = (DQK == 64) ? 4 : 3;
  constexpr int LK = (64 * DCH) / 256, LPT = LK + 2;
  float* sBias = (float*)(smem + NS * SBF);
  const int lane = tid & 63, wave = tid >> 6, l15 = lane & 15, quad = lane >> 4;
  const float L2E = 1.4426950408889634f;
  int r0 = 0;
  if (MODE == 1) {
    r0 = min(max(nat_r - 4, 0), 24);
    for (int i = tid; i < 15 * 31; i += 256) sBias[i] = bias_g[i];
  }
  bf16x8 qf[NQ][KS];
#pragma unroll
  for (int qi = 0; qi < NQ; ++qi) {
    const int row = wave * 16 * NQ + qi * 16 + l15;
#pragma unroll
    for (int ks = 0; ks < KS; ++ks) qf[qi][ks] = *(const bf16x8*)(Qp + (size_t)row * ldq + ks * 32 + quad * 8);
    if (DQK == 96 && ropeq) {
      bf16x8 own = qf[qi][KS - 1];
      bf16x8 par = *(const bf16x8*)(Qp + (size_t)row * ldq + 64 + (quad ^ 1) * 8);
      const int qt = qtok0 + row;
      const int pos = (quad < 2) ? ((qt >> 6) & 31) : (qt & 63);
      bf16x8 res;
#pragma unroll
      for (int i = 0; i < 8; ++i) {
        float c = ropeB[(pos * 8 + i) * 2], s = ropeB[(pos * 8 + i) * 2 + 1];
        float xo = bf2f((u16)own[i]), xp = bf2f((u16)par[i]);
        float o = ((quad & 1) == 0) ? (xo * c - xp * s) : (xp * s + xo * c);
        res[i] = (short)f2bf(o);
      }
      qf[qi][KS - 1] = res;
    }
  }
  auto koff = [&](int t) -> int { return (MODE == 1) ? ((t < 8) ? (256 + (r0 + t) * 64) : ((t - 8) * 64)) : t * 64; };
  unsigned char* dstw = smem + __builtin_amdgcn_readfirstlane(tid >> 6) * 1024;
  auto issue = [&](int t, int buf) {
    const int ko = koff(t);
#pragma unroll
    for (int i = 0; i < LK; ++i) {
      const int L = tid + 256 * i;
      int row, c;
      if (DQK == 64) { row = L >> 3; c = (L & 7) ^ (row & 7); }
      else { row = L / 12; const int pp = L - row * 12; c = (pp & ~3) | ((pp & 3) ^ ((0x1230 >> (((row >> 2) & 3) * 4)) & 3)); }
      __builtin_amdgcn_global_load_lds((const unsigned*)(Kp + (size_t)(ko + row) * ldk + c * 8), (unsigned*)(dstw + buf * SBF + i * 4096), 16, 0, 0);
    }
#pragma unroll
    for (int i = 0; i < 2; ++i) {
      const int L = tid + 256 * i;
      const int d = L >> 3, c = (L & 7) ^ (d & 7);
      __builtin_amdgcn_global_load_lds((const unsigned*)(Vtp + (size_t)d * TL + ko + c * 8), (unsigned*)(dstw + buf * SBF + KB_ + i * 4096), 16, 0, 0);
    }
  };
  int koffs[KS];
#pragma unroll
  for (int ks = 0; ks < KS; ++ks) {
    const int c = ks * 4 + quad;
    if (DQK == 64) koffs[ks] = l15 * 128 + ((c ^ (l15 & 7)) * 16);
    else koffs[ks] = l15 * 192 + (((c & ~3) | ((c & 3) ^ ((0x1230 >> ((l15 >> 2) * 4)) & 3))) * 16);
  }
  int voffs[2][2];
#pragma unroll
  for (int kk = 0; kk < 2; ++kk)
#pragma unroll
    for (int ab = 0; ab < 2; ++ab) {
      const int keyb = ((2 * kk + ab) * 16 + quad * 4) * 2;
      const int c = keyb >> 4;
      voffs[kk][ab] = l15 * 128 + ((c ^ (l15 & 7)) * 16) + (keyb & 15);
    }
  f32x4 o[4][NQ];
  float m[NQ], lsum[NQ];
#pragma unroll
  for (int qi = 0; qi < NQ; ++qi) {
    m[qi] = -INFINITY; lsum[qi] = 0.f;
#pragma unroll
    for (int dt = 0; dt < 4; ++dt) o[dt][qi] = (f32x4){0.f, 0.f, 0.f, 0.f};
  }
  const int qc = wave * 16 + l15;
  const int st = min(max(qc - 8, 0), 48);
  GEMM_WAIT_VM(0);
#pragma unroll
  for (int s_ = 0; s_ < NS - 1; ++s_)
    if (s_ < ntiles) issue(s_, s_);
  int buf = 0;
  for (int t = 0; t < ntiles; ++t) {
    if (!(abl & 4)) {
      const int rem = ntiles - 1 - t;
      if (NS == 4) {
        if (rem >= 2) GEMM_WAIT_VM(8); else if (rem == 1) GEMM_WAIT_VM(4); else GEMM_WAIT_VM(0);
      } else {
        if (rem >= 1) GEMM_WAIT_VM(5); else GEMM_WAIT_VM(0);
      }
    }
    if (!(abl & 8)) raw_barrier();
    if (!(abl & 4) && t + NS - 1 < ntiles) { int nb = buf + NS - 1; if (nb >= NS) nb -= NS; issue(t + NS - 1, nb); }
    const unsigned char* k_s = smem + buf * SBF;
    const unsigned char* v_s = k_s + KB_;
    f32x4 s[4][NQ];
    {
      bf16x8 kf[4][KS];
#pragma unroll
      for (int kt = 0; kt < 4; ++kt)
#pragma unroll
        for (int ks = 0; ks < KS; ++ks) kf[kt][ks] = *(const bf16x8*)(k_s + kt * 16 * DQK * 2 + koffs[ks]);
      __builtin_amdgcn_sched_barrier(0);
#pragma unroll
      for (int kt = 0; kt < 4; ++kt) {
#pragma unroll
        for (int qi = 0; qi < NQ; ++qi) s[kt][qi] = (f32x4){0.f, 0.f, 0.f, 0.f};
#pragma unroll
        for (int ks = 0; ks < KS; ++ks)
#pragma unroll
          for (int qi = 0; qi < NQ; ++qi) s[kt][qi] = __builtin_amdgcn_mfma_f32_16x16x32_bf16(kf[kt][ks], qf[qi][ks], s[kt][qi], 0, 0, 0);
      }
    }
    uint2 vfa[2][4], vfb[2][4];
#pragma unroll
    for (int kk = 0; kk < 2; ++kk)
#pragma unroll
      for (int dt = 0; dt < 4; ++dt) {
        vfa[kk][dt] = *(const uint2*)(v_s + dt * 2048 + voffs[kk][0]);
        vfb[kk][dt] = *(const uint2*)(v_s + dt * 2048 + voffs[kk][1]);
      }
    __builtin_amdgcn_sched_barrier(0);
    const float c2 = scale * L2E;
    if (MODE == 1 && t < 8) {
      const int drow = r0 + t - nat_r + 7;
#pragma unroll
      for (int kt = 0; kt < 4; ++kt)
#pragma unroll
        for (int j = 0; j < 4; ++j) {
          int kc = kt * 16 + quad * 4 + j;
          bool valid = (kc >= st) && (kc < st + 16);
          int bi = drow * 31 + (kc - qc + 15);
          bi = valid ? bi : 0;
          float bv = sBias[bi];
          s[kt][0][j] = valid ? (s[kt][0][j] * c2 + bv * L2E) : -INFINITY;
        }
    }
    const bool pre = (MODE == 1 && t < 8);
    bf16x8 pb[NQ][2];
    if (abl & 1) {
#pragma unroll
      for (int qi = 0; qi < NQ; ++qi)
#pragma unroll
        for (int kk = 0; kk < 2; ++kk) {
          uint4 u = make_uint4(pack2(s[2 * kk][qi][0], s[2 * kk][qi][1]), pack2(s[2 * kk][qi][2], s[2 * kk][qi][3]),
                               pack2(s[2 * kk + 1][qi][0], s[2 * kk + 1][qi][1]), pack2(s[2 * kk + 1][qi][2], s[2 * kk + 1][qi][3]));
          pb[qi][kk] = __builtin_bit_cast(bf16x8, u);
        }
    } else
#pragma unroll
    for (int qi = 0; qi < NQ; ++qi) {
      float mx = fmaxf(fmaxf(s[0][qi][0], s[0][qi][1]), fmaxf(s[0][qi][2], s[0][qi][3]));
#pragma unroll
      for (int kt = 1; kt < 4; ++kt) mx = fmaxf(mx, fmaxf(fmaxf(s[kt][qi][0], s[kt][qi][1]), fmaxf(s[kt][qi][2], s[kt][qi][3])));
      mx = xq_max(mx);
      const float cc = pre ? 1.f : c2;
      const float mnew = fmaxf(m[qi], mx * cc);
      const bool grew = __builtin_amdgcn_ballot_w64(mnew > m[qi]) != 0;
      const float alpha = __builtin_amdgcn_exp2f(m[qi] - mnew);
      m[qi] = mnew;
      float ps = 0.f;
#pragma unroll
      for (int kt = 0; kt < 4; ++kt)
#pragma unroll
        for (int j = 0; j < 4; ++j) {
          float pv = __builtin_amdgcn_exp2f(s[kt][qi][j] * cc - mnew);
          s[kt][qi][j] = pv;
          ps += pv;
        }
      if (grew) {
        lsum[qi] *= alpha;
#pragma unroll
        for (int dt = 0; dt < 4; ++dt)
#pragma unroll
          for (int j = 0; j < 4; ++j) o[dt][qi][j] *= alpha;
      }
      lsum[qi] += ps;
#pragma unroll
      for (int kk = 0; kk < 2; ++kk) {
        uint4 u = make_uint4(pack2(s[2 * kk][qi][0], s[2 * kk][qi][1]), pack2(s[2 * kk][qi][2], s[2 * kk][qi][3]),
                             pack2(s[2 * kk + 1][qi][0], s[2 * kk + 1][qi][1]), pack2(s[2 * kk + 1][qi][2], s[2 * kk + 1][qi][3]));
        pb[qi][kk] = __builtin_bit_cast(bf16x8, u);
      }
    }
#pragma unroll
    for (int kk = 0; kk < 2; ++kk)
#pragma unroll
      for (int dt = 0; dt < 4; ++dt) {
        uint4 vv = make_uint4(vfa[kk][dt].x, vfa[kk][dt].y, vfb[kk][dt].x, vfb[kk][dt].y);
        bf16x8 av = __builtin_bit_cast(bf16x8, vv);
#pragma unroll
        for (int qi = 0; qi < NQ; ++qi) o[dt][qi] = __builtin_amdgcn_mfma_f32_16x16x32_bf16(av, pb[qi][kk], o[dt][qi], 0, 0, 0);
      }
    if (++buf == NS) buf = 0;
  }
  raw_barrier();
#pragma unroll
  for (int qi = 0; qi < NQ; ++qi) {
    float l = xq_sum(lsum[qi]);
    const float inv = 1.f / l;
    const int row = wave * 16 * NQ + qi * 16 + l15;
#pragma unroll
    for (int dt = 0; dt < 4; ++dt)
      *(uint2*)(Op + (size_t)row * ldo + dt * 16 + quad * 4) =
          make_uint2(pack2(o[dt][qi][0] * inv, o[dt][qi][1] * inv), pack2(o[dt][qi][2] * inv, o[dt][qi][3] * inv));
  }
}

__device__ void scan_item(const Params& p, int l, int bl, int h, int dir, int half, unsigned char* smem, const int tid, const int abl) {
  float* R = (float*)smem;
  float* V = R + 2048;
  float* KK = V + 2048;
  float* KD = KK + 2048;
  float* W = KD + 2048;
  float* T1 = W + 2048;
  float* Y = T1 + 2048;
  float* BONW = Y + 2048;
  u16* XW = (u16*)(BONW + 128);
  u16* XA = XW + 32 * 72;
  const int lane = tid & 63, wave = tid >> 6, l15 = lane & 15, quad = lane >> 4;
  const u16* P = (const u16*)(p.ws + OFF_P);
  u16* Yd = (u16*)(p.ws + (dir ? OFF_YB : OFF_YF));
  float* BON = (float*)(p.ws + OFF_BON);
  const u16* Wl = (const u16*)(p.ws + OFF_W) + (size_t)l * W_TOTAL;
  const float* mu = p.in[15] + l * 1920;
  const int nn = wave * 16 + l15;
  const float w0 = p.in[16][(l * 2 + dir) * 512 + h * 64 + nn];
  const float a0 = p.in[18][(l * 2 + dir) * 512 + h * 64 + nn];
  const float ka = p.in[22][l * 512 + h * 64 + nn];
  const float rk = p.in[23][l * 512 + h * 64 + nn];
  bf16x8 wdec[2], waaa[2];
#pragma unroll
  for (int ks = 0; ks < 2; ++ks) {
    wdec[ks] = *(const bf16x8*)(Wl + W_DEC + ((size_t)dir * 512 + h * 64 + nn) * 64 + ks * 32 + quad * 8);
    waaa[ks] = *(const bf16x8*)(Wl + W_AAA + ((size_t)dir * 512 + h * 64 + nn) * 64 + ks * 32 + quad * 8);
  }
  const int st_t = tid >> 3, part = tid & 7, n0 = part * 8;
  const int sl = lane & 7, srow = half * 32 + wave * 8 + (lane >> 3);
  v2f S2[4];
#pragma unroll
  for (int i = 0; i < 4; ++i) S2[i] = (v2f){0.f, 0.f};
  float* MU = (float*)(XA + 32 * 72);
  float* KKC = MU + 320;
  for (int i = tid; i < 384; i += 256) {
    int g = i >> 6, n = i & 63;
    float v;
    if (g == 0) v = mu[h * 64 + n];
    else if (g == 1) v = mu[1024 + h * 64 + n];
    else if (g == 2) v = mu[512 + h * 64 + n];
    else if (g == 3) v = mu[1536 + dir * 64 + n];
    else if (g == 4) v = mu[1664 + dir * 64 + n];
    else v = p.in[21][l * 512 + h * 64 + n];
    MU[i] = v;
  }
  uint4 raw[15];
  auto issue_raw = [&](int cidx) {
    const int seg = cidx >= 8;
    const int cc = seg ? cidx - 8 : cidx, nch = seg ? 64 : 8, len = seg ? 2048 : 256;
    const int tb = bl * TL + (seg ? 256 : 0);
    const int c = dir ? (nch - 1 - cc) : cc;
    const int pos = c * 32 + st_t;
    const bool hasp = pos > 0, hasn = pos < len - 1;
    const u16* rowp = P + (size_t)(tb + pos) * NP + n0;
    const int cols[5] = {PC_R + h * 64, PC_V + h * 64, PC_K + h * 64, PC_WLO + dir * 64, PC_ALO + dir * 64};
#pragma unroll
    for (int g = 0; g < 5; ++g) {
      raw[3 * g] = *(const uint4*)(rowp + cols[g]);
      raw[3 * g + 1] = make_uint4(0, 0, 0, 0);
      raw[3 * g + 2] = make_uint4(0, 0, 0, 0);
      if (hasp) raw[3 * g + 1] = *(const uint4*)(rowp + cols[g] - NP);
      if (hasn) raw[3 * g + 2] = *(const uint4*)(rowp + cols[g] + NP);
    }
  };
  issue_raw(0);
  __syncthreads();

  for (int cidx = 0; cidx < 72; ++cidx) {
    {
      const int seg = cidx >= 8;
      const int cc = seg ? cidx - 8 : cidx, nch = seg ? 64 : 8;
      const int tb = bl * TL + (seg ? 256 : 0);
      const int c = dir ? (nch - 1 - cc) : cc;
      const int pos0 = c * 32;
      {
#define SHIFT8(G, z)                                                                              \
  {                                                                                               \
    const uint4 c4 = raw[3 * (G)], p4 = raw[3 * (G) + 1], n4 = raw[3 * (G) + 2];                  \
    const float4 m0 = *(const float4*)(MU + (G)*64 + n0), m1 = *(const float4*)(MU + (G)*64 + n0 + 4); \
    const float mm[8] = {m0.x, m0.y, m0.z, m0.w, m1.x, m1.y, m1.z, m1.w};                          \
    const uint32_t cu[4] = {c4.x, c4.y, c4.z, c4.w}, pu[4] = {p4.x, p4.y, p4.z, p4.w}, nu[4] = {n4.x, n4.y, n4.z, n4.w}; \
    _Pragma("unroll") for (int i = 0; i < 4; ++i) {                                               \
      float c0 = lo2f(cu[i]), c1 = hi2f(cu[i]);                                                   \
      z[2 * i] = c0 + (0.5f * (lo2f(pu[i]) + lo2f(nu[i])) - c0) * mm[2 * i];                      \
      z[2 * i + 1] = c1 + (0.5f * (hi2f(pu[i]) + hi2f(nu[i])) - c1) * mm[2 * i + 1];              \
    }                                                                                             \
  }
        float z[8];
        SHIFT8(0, z);
        *(float4*)(R + st_t * 64 + n0) = make_float4(z[0], z[1], z[2], z[3]);
        *(float4*)(R + st_t * 64 + n0 + 4) = make_float4(z[4], z[5], z[6], z[7]);
        SHIFT8(1, z);
        *(float4*)(V + st_t * 64 + n0) = make_float4(z[0], z[1], z[2], z[3]);
        *(float4*)(V + st_t * 64 + n0 + 4) = make_float4(z[4], z[5], z[6], z[7]);
        SHIFT8(2, z);
        {
          const float4 k0 = *(const float4*)(KKC + n0), k1 = *(const float4*)(KKC + n0 + 4);
          const float kc[8] = {k0.x, k0.y, k0.z, k0.w, k1.x, k1.y, k1.z, k1.w};
          float q[8], ss = 0.f;
#pragma unroll
          for (int i = 0; i < 8; ++i) { q[i] = z[i] * kc[i]; ss += q[i] * q[i]; }
          *(float4*)(KD + st_t * 64 + n0) = make_float4(z[0], z[1], z[2], z[3]);
          *(float4*)(KD + st_t * 64 + n0 + 4) = make_float4(z[4], z[5], z[6], z[7]);
          ss = row8_sum(ss);
          const float inv = 1.f / fmaxf(sqrtf(ss), 1e-12f);
          *(float4*)(KK + st_t * 64 + n0) = make_float4(q[0] * inv, q[1] * inv, q[2] * inv, q[3] * inv);
          *(float4*)(KK + st_t * 64 + n0 + 4) = make_float4(q[4] * inv, q[5] * inv, q[6] * inv, q[7] * inv);
        }
        SHIFT8(3, z);
        {
          float th[8];
#pragma unroll
          for (int i = 0; i < 8; ++i) th[i] = 1.f - 2.f / (1.f + __expf(2.f * z[i]));
          *(uint4*)(XW + st_t * 72 + n0) = make_uint4(pack2(th[0], th[1]), pack2(th[2], th[3]), pack2(th[4], th[5]), pack2(th[6], th[7]));
        }
        SHIFT8(4, z);
        *(uint4*)(XA + st_t * 72 + n0) = make_uint4(pack2(z[0], z[1]), pack2(z[2], z[3]), pack2(z[4], z[5]), pack2(z[6], z[7]));
#undef SHIFT8
      }
      raw_barrier();
#pragma unroll
      for (int mt = 0; mt < 2; ++mt) {
        f32x4 aw = (f32x4){0.f, 0.f, 0.f, 0.f}, aa = (f32x4){0.f, 0.f, 0.f, 0.f};
#pragma unroll
        for (int ks = 0; ks < 2; ++ks) {
          bf16x8 xw = *(const bf16x8*)(XW + (mt * 16 + l15) * 72 + ks * 32 + quad * 8);
          bf16x8 xa = *(const bf16x8*)(XA + (mt * 16 + l15) * 72 + ks * 32 + quad * 8);
          aw = __builtin_amdgcn_mfma_f32_16x16x32_bf16(xw, wdec[ks], aw, 0, 0, 0);
          aa = __builtin_amdgcn_mfma_f32_16x16x32_bf16(xa, waaa[ks], aa, 0, 0, 0);
        }
#pragma unroll
        for (int j = 0; j < 4; ++j) {
          const int t = mt * 16 + quad * 4 + j;
          const float wv = __expf(-0.6065306597126334f / (1.f + __expf(-(w0 + aw[j]))));
          const float av = 1.f / (1.f + __expf(-(a0 + aa[j])));
          W[t * 64 + nn] = wv;
          T1[t * 64 + nn] = KK[t * 64 + nn] * av;
          const float kd = KD[t * 64 + nn] * (1.f + (av - 1.f) * ka);
          KD[t * 64 + nn] = kd;
          const float bon = row16_sum(R[t * 64 + nn] * kd * rk);
          if (l15 == 0) BONW[wave * 32 + t] = bon;
        }
      }
      if (cidx + 1 < 72) issue_raw(cidx + 1);
      raw_barrier();
      {
        float4 Akk0, Akk1, At0, At1, Ad0, Ad1, Aw0, Aw1, Ar0, Ar1, Bkk0, Bkk1, Bt0, Bt1, Bd0, Bd1, Bw0, Bw1, Br0, Br1;
        float Av, Bv;
#define SCAN_LOAD(X, I)                                                  \
  {                                                                      \
    const int o_ = (I) * 64 + sl * 8;                                    \
    X##kk0 = *(const float4*)(KK + o_); X##kk1 = *(const float4*)(KK + o_ + 4); \
    X##t0 = *(const float4*)(T1 + o_);  X##t1 = *(const float4*)(T1 + o_ + 4);  \
    X##d0 = *(const float4*)(KD + o_);  X##d1 = *(const float4*)(KD + o_ + 4);  \
    X##w0 = *(const float4*)(W + o_);   X##w1 = *(const float4*)(W + o_ + 4);   \
    X##r0 = *(const float4*)(R + o_);   X##r1 = *(const float4*)(R + o_ + 4);   \
    X##v = V[(I) * 64 + srow];                                           \
  }
#define SCAN_PRE(C, KDv, Wv)    \
  const v2f tmp##C = S2[C] * (Wv) + vv0 * (KDv);
#define SCAN_EL(C, T1v, Rv)                                              \
  {                                                                      \
    const v2f t1_ = T1v, r_ = Rv;                                        \
    S2[C] = tmp##C + nsa0 * t1_;                                         \
    if ((C) & 1) y1 += S2[C] * r_; else y0 += S2[C] * r_;                \
  }
#define SCAN_STEP(X, I)                                                  \
  {                                                                      \
    const v2f k0 = (v2f){X##kk0.x, X##kk0.y}, k1 = (v2f){X##kk0.z, X##kk0.w}, k2 = (v2f){X##kk1.x, X##kk1.y}, k3 = (v2f){X##kk1.z, X##kk1.w}; \
    v2f a0 = S2[0] * k0, a0b = S2[1] * k1;                               \
    a0 += S2[2] * k2; a0b += S2[3] * k3;                                 \
    a0 += a0b;                                                           \
    const v2f vv0 = (v2f){X##v, X##v};                                   \
    SCAN_PRE(0, ((v2f){X##d0.x, X##d0.y}), ((v2f){X##w0.x, X##w0.y}))    \
    SCAN_PRE(1, ((v2f){X##d0.z, X##d0.w}), ((v2f){X##w0.z, X##w0.w}))    \
    SCAN_PRE(2, ((v2f){X##d1.x, X##d1.y}), ((v2f){X##w1.x, X##w1.y}))    \
    SCAN_PRE(3, ((v2f){X##d1.z, X##d1.w}), ((v2f){X##w1.z, X##w1.w}))    \
    const float sa0 = row8_sum(a0.x + a0.y);                             \
    const v2f nsa0 = (v2f){-sa0, -sa0};                                  \
    v2f y0 = (v2f){0.f, 0.f}, y1 = (v2f){0.f, 0.f};                      \
    SCAN_EL(0, ((v2f){X##t0.x, X##t0.y}), ((v2f){X##r0.x, X##r0.y}))     \
    SCAN_EL(1, ((v2f){X##t0.z, X##t0.w}), ((v2f){X##r0.z, X##r0.w}))     \
    SCAN_EL(2, ((v2f){X##t1.x, X##t1.y}), ((v2f){X##r1.x, X##r1.y}))     \
    SCAN_EL(3, ((v2f){X##t1.z, X##t1.w}), ((v2f){X##r1.z, X##r1.w}))     \
    y0 += y1;                                                            \
    const float ys0 = row8_sum(y0.x + y0.y);                             \
    if (sl == 0) Y[(I) * 64 + srow] = ys0;                               \
  }
        SCAN_LOAD(A, dir ? 31 : 0);
        for (int s = 0; s < ((abl & 32) ? 0 : 32); s += 2) {
          const int i0 = dir ? (31 - s) : s, i1 = dir ? (30 - s) : (s + 1);
          SCAN_LOAD(B, i1);
          SCAN_STEP(A, i0);
          if (s + 2 < 32) { SCAN_LOAD(A, dir ? (29 - s) : (s + 2)); }
          SCAN_STEP(B, i1);
        }
#undef SCAN_LOAD
#undef SCAN_EL
#undef SCAN_PRE
#undef SCAN_STEP
      }
      raw_barrier();
      {
        const float* yp = Y + st_t * 64 + half * 32 + part * 4;
        const size_t tok = (size_t)(tb + pos0 + st_t);
        *(uint2*)(Yd + tok * 512 + h * 64 + half * 32 + part * 4) = make_uint2(pack2(yp[0], yp[1]), pack2(yp[2], yp[3]));
        if (part == 0 && half == 0) BON[tok * 16 + h * 2 + dir] = BONW[st_t] + BONW[32 + st_t] + BONW[64 + st_t] + BONW[96 + st_t];
      }
    }
  }
  __syncthreads();
}

__device__ void phase_mixers(const Params& p, int chunk, int l, bool with_ctx, int* counter, unsigned char* smem, u16* dum, int kmask) {
  int& s_item = *(int*)(smem + SMEM_BYTES + 16);
  u16* sm = (u16*)smem;
  u16* P = (u16*)(p.ws + OFF_P);
  const u16* KA = (const u16*)(p.ws + OFF_KA);
  const u16* VtA = (const u16*)(p.ws + OFF_VTA);
  const u16* QB = (const u16*)(p.ws + OFF_QB);
  const u16* KB = (const u16*)(p.ws + OFF_KB);
  const u16* VtB = (const u16*)(p.ws + OFF_VTB);
  const u16* VtD = (const u16*)(p.ws + OFF_VTD);
  const float* ropeB = (const float*)(p.ws + OFF_ROPE) + 64 * 16 * 2;
  const int n_scan = BC * 8 * 2 * 2;
  const int n_al = BC * 8 * 16;
  const int n_nat = BC * 8 * 32;
  const int n_cx = BC * 8 * 2;
  const int total = n_scan + 2 * n_al + n_nat + (with_ctx ? 3 * n_cx : 0);
  const float scaleB = 0.10206207261596575f;
  while (true) {
    const int tid = otid();
    if (tid == 0) s_item = atomicAdd(counter, 1);
    __syncthreads();
    int it = s_item;
    __syncthreads();
    if (it >= total) break;
    if (it < n_scan) {
      if (!(kmask & 1)) continue;
      int half = it & 1, dir = (it >> 1) & 1, h = (it >> 2) & 7, bl = it >> 5;
      __builtin_amdgcn_s_setprio(3);
      scan_item(p, l, bl, h, dir, half, smem, otid(), dum ? PR_ABL : 0);
      __builtin_amdgcn_s_setprio(0);
      continue;
    }
    it -= n_scan;
    int kind, h, bl, ntl;
    size_t tok0;
    bool rq = false;
    int qtok0 = 0, natr = 0;
    if (it < 2 * n_al) {
      kind = (it >= n_al) ? 1 : 0;
      int i2 = it - kind * n_al;
      int qt = i2 & 15; h = (i2 >> 4) & 7; bl = i2 >> 7;
      tok0 = (size_t)bl * TL + 256 + qt * 128; ntl = 36; rq = true; qtok0 = qt * 128;
    } else if (it < 2 * n_al + n_nat) {
      int i2 = it - 2 * n_al;
      kind = 3; natr = i2 & 31; h = (i2 >> 5) & 7; bl = i2 >> 8;
      tok0 = (size_t)bl * TL + 256 + natr * 64; ntl = 12;
    } else {
      int i2 = it - 2 * n_al - n_nat;
      kind = i2 / n_cx; i2 -= kind * n_cx;
      int qt = i2 & 1; h = (i2 >> 1) & 7; bl = i2 >> 4;
      tok0 = (size_t)bl * TL + qt * 128; ntl = 4;
    }
    {
      const int cls = (ntl == 36) ? (kind == 0 ? 2 : 4) : (ntl == 12 ? 8 : 16);
      if (!(kmask & cls)) continue;
    }
    if (kind == 1) {
      flash_item<96, 2, 0>(QB + tok0 * 768 + h * 96, 768, KB + (size_t)(bl * 8 + h) * TL * 96, 96, VtB + (size_t)(bl * 8 + h) * 64 * TL,
                           ntl, dum ? (dum + tok0 * 1536 + 512 + h * 64) : (P + tok0 * NP + O_B + h * 64), dum ? 1536 : NP, scaleB, rq, qtok0, ropeB, 0, nullptr, smem, otid(), dum ? PR_ABL : 0);
    } else if (kind == 3) {
      u16* q = P + tok0 * NP + PD_Q + h * 64;
      flash_item<64, 1, 1>(q, NP, P + (size_t)bl * TL * NP + PD_K + h * 64, NP, VtD + (size_t)(bl * 8 + h) * 64 * TL, ntl, dum ? (dum + tok0 * 1536 + 1024 + h * 64) : q, dum ? 1536 : NP, 0.125f,
                           false, 0, ropeB, natr, p.in[26] + (size_t)(l * 8 + h) * 15 * 31, smem, otid(), dum ? PR_ABL : 0);
    } else {
      u16* q = P + tok0 * NP + (kind == 0 ? PA_Q : PD_Q) + h * 64;
      const u16* kp = (kind == 0) ? (KA + (size_t)(bl * 2 + (h >> 2)) * TL * 64) : (P + (size_t)bl * TL * NP + PD_K + h * 64);
      const u16* vp = (kind == 0) ? (VtA + (size_t)(bl * 2 + (h >> 2)) * 64 * TL) : (VtD + (size_t)(bl * 8 + h) * 64 * TL);
      flash_item<64, 2, 0>(q, NP, kp, (kind == 0) ? 64 : NP, vp, ntl, dum ? (dum + tok0 * 1536 + (kind == 0 ? 0 : 1024) + h * 64) : q, dum ? 1536 : NP, 0.125f, false, 0, ropeB, 0, nullptr, smem, otid(), dum ? PR_ABL : 0);
    }
  }
}

__device__ void phase_cout(const Params& p, int l, bool latonly) {
  const int tid = otid();
  const int lane = tid & 63, wave = tid >> 6;
  u16* P = (u16*)(p.ws + OFF_P);
  const u16* YF = (const u16*)(p.ws + OFF_YF);
  const u16* YB = (const u16*)(p.ws + OFF_YB);
  const u16* G = (const u16*)(p.ws + OFF_G);
  const float* BON = (const float*)(p.ws + OFF_BON);
  const float* gnw = p.in[24] + l * 512;
  const float* gnb = p.in[25] + l * 512;
  const float* mu = p.in[15] + l * 1920 + 1024;
  for (int tok = blockIdx.x * 4 + wave; tok < TC; tok += gridDim.x * 4) {
    const int bl = tok / TL, j = tok - bl * TL;
    const bool islat = j >= 256;
    if (latonly && !islat) continue;
    const int jj = j - 256;
    const bool hasp = islat ? (jj > 0) : (j > 0);
    const bool hasn = islat ? (jj < 2047) : (j < 255);
    u16* pr = P + (size_t)tok * NP;
    u16 yf[8], yb[8], gg[8], vcu[8], vpu[8], vnu[8];
    float bon[8];
#pragma unroll
    for (int h = 0; h < 8; ++h) {
      const int col = h * 64 + lane;
      yf[h] = YF[(size_t)tok * 512 + col];
      yb[h] = YB[(size_t)tok * 512 + col];
      gg[h] = G[(size_t)tok * 512 + col];
      vcu[h] = pr[PC_V + col];
      vpu[h] = hasp ? pr[PC_V + col - NP] : (u16)0;
      vnu[h] = hasn ? pr[PC_V + col + NP] : (u16)0;
      bon[h] = BON[(size_t)tok * 16 + h * 2] + BON[(size_t)tok * 16 + h * 2 + 1];
    }
#pragma unroll
    for (int h = 0; h < 8; ++h) {
      const int col = h * 64 + lane;
      const float y = bf2f(yf[h]) + bf2f(yb[h]);
      const float mean = wave_sum(y) * (1.f / 64.f);
      const float d = y - mean;
      const float var = wave_sum(d * d) * (1.f / 64.f);
      const float yn = d * rsqrtf(var + 64e-5f) * gnw[col] + gnb[col];
      const float vc = bf2f(vcu[h]);
      const float vs = vc + (0.5f * (bf2f(vpu[h]) + bf2f(vnu[h])) - vc) * mu[col];
      const float oc = (yn + bon[h] * vs) * bf2f(gg[h]);
      pr[O_C + col] = f2bf(oc);
    }
  }
}

#ifndef PR_GEMM1
#define PR_GEMM1 0
#endif
#ifndef PR_MERGE
#define PR_MERGE 0
#endif
#ifndef PR_KIND
#define PR_KIND -1
#endif
__device__ void phase_probe(const Params& p, int l, int kind, unsigned char* smem) {
  u16* sm = (u16*)smem;
  u16* P = (u16*)(p.ws + OFF_P);
  u16* DUM = (u16*)(p.ws + OFF_YM);
  const float* ropeB = (const float*)(p.ws + OFF_ROPE) + 64 * 16 * 2;
  const int total = (kind == 0) ? 128 : (kind == 3 ? 2048 : 1024);
  for (int it = blockIdx.x; it < total; it += gridDim.x) {
    if (kind == 0) {
      int dir = it & 1, h = (it >> 1) & 7, bl = it >> 4;
      scan_item(p, l, bl, h, dir, 0, smem, otid(), 0);
      scan_item(p, l, bl, h, dir, 1, smem, otid(), 0);
    } else if (kind == 1) {
      int qt = it & 15, h = (it >> 4) & 7, bl = it >> 7;
      size_t tok0 = (size_t)bl * TL + 256 + qt * 128;
      flash_item<64, 2, 0>(P + tok0 * NP + PA_Q + h * 64, NP, (const u16*)(p.ws + OFF_KA) + (size_t)(bl * 2 + (h >> 2)) * TL * 64, 64,
                           (const u16*)(p.ws + OFF_VTA) + (size_t)(bl * 2 + (h >> 2)) * 64 * TL, 36, DUM + tok0 * 1024 + h * 64, 1024,
                           0.125f, false, 0, ropeB, 0, nullptr, smem, otid(), 0);
    } else if (kind == 2) {
      int qt = it & 15, h = (it >> 4) & 7, bl = it >> 7;
      size_t tok0 = (size_t)bl * TL + 256 + qt * 128;
      flash_item<96, 2, 0>((const u16*)(p.ws + OFF_QB) + tok0 * 768 + h * 96, 768, (const u16*)(p.ws + OFF_KB) + (size_t)(bl * 8 + h) * TL * 96,
                           96, (const u16*)(p.ws + OFF_VTB) + (size_t)(bl * 8 + h) * 64 * TL, 36, P + tok0 * NP + O_B + h * 64, NP,
                           0.10206207261596575f, true, qt * 128, ropeB, 0, nullptr, smem, otid(), 0);
    } else {
      int r = it & 31, h = (it >> 5) & 7, bl = it >> 8;
      size_t tok0 = (size_t)bl * TL + 256 + r * 64;
      flash_item<64, 1, 1>(P + tok0 * NP + PD_Q + h * 64, NP, P + (size_t)bl * TL * NP + PD_K + h * 64, NP,
                           (const u16*)(p.ws + OFF_VTD) + (size_t)(bl * 8 + h) * 64 * TL, 12, DUM + tok0 * 1024 + h * 64, 1024, 0.125f,
                           false, 0, ropeB, r, p.in[26] + (size_t)(l * 8 + h) * 15 * 31, smem, otid(), 0);
    }
  }
}

#define XB_TMO      128
#define XB_XCNT(j)  (256  + 64 * (j))
#define XB_XSUB(j)  (1280 + 64 * (j))
#define XB_XGEN(j)  (2304 + 64 * (j))
#define XB_TOP      3328
#define XB_TOPGEN   3392
#define XCD_BAR_WORDS 3456
#define XB_SPIN_CAP (1u << 18)
#define LAS __attribute__((address_space(3)))
DI unsigned xb_ld(unsigned* p) { return __hip_atomic_load(p, __ATOMIC_RELAXED, __HIP_MEMORY_SCOPE_AGENT); }
DI unsigned xb_add(unsigned* p, unsigned v) { return __hip_atomic_fetch_add(p, v, __ATOMIC_RELAXED, __HIP_MEMORY_SCOPE_AGENT); }
DI unsigned xb_xcc_id() { return (unsigned)__builtin_amdgcn_s_getreg((3 << 11) | 20) & 0xFu; }
#define XB_SPIN(cond, bar) do { unsigned _sp = 0; while (cond) { __builtin_amdgcn_s_sleep(1); \
    if ((++_sp & 255u) == 0u) { if (xb_ld(&(bar)[XB_TMO])) break; if (_sp > XB_SPIN_CAP) { atomicAdd(&(bar)[XB_TMO], 1u); break; } } } } while (0)
struct XcdBarrier { unsigned* bar; unsigned x; volatile LAS unsigned* st; };
DI XcdBarrier xcd_barrier_post(unsigned* bar, volatile LAS unsigned* st) {
  XcdBarrier b; b.bar = bar; b.x = xb_xcc_id(); b.st = st;
  if (threadIdx.x == 0) (void)xb_add(&bar[XB_XCNT(b.x)], 1u);
  return b;
}
DI void xcd_barrier_complete(unsigned* bar, unsigned x, unsigned& nloc, unsigned& nx) {
  const unsigned G = gridDim.x * gridDim.y * gridDim.z;
  unsigned sum, cnt, mine, sp = 0u;
  for (;;) {
    sum = 0u; cnt = 0u; mine = 0u;
#pragma unroll
    for (unsigned j = 0; j < 16; ++j) { const unsigned c = xb_ld(&bar[XB_XCNT(j)]); sum += c; cnt += (c > 0u) ? 1u : 0u; mine = (j == x) ? c : mine; }
    if (sum == G) break;
    __builtin_amdgcn_s_sleep(1);
    if ((++sp & 255u) == 0u) { if (xb_ld(&bar[XB_TMO])) break; if (sp > XB_SPIN_CAP) { atomicAdd(&bar[XB_TMO], 1u); break; } }
  }
  nloc = mine > 0u ? mine : 1u; nx = cnt > 0u ? cnt : 1u;
}
DI void xcd_barrier(const XcdBarrier& b) {
  asm volatile("s_waitcnt vmcnt(0)" ::: "memory");
  __syncthreads();
  if (threadIdx.x == 0) {
    unsigned* bar = b.bar;
    __builtin_amdgcn_s_waitcnt(0);
    unsigned nloc = b.st[0], nx = b.st[1];
    if (nloc == 0u) { xcd_barrier_complete(bar, b.x, nloc, nx); b.st[0] = nloc; b.st[1] = nx; }
    const unsigned old = xb_add(&bar[XB_XSUB(b.x)], 1u);
    const unsigned gen = old / nloc;
    if (old + 1u == (gen + 1u) * nloc) {
      __builtin_amdgcn_fence(__ATOMIC_RELEASE, "agent");
      asm volatile("s_waitcnt vmcnt(0)" ::: "memory");
      const unsigned og = xb_add(&bar[XB_TOP], 1u);
      const unsigned tg = og / nx;
      if (og + 1u == (tg + 1u) * nx) xb_add(&bar[XB_TOPGEN], 1u);
      else XB_SPIN(xb_ld(&bar[XB_TOPGEN]) == tg, bar);
      __builtin_amdgcn_fence(__ATOMIC_ACQUIRE, "agent");
      xb_add(&bar[XB_XGEN(b.x)], 1u);
      asm volatile("s_waitcnt vmcnt(0)" ::: "memory");
    } else {
      XB_SPIN(xb_ld(&bar[XB_XGEN(b.x)]) == gen, bar);
      __builtin_amdgcn_fence(__ATOMIC_ACQUIRE, "agent");
      asm volatile("s_waitcnt vmcnt(0)" ::: "memory");
    }
  }
  __syncthreads();
}

__global__ void __launch_bounds__(256, 2) fwd_megakernel(Params p) {
  extern __shared__ __attribute__((aligned(16))) unsigned char smem[];
  cg::grid_group grid = cg::this_grid();
  u16* sm = (u16*)smem;
  unsigned* xb_words = (unsigned*)(smem + SMEM_BYTES);
  if (threadIdx.x < 4) xb_words[threadIdx.x] = 0u;
  __syncthreads();
  const XcdBarrier xb = xcd_barrier_post((unsigned*)(p.ws + OFF_BAR), (volatile LAS unsigned*)xb_words);
  phase0(p, smem);
  grid.sync();
  u16* H = (u16*)(p.ws + OFF_H);
  u16* P = (u16*)(p.ws + OFF_P);
  int* ctr = (int*)(p.ws + OFF_CTR);
  for (int chunk = 0; chunk < NCHUNK; ++chunk) {
    for (int l = 0; l < 2; ++l) {
      const bool last = (l == 1);
      const u16* W = (const u16*)(p.ws + OFF_W) + (size_t)l * W_TOTAL;
      const float* mod = (const float*)(p.ws + OFF_MOD) + (size_t)l * 17 * 6144;
      phase_norm(p, chunk, l, 0, false);
      xcd_barrier(xb);
      for (int rep = 0; rep <= PR_GEMM1; ++rep) {
        gemm_phase<8, 4, true>(H, 1024, W + W_IN, 1024, NP, false, EpiStore{P, NP}, smem);
        xcd_barrier(xb);
      }
      phase_prep(p, l, sm);
      xcd_barrier(xb);
      gemm_phase<4, 4, true>(P + PB_CQ, NP, W + W_QUP, 384, 768, false, EpiStore{(u16*)(p.ws + OFF_QB), 768}, smem);
      gemm_phase<4, 4, false>(P + PB_CKV, NP, W + W_KVUP, 256, 1024, false, EpiKV{(u16*)(p.ws + OFF_KB), (u16*)(p.ws + OFF_VTB)}, smem);
      gemm_phase<4, 4, true>((const u16*)(p.ws + OFF_GL), 128, W + W_GATE, 128, 512, false, EpiStore{(u16*)(p.ws + OFF_G), 512}, smem);
      xcd_barrier(xb);
      if (PR_KIND >= 0) {
        phase_probe(p, l, PR_KIND, smem);
        xcd_barrier(xb);
      }
#ifdef PR_MIX
      if (chunk == 0) { phase_mixers(p, chunk, l, !last, ctr + 8 + l, smem, (u16*)(p.out + (size_t)BC * 2048 * 1024), PR_MIX); xcd_barrier(xb); }
#endif
      phase_mixers(p, chunk, l, !last, ctr + chunk * 2 + l, smem, nullptr, 31);
      xcd_barrier(xb);
      phase_cout(p, l, last);
      xcd_barrier(xb);
      for (int rep = 0; rep <= PR_MERGE; ++rep) {
        phase_merge(p, l, last, smem);
        xcd_barrier(xb);
      }
      if (last) gemm_phase<8, 4, true>((const u16*)(p.ws + OFF_YM), 1024, W + W_OUT, 1024, 1024, true, EpiResid{p, chunk, mod, 2048, false}, smem);
      else gemm_phase<4, 4, true>((const u16*)(p.ws + OFF_YM), 1024, W + W_OUT, 1024, 1024, false, EpiResid{p, chunk, mod, 2048, true}, smem);
      xcd_barrier(xb);
      phase_norm(p, chunk, l, 1, last);
      xcd_barrier(xb);
      gemm_phase<8, 4, true>(H, 1024, W + W_1, 1024, 4096, last, EpiRelu2{P}, smem);
      xcd_barrier(xb);
      if (last) gemm_phase<8, 4, true>(P, 4096, W + W_2, 4096, 1024, true, EpiResid{p, chunk, mod, 5120, false}, smem);
      else gemm_phase<4, 4, true>(P, 4096, W + W_2, 4096, 1024, false, EpiResid{p, chunk, mod, 5120, false}, smem);
      xcd_barrier(xb);
    }
    phase_final(p, chunk);
    xcd_barrier(xb);
  }
}

extern "C" void kernel_launch(void* const* d_in, const int* in_sizes, int n_in, void* d_out, int out_size, void* d_ws,
                              size_t ws_size, hipStream_t stream) {
  static int grid_blocks = 0;
  if (!grid_blocks) {
    int dev = 0, cus = 0, per_cu = 0;
    hipGetDevice(&dev);
    hipDeviceGetAttribute(&cus, hipDeviceAttributeMultiprocessorCount, dev);
    hipFuncSetAttribute((const void*)fwd_megakernel, hipFuncAttributeMaxDynamicSharedMemorySize, SMEM_DYN);
    hipOccupancyMaxActiveBlocksPerMultiprocessor(&per_cu, fwd_megakernel, 256, SMEM_DYN);
    if (per_cu > 2) per_cu = 2;
    if (per_cu < 1) per_cu = 1;
    grid_blocks = cus * per_cu;
  }
  if (ws_size < OFF_END) fprintf(stderr, "workspace too small: %zu < %zu\n", ws_size, (size_t)OFF_END);
  Params p{};
  for (int i = 0; i < 32; ++i) p.in[i] = (const float*)d_in[i];
  p.out = (float*)d_out;
  p.ws = (unsigned char*)d_ws;
  hipMemsetAsync(d_ws, 0, 1048576, stream);
  void* args[] = {&p};
  hipError_t e = hipLaunchCooperativeKernel((void*)fwd_megakernel, dim3(grid_blocks), dim3(256), args, SMEM_DYN, stream);
  if (e != hipSuccess) fprintf(stderr, "cooperative launch failed: %s (grid %d)\n", hipGetErrorString(e), grid_blocks);
}
```

```cpp
#include <hip/hip_runtime.h>
#include <hip/hip_cooperative_groups.h>
#include <stdint.h>
#include <cstdio>
namespace cg = cooperative_groups;

typedef unsigned short u16;
typedef __attribute__((ext_vector_type(8))) short bf16x8;
typedef __attribute__((ext_vector_type(4))) float f32x4;
typedef __attribute__((ext_vector_type(2))) float v2f;
#define DI __device__ __forceinline__

#ifndef PR_ABL
#define PR_ABL 0
#endif
constexpr int SMEM_BYTES = 73728;
constexpr int SMEM_DYN = SMEM_BYTES + 64;
constexpr int DM = 1024, TL = 2304;
constexpr int BC = 8, NCHUNK = 2, TC = BC * TL;
constexpr int NP = 4992;
constexpr int PA_Q = 0, PA_K = 512, PA_V = 640, PB_CQ = 768, PB_CKV = 1152, PB_KR = 1408;
constexpr int PC_R = 1440, PC_K = 1952, PC_V = 2464, PC_WLO = 2976, PC_ALO = 3104, PC_GLO = 3232;
constexpr int PD_Q = 3360, PD_K = 3872, PD_V = 4384;
constexpr int O_A = 0, O_B = 768, O_C = 1440, O_D = 3360;

constexpr int W_IN = 0, W_G = 5111808, W_QUP = 9306112, W_KVUP = 9601024, W_GATE = 9863168, W_DEC = 9928704,
              W_AAA = 9994240, W_BR = 10059776, W_OUT = 12156928, W_1 = 13205504, W_2 = 17399808, W_TOTAL = 21594112;

constexpr size_t OFF_MOD = 0;
constexpr size_t OFF_CTR = 835584;
constexpr size_t OFF_BAR = 851968;
constexpr size_t OFF_ROPE = 1048576;
constexpr size_t OFF_W = 2097152;
constexpr size_t OFF_H = OFF_W + (size_t)2 * W_TOTAL * 2;
constexpr size_t OFF_P = OFF_H + (size_t)TC * 1024 * 2;
constexpr size_t OFF_KA = OFF_P + (size_t)TC * NP * 2;
constexpr size_t OFF_VTA = OFF_KA + (size_t)BC * 2 * TL * 64 * 2;
constexpr size_t OFF_QB = OFF_VTA + (size_t)BC * 2 * TL * 64 * 2;
constexpr size_t OFF_KB = OFF_QB + (size_t)TC * 768 * 2;
constexpr size_t OFF_VTB = OFF_KB + (size_t)TC * 768 * 2;
constexpr size_t OFF_VTD = OFF_VTB + (size_t)TC * 512 * 2;
constexpr size_t OFF_GL = OFF_VTD + (size_t)TC * 512 * 2;
constexpr size_t OFF_G = OFF_GL + (size_t)TC * 128 * 2;
constexpr size_t OFF_YF = OFF_G + (size_t)TC * 512 * 2;
constexpr size_t OFF_YB = OFF_YF + (size_t)TC * 512 * 2;
constexpr size_t OFF_BON = OFF_YB + (size_t)TC * 512 * 2;
constexpr size_t OFF_XC = OFF_BON + (size_t)TC * 16 * 4;
constexpr size_t OFF_END = OFF_XC + (size_t)BC * 256 * 1024 * 4;
constexpr size_t OFF_YM = OFF_QB;

struct Params {
  const float* in[32];
  float* out;
  unsigned char* ws;
};

DI u16 f2bf(float f) { uint32_t u = __float_as_uint(f); u += 0x7fffu + ((u >> 16) & 1u); return (u16)(u >> 16); }
DI float bf2f(u16 h) { return __uint_as_float(((uint32_t)h) << 16); }
typedef __bf16 bf2_t __attribute__((ext_vector_type(2)));
DI uint32_t pack2(float a, float b) { v2f v = {a, b}; bf2_t r = __builtin_convertvector(v, bf2_t); return __builtin_bit_cast(uint32_t, r); }
DI float lo2f(uint32_t u) { return __uint_as_float(u << 16); }
DI float hi2f(uint32_t u) { return __uint_as_float(u & 0xffff0000u); }
DI float dpp_f(float v, const int ctrl_is_unused) { return v; }
#define DPP_ADD(v, ctrl) ((v) + __int_as_float(__builtin_amdgcn_update_dpp(0, __float_as_int(v), (ctrl), 0xF, 0xF, true)))
DI float row8_sum(float v) {
  v = DPP_ADD(v, 0xB1); v = DPP_ADD(v, 0x4E); v = DPP_ADD(v, 0x141);
  return v;
}
DI float row16_sum(float v) {
  v = DPP_ADD(v, 0xB1); v = DPP_ADD(v, 0x4E); v = DPP_ADD(v, 0x141); v = DPP_ADD(v, 0x140);
  return v;
}
DI float xq_sum(float v) {
  auto r = __builtin_amdgcn_permlane16_swap(__float_as_uint(v), __float_as_uint(v), false, false);
  v = __uint_as_float(r[0]) + __uint_as_float(r[1]);
  auto r2 = __builtin_amdgcn_permlane32_swap(__float_as_uint(v), __float_as_uint(v), false, false);
  return __uint_as_float(r2[0]) + __uint_as_float(r2[1]);
}
DI float xq_max(float v) {
  auto r = __builtin_amdgcn_permlane16_swap(__float_as_uint(v), __float_as_uint(v), false, false);
  v = fmaxf(__uint_as_float(r[0]), __uint_as_float(r[1]));
  auto r2 = __builtin_amdgcn_permlane32_swap(__float_as_uint(v), __float_as_uint(v), false, false);
  return fmaxf(__uint_as_float(r2[0]), __uint_as_float(r2[1]));
}
DI float wave_sum(float v) { return xq_sum(row16_sum(v)); }
DI float quad_sum(float v) {
  v += __int_as_float(__builtin_amdgcn_update_dpp(0, __float_as_int(v), 0xB1, 0xF, 0xF, true));
  v += __int_as_float(__builtin_amdgcn_update_dpp(0, __float_as_int(v), 0x4E, 0xF, 0xF, true));
  return v;
}
DI int otid() { int t = threadIdx.x; asm volatile("" : "+v"(t)); return t; }
DI float sigmoidf_(float x) { return 1.f / (1.f + __expf(-x)); }

DI float* x1_row(const Params& p, int chunk, int row) {
  int bl = row / TL, j = row - bl * TL;
  if (j < 256) return (float*)(p.ws + OFF_XC) + ((size_t)(bl * 256 + j)) * DM;
  return p.out + ((size_t)((chunk * BC + bl) * 2048 + (j - 256))) * DM;
}
DI const float* xin_row(const Params& p, int chunk, int row) {
  int bl = row / TL, j = row - bl * TL;
  int b = chunk * BC + bl;
  if (j < 256) return p.in[2] + ((size_t)(b * 256 + j)) * DM;
  return p.in[0] + ((size_t)(b * 2048 + (j - 256))) * DM;
}
DI int mod_row(int chunk, int row) {
  int bl = row / TL, j = row - bl * TL;
  return (j < 256) ? 16 : (chunk * BC + bl);
}

__constant__ int CONVTAB[16][8] = {
  {8, 1024 * 8992, 0, 1024, 8992, 0, 4896, W_IN},
  {8, 1024 * 8992, 0, 1024, 8992, 4896, 4096, W_G},
  {13, 384 * 768, 0, 384, 768, 0, 768, W_QUP},
  {14, 256 * 1024, 0, 256, 1024, 0, 1024, W_KVUP},
  {20, 128 * 512, 0, 128, 512, 0, 512, W_GATE},
  {17, 2 * 64 * 512, 0, 64, 512, 0, 512, W_DEC},
  {17, 2 * 64 * 512, 64 * 512, 64, 512, 0, 512, W_DEC + 512 * 64},
  {19, 2 * 64 * 512, 0, 64, 512, 0, 512, W_AAA},
  {19, 2 * 64 * 512, 64 * 512, 64, 512, 0, 512, W_AAA + 512 * 64},
  {27, 4 * 512 * 1024, 0, 512, 1024, 0, 1024, W_BR},
  {27, 4 * 512 * 1024, 512 * 1024, 512, 1024, 0, 1024, W_BR + 1024 * 512},
  {27, 4 * 512 * 1024, 2 * 512 * 1024, 512, 1024, 0, 1024, W_BR + 2 * 1024 * 512},
  {27, 4 * 512 * 1024, 3 * 512 * 1024, 512, 1024, 0, 1024, W_BR + 3 * 1024 * 512},
  {28, 1024 * 1024, 0, 1024, 1024, 0, 1024, W_OUT},
  {29, 1024 * 4096, 0, 1024, 4096, 0, 4096, W_1},
  {30, 4096 * 1024, 0, 4096, 1024, 0, 1024, W_2},
};
constexpr int CONV_TILES_PER_LAYER = 1232 + 1024 + 72 + 64 + 16 + 8 + 8 + 8 + 8 + 128 * 4 + 256 + 1024 + 1024;

__device__ void conv_tile(const float* __restrict__ src, int ld, int k0, int n0, int ncols, u16* __restrict__ dst, int K,
                          float* tile, const int tid) {
  {
    const int c4 = (tid & 15) * 4;
#pragma unroll
    for (int i = 0; i < 4; ++i) {
      int r = (tid >> 4) + 16 * i;
      float4 v = make_float4(0.f, 0.f, 0.f, 0.f);
      if (n0 + c4 < ncols) v = *(const float4*)(src + (size_t)(k0 + r) * ld + n0 + c4);
      tile[r * 65 + c4 + 0] = v.x; tile[r * 65 + c4 + 1] = v.y; tile[r * 65 + c4 + 2] = v.z; tile[r * 65 + c4 + 3] = v.w;
    }
  }
  __syncthreads();
  {
    const int n = tid >> 2, kc = (tid & 3) * 16;
    if (n0 + n < ncols) {
      uint32_t w[8];
#pragma unroll
      for (int i = 0; i < 8; ++i) w[i] = pack2(tile[(kc + 2 * i) * 65 + n], tile[(kc + 2 * i + 1) * 65 + n]);
      uint4* d = (uint4*)(dst + (size_t)(n0 + n) * K + k0 + kc);
      d[0] = make_uint4(w[0], w[1], w[2], w[3]);
      d[1] = make_uint4(w[4], w[5], w[6], w[7]);
    }
  }
  __syncthreads();
}

__device__ void phase0(const Params& p, unsigned char* smem) {
  float* fsm = (float*)smem;
  const int tid = otid();
  const int n_conv = 2 * CONV_TILES_PER_LAYER;
  const int n_pad = 2 * 48;
  const int n_ada = 2 * 16 * 24;
  const int total = n_conv + n_pad + n_ada + 1;
  u16* wbase = (u16*)(p.ws + OFF_W);
  for (int it = blockIdx.x; it < total; it += gridDim.x) {
    if (it < n_conv) {
      int l = it / CONV_TILES_PER_LAYER, r = it - l * CONV_TILES_PER_LAYER;
      int job = 0;
      for (; job < 16; ++job) {
        int nt = (CONVTAB[job][3] >> 6) * ((CONVTAB[job][6] + 63) >> 6);
        if (r < nt) break;
        r -= nt;
      }
      const int K = CONVTAB[job][3], ld = CONVTAB[job][4], col0 = CONVTAB[job][5], ncols = CONVTAB[job][6];
      const int nkt = K >> 6;
      const int kt = r % nkt, ntile = r / nkt;
      const float* src = p.in[CONVTAB[job][0]] + (size_t)l * CONVTAB[job][1] + CONVTAB[job][2] + col0;
      u16* dst = wbase + (size_t)l * W_TOTAL + CONVTAB[job][7];
      conv_tile(src, ld, kt * 64, ntile * 64, ncols, dst, K, fsm, tid);
    } else if (it < n_conv + n_pad) {
      int r = it - n_conv;
      int l = r / 48, q = r - l * 48;
      u16* dst = wbase + (size_t)l * W_TOTAL + W_IN + (size_t)(4896 + q * 2) * 1024;
      *(uint4*)(dst + tid * 8) = make_uint4(0, 0, 0, 0);
    } else if (it < n_conv + n_pad + n_ada) {
      int r = it - n_conv - n_pad;
      int l = r / 384; r -= l * 384;
      int kc = r / 24, nb = r - kc * 24;
      for (int idx = tid; idx < 17 * 64; idx += 256) {
        int rr = idx >> 6, k = idx & 63;
        float cv = (rr < 16) ? p.in[1][rr * 1024 + kc * 64 + k] : p.in[3][kc * 64 + k];
        fsm[idx] = cv / (1.f + expf(-cv));
      }
      __syncthreads();
      const int n = nb * 256 + tid;
      float acc[17];
#pragma unroll
      for (int i = 0; i < 17; ++i) acc[i] = 0.f;
      const float* wp = p.in[4] + ((size_t)l * 1024 + kc * 64) * 6144 + n;
#pragma unroll 4
      for (int k = 0; k < 64; ++k) {
        float w = wp[(size_t)k * 6144];
#pragma unroll
        for (int i = 0; i < 17; ++i) acc[i] += fsm[i * 64 + k] * w;
      }
      float bias = (kc == 0) ? p.in[5][l * 6144 + n] : 0.f;
      float* mod = (float*)(p.ws + OFF_MOD);
#pragma unroll
      for (int i = 0; i < 17; ++i) atomicAdd(&mod[(size_t)(l * 17 + i) * 6144 + n], acc[i] + bias);
      __syncthreads();
    } else {
      float* ra = (float*)(p.ws + OFF_ROPE);
      float* rb = ra + 64 * 16 * 2;
      for (int idx = tid; idx < 64 * 16; idx += 256) {
        int pos = idx >> 4, i = idx & 15;
        float inv = powf(10000.f, -(float)i / 16.f);
        float ang = (float)pos * inv;
        ra[idx * 2] = cosf(ang); ra[idx * 2 + 1] = sinf(ang);
      }
      for (int idx = tid; idx < 64 * 8; idx += 256) {
        int pos = idx >> 3, i = idx & 7;
        float inv = powf(10000.f, -(float)i / 8.f);
        float ang = (float)pos * inv;
        rb[idx * 2] = cosf(ang); rb[idx * 2 + 1] = sinf(ang);
      }
    }
  }
}

__device__ void phase_norm(const Params& p, int chunk, int l, int which, bool latonly) {
  const int tid = otid();
  const int lane = tid & 63, wave = tid >> 6;
  const float* g = p.in[which == 0 ? 6 : 7] + l * 1024;
  const float* mod = (const float*)(p.ws + OFF_MOD) + (size_t)l * 17 * 6144;
  u16* H = (u16*)(p.ws + OFF_H);
  for (int row = blockIdx.x * 4 + wave; row < TC; row += gridDim.x * 4) {
    int j = row % TL;
    if (latonly && j < 256) continue;
    const float* src = (which == 0 && l == 0) ? xin_row(p, chunk, row) : (const float*)x1_row(p, chunk, row);
    const float* mr = mod + (size_t)mod_row(chunk, row) * 6144 + which * 3072;
    float4 v[4];
    float ss = 0.f;
#pragma unroll
    for (int i = 0; i < 4; ++i) {
      v[i] = *(const float4*)(src + i * 256 + lane * 4);
      ss += v[i].x * v[i].x + v[i].y * v[i].y + v[i].z * v[i].z + v[i].w * v[i].w;
    }
    ss = wave_sum(ss);
    float rs = rsqrtf(ss * (1.f / 1024.f) + 1e-6f);
#pragma unroll
    for (int i = 0; i < 4; ++i) {
      int c = i * 256 + lane * 4;
      float4 gg = *(const float4*)(g + c);
      float4 sh = *(const float4*)(mr + c);
      float4 sc = *(const float4*)(mr + 1024 + c);
      float a0 = v[i].x * rs * gg.x * (1.f + sc.x) + sh.x;
      float a1 = v[i].y * rs * gg.y * (1.f + sc.y) + sh.y;
      float a2 = v[i].z * rs * gg.z * (1.f + sc.z) + sh.z;
      float a3 = v[i].w * rs * gg.w * (1.f + sc.w) + sh.w;
      *(uint2*)(H + (size_t)row * 1024 + c) = make_uint2(pack2(a0, a1), pack2(a2, a3));
    }
  }
}

__device__ void phase_final(const Params& p, int chunk) {
  const int tid = otid();
  const int lane = tid & 63, wave = tid >> 6;
  const float* g = p.in[31];
  for (int r = blockIdx.x * 4 + wave; r < BC * 2048; r += gridDim.x * 4) {
    float* px = p.out + ((size_t)chunk * BC * 2048 + r) * DM;
    float4 v[4];
    float ss = 0.f;
#pragma unroll
    for (int i = 0; i < 4; ++i) {
      v[i] = *(const float4*)(px + i * 256 + lane * 4);
      ss += v[i].x * v[i].x + v[i].y * v[i].y + v[i].z * v[i].z + v[i].w * v[i].w;
    }
    ss = wave_sum(ss);
    float rs = rsqrtf(ss * (1.f / 1024.f) + 1e-6f);
#pragma unroll
    for (int i = 0; i < 4; ++i) {
      int c = i * 256 + lane * 4;
      float4 gg = *(const float4*)(g + c);
      *(float4*)(px + c) = make_float4(v[i].x * rs * gg.x, v[i].y * rs * gg.y, v[i].z * rs * gg.z, v[i].w * rs * gg.w);
    }
  }
}

#define GEMM_WAIT_VM(n) asm volatile("s_waitcnt vmcnt(" #n ")" ::: "memory")
DI void raw_barrier() { asm volatile("s_waitcnt lgkmcnt(0)" ::: "memory"); __builtin_amdgcn_s_barrier(); }
template <int MI, int NI, bool TR>
DI void gemm_dma(const u16* __restrict__ A, int lda, const u16* __restrict__ Bt, int ldb, int K, f32x4 (&acc)[MI][NI],
                 unsigned char* smem, const int tid) {
  constexpr int BM = 32 * MI, BN = 32 * NI;
  constexpr int SB = (BM + BN) * 64;
  constexpr int NS = (73728 / SB) >= 4 ? 4 : 3;
  constexpr int LA = BM / 64, LB = BN / 64, LPT = LA + LB;
  static_assert(LPT == 3 || LPT == 4 || LPT == 6, "unexpected tile");
  const int lane = tid & 63, wave = tid >> 6, l15 = lane & 15, quad = lane >> 4;
  const int wm = wave >> 1, wn = wave & 1;
  const int drow = tid >> 2;
  const int g4 = (0x1230 >> (((drow >> 2) & 3) * 4)) & 3;
  const int dc = (tid & 3) ^ g4;
  const u16* Asrc = A + (size_t)drow * lda + dc * 8;
  const u16* Bsrc = Bt + (size_t)drow * ldb + dc * 8;
  unsigned char* dstw = smem + __builtin_amdgcn_readfirstlane(tid >> 6) * 1024;
  auto issue = [&](int kt, int buf) {
    const int ko = kt * 32;
#pragma unroll
    for (int j = 0; j < LA; ++j)
      __builtin_amdgcn_global_load_lds((const unsigned*)(Asrc + (size_t)(j * 64) * lda + ko), (unsigned*)(dstw + buf * SB + j * 4096), 16, 0, 0);
#pragma unroll
    for (int j = 0; j < LB; ++j)
      __builtin_amdgcn_global_load_lds((const unsigned*)(Bsrc + (size_t)(j * 64) * ldb + ko), (unsigned*)(dstw + buf * SB + (LA + j) * 4096), 16, 0, 0);
  };
  const int rg4 = (0x1230 >> ((l15 >> 2) * 4)) & 3;
  const int aoff = (wm * 16 * MI + l15) * 64 + ((quad ^ rg4) * 16);
  const int boff = BM * 64 + (wn * 16 * NI + l15) * 64 + ((quad ^ rg4) * 16);
  const int nk = K >> 5;
  GEMM_WAIT_VM(0);
#pragma unroll
  for (int s_ = 0; s_ < NS - 1; ++s_)
    if (s_ < nk) issue(s_, s_);
  int buf = 0;
  for (int kt = 0; kt < nk; ++kt) {
    const int rem = nk - 1 - kt;
    if (NS == 4) {
      if (rem >= 2) { if (LPT == 3) GEMM_WAIT_VM(6); else if (LPT == 4) GEMM_WAIT_VM(8); else GEMM_WAIT_VM(12); }
      else if (rem == 1) { if (LPT == 3) GEMM_WAIT_VM(3); else if (LPT == 4) GEMM_WAIT_VM(4); else GEMM_WAIT_VM(6); }
      else GEMM_WAIT_VM(0);
    } else {
      if (rem >= 1) { if (LPT == 3) GEMM_WAIT_VM(3); else if (LPT == 4) GEMM_WAIT_VM(4); else GEMM_WAIT_VM(6); }
      else GEMM_WAIT_VM(0);
    }
    raw_barrier();
    const unsigned char* st = smem + buf * SB;
    bf16x8 af[MI], bfr[NI];
#pragma unroll
    for (int mi = 0; mi < MI; ++mi) af[mi] = *(const bf16x8*)(st + aoff + mi * 1024);
#pragma unroll
    for (int ni = 0; ni < NI; ++ni) bfr[ni] = *(const bf16x8*)(st + boff + ni * 1024);
    __builtin_amdgcn_sched_barrier(0);
    if (kt + NS - 1 < nk) { int nb = buf + NS - 1; if (nb >= NS) nb -= NS; issue(kt + NS - 1, nb); }
    __builtin_amdgcn_sched_barrier(0);
    __builtin_amdgcn_s_setprio(1);
#pragma unroll
    for (int mi = 0; mi < MI; ++mi)
#pragma unroll
      for (int ni = 0; ni < NI; ++ni)
        acc[mi][ni] = TR ? __builtin_amdgcn_mfma_f32_16x16x32_bf16(bfr[ni], af[mi], acc[mi][ni], 0, 0, 0)
                         : __builtin_amdgcn_mfma_f32_16x16x32_bf16(af[mi], bfr[ni], acc[mi][ni], 0, 0, 0);
    __builtin_amdgcn_s_setprio(0);
    if (++buf == NS) buf = 0;
  }
  raw_barrier();
}

DI bool tile_map(int t, int nMg, int nNt, bool latonly, int MT, int& mt, int& nt) {
  int x = t & 7, rest = t >> 3;
  int ni = rest & 7, q = rest >> 3;
  int mg = q % nMg, ng = q / nMg;
  nt = ng * 8 + ni;
  if (nt >= nNt) return false;
  int mti = mg * 8 + x;
  if (MT == 128) mt = latonly ? ((mti >> 4) * 18 + 2 + (mti & 15)) : mti;
  else mt = latonly ? ((mti >> 3) * 9 + 1 + (mti & 7)) : mti;
  return true;
}

template <int MI, int NI, bool TR, class Epi>
__device__ void gemm_phase(const u16* A, int lda, const u16* Bt, int K, int N, bool latonly, Epi epi, unsigned char* smem) {
  constexpr int BM = 32 * MI, BN = 32 * NI;
  const int nMg = (BM == 128) ? (latonly ? 16 : 18) : (latonly ? 8 : 9);
  const int nNt = N / BN;
  const int total = 64 * nMg * ((nNt + 7) >> 3);
  const int tid = otid();
  const int lane = tid & 63, wave = tid >> 6, l15 = lane & 15, quad = lane >> 4;
  const int wm = wave >> 1, wn = wave & 1;
  for (int t = blockIdx.x; t < total; t += gridDim.x) {
    int mt, nt;
    if (!tile_map(t, nMg, nNt, latonly, BM, mt, nt)) continue;
    const int m0 = mt * BM, n0 = nt * BN;
    f32x4 acc[MI][NI];
#pragma unroll
    for (int mi = 0; mi < MI; ++mi)
#pragma unroll
      for (int ni = 0; ni < NI; ++ni) acc[mi][ni] = (f32x4){0.f, 0.f, 0.f, 0.f};
    gemm_dma<MI, NI, TR>(A + (size_t)m0 * lda, lda, Bt + (size_t)n0 * K, K, K, acc, smem, tid);
    if constexpr (Epi::BATCH) {
#pragma unroll
      for (int mi = 0; mi < MI; ++mi) epi.template row<NI>(m0 + wm * 16 * MI + mi * 16 + l15, n0 + wn * 16 * NI + quad * 4, acc[mi]);
    } else {
#pragma unroll
      for (int mi = 0; mi < MI; ++mi)
#pragma unroll
        for (int ni = 0; ni < NI; ++ni) {
          if (TR) epi(m0 + wm * 16 * MI + mi * 16 + l15, n0 + wn * 16 * NI + ni * 16 + quad * 4, acc[mi][ni]);
          else epi(m0 + wm * 16 * MI + mi * 16 + quad * 4, n0 + wn * 16 * NI + ni * 16 + l15, acc[mi][ni]);
        }
    }
  }
}

struct EpiStore {
  u16* C; int ldc;
  static constexpr bool BATCH = false;
  DI void operator()(int r, int c0, f32x4 v) const {
    *(uint2*)(C + (size_t)r * ldc + c0) = make_uint2(pack2(v[0], v[1]), pack2(v[2], v[3]));
  }
};
struct EpiKV {
  u16* KB; u16* VtB;
  static constexpr bool BATCH = false;
  DI void operator()(int r0, int c, f32x4 v) const {
    int bl = r0 / TL, j0 = r0 - bl * TL;
    int head = c >> 7, w = c & 127;
    if (w < 64) {
#pragma unroll
      for (int j = 0; j < 4; ++j) KB[((size_t)(bl * 8 + head) * TL + j0 + j) * 96 + w] = f2bf(v[j]);
    } else {
      *(uint2*)(VtB + ((size_t)(bl * 8 + head) * 64 + (w - 64)) * TL + j0) = make_uint2(pack2(v[0], v[1]), pack2(v[2], v[3]));
    }
  }
};
struct EpiRelu2 {
  u16* C;
  static constexpr bool BATCH = false;
  DI void operator()(int r, int c0, f32x4 v) const {
    float t0 = fmaxf(v[0], 0.f), t1 = fmaxf(v[1], 0.f), t2 = fmaxf(v[2], 0.f), t3 = fmaxf(v[3], 0.f);
    *(uint2*)(C + (size_t)r * 4096 + c0) = make_uint2(pack2(t0 * t0, t1 * t1), pack2(t2 * t2, t3 * t3));
  }
};
struct EpiResid {
  Params p; int chunk; const float* mod; int gofs; bool from_input;
  static constexpr bool BATCH = true;
  template <int NI>
  DI void row(int r, int c0, const f32x4 (&v)[NI]) const {
    const float* gtp = mod + (size_t)mod_row(chunk, r) * 6144 + gofs + c0;
    float* dst = x1_row(p, chunk, r) + c0;
    const float* src = from_input ? (xin_row(p, chunk, r) + c0) : (const float*)dst;
    float4 gt[NI], xin[NI];
#pragma unroll
    for (int ni = 0; ni < NI; ++ni) { gt[ni] = *(const float4*)(gtp + ni * 16); xin[ni] = *(const float4*)(src + ni * 16); }
#pragma unroll
    for (int ni = 0; ni < NI; ++ni)
      *(float4*)(dst + ni * 16) = make_float4(xin[ni].x + gt[ni].x * v[ni][0], xin[ni].y + gt[ni].y * v[ni][1],
                                              xin[ni].z + gt[ni].z * v[ni][2], xin[ni].w + gt[ni].w * v[ni][3]);
  }
};

__device__ void phase_merge(const Params& p, int l, bool latonly, unsigned char* smem) {
  const u16* H = (const u16*)(p.ws + OFF_H);
  const u16* P = (const u16*)(p.ws + OFF_P);
  const u16* W = (const u16*)(p.ws + OFF_W) + (size_t)l * W_TOTAL;
  u16* YM = (u16*)(p.ws + OFF_YM);
  const int nMg = latonly ? 16 : 18;
  const int nNt = 8;
  const int total = 64 * nMg;
  const int tid = otid();
  const int lane = tid & 63, wave = tid >> 6, l15 = lane & 15, quad = lane >> 4;
  const int wm = wave >> 1, wn = wave & 1;
  for (int t = blockIdx.x; t < total; t += gridDim.x) {
    int mt, nt;
    if (!tile_map(t, nMg, nNt, latonly, 128, mt, nt)) continue;
    const int m0 = mt * 128, n0 = nt * 128;
    uint2 yp[4][4];
#pragma unroll
    for (int mi = 0; mi < 4; ++mi)
#pragma unroll
      for (int ni = 0; ni < 4; ++ni) yp[mi][ni] = make_uint2(0u, 0u);
    for (int i = 0; i < 4; ++i) {
      const int ocol = (i == 0) ? O_A : (i == 1) ? O_B : (i == 2) ? O_C : O_D;
      uint2 gp[4][4];
      {
        f32x4 g[4][4];
#pragma unroll
        for (int mi = 0; mi < 4; ++mi)
#pragma unroll
          for (int ni = 0; ni < 4; ++ni) g[mi][ni] = (f32x4){0.f, 0.f, 0.f, 0.f};
        gemm_dma<4, 4, true>(H + (size_t)m0 * 1024, 1024, W + W_G + (size_t)(i * 1024 + n0) * 1024, 1024, 1024, g, smem, tid);
#pragma unroll
        for (int mi = 0; mi < 4; ++mi)
#pragma unroll
          for (int ni = 0; ni < 4; ++ni)
            gp[mi][ni] = make_uint2(pack2(sigmoidf_(g[mi][ni][0]), sigmoidf_(g[mi][ni][1])), pack2(sigmoidf_(g[mi][ni][2]), sigmoidf_(g[mi][ni][3])));
      }
      f32x4 b[4][4];
#pragma unroll
      for (int mi = 0; mi < 4; ++mi)
#pragma unroll
        for (int ni = 0; ni < 4; ++ni) b[mi][ni] = (f32x4){0.f, 0.f, 0.f, 0.f};
      gemm_dma<4, 4, true>(P + (size_t)m0 * NP + ocol, NP, W + W_BR + (size_t)(i * 1024 + n0) * 512, 512, 512, b, smem, tid);
#pragma unroll
      for (int mi = 0; mi < 4; ++mi)
#pragma unroll
        for (int ni = 0; ni < 4; ++ni) {
          const float y0 = lo2f(yp[mi][ni].x) + lo2f(gp[mi][ni].x) * b[mi][ni][0];
          const float y1 = hi2f(yp[mi][ni].x) + hi2f(gp[mi][ni].x) * b[mi][ni][1];
          const float y2 = lo2f(yp[mi][ni].y) + lo2f(gp[mi][ni].y) * b[mi][ni][2];
          const float y3 = hi2f(yp[mi][ni].y) + hi2f(gp[mi][ni].y) * b[mi][ni][3];
          yp[mi][ni] = make_uint2(pack2(y0, y1), pack2(y2, y3));
        }
    }
#pragma unroll
    for (int mi = 0; mi < 4; ++mi)
#pragma unroll
      for (int ni = 0; ni < 4; ++ni)
        *(uint2*)(YM + (size_t)(m0 + wm * 64 + mi * 16 + l15) * 1024 + n0 + wn * 64 + ni * 16 + quad * 4) = yp[mi][ni];
  }
}

__device__ void transpose64(const u16* __restrict__ src, int lds_, u16* __restrict__ dst, int ldd, u16* tile, const int tid) {
  {
    const int r = tid >> 2, c = (tid & 3) * 16;
    uint4 a = *(const uint4*)(src + (size_t)r * lds_ + c);
    uint4 b = *(const uint4*)(src + (size_t)r * lds_ + c + 8);
    uint32_t* t32 = (uint32_t*)(tile + r * 66 + c);
    t32[0] = a.x; t32[1] = a.y; t32[2] = a.z; t32[3] = a.w; t32[4] = b.x; t32[5] = b.y; t32[6] = b.z; t32[7] = b.w;
  }
  __syncthreads();
  {
    const int d = tid >> 2, tc = (tid & 3) * 16;
    uint32_t w[8];
#pragma unroll
    for (int i = 0; i < 8; ++i) w[i] = (uint32_t)tile[(tc + 2 * i) * 66 + d] | ((uint32_t)tile[(tc + 2 * i + 1) * 66 + d] << 16);
    uint4* o = (uint4*)(dst + (size_t)d * ldd + tc);
    o[0] = make_uint4(w[0], w[1], w[2], w[3]);
    o[1] = make_uint4(w[4], w[5], w[6], w[7]);
  }
  __syncthreads();
}

__device__ void phase_prep(const Params& p, int l, u16* sm) {
  const int tid = otid();
  const int lane = tid & 63, wave = tid >> 6;
  u16* P = (u16*)(p.ws + OFF_P);
  u16* KA = (u16*)(p.ws + OFF_KA);
  u16* VtA = (u16*)(p.ws + OFF_VTA);
  u16* KB = (u16*)(p.ws + OFF_KB);
  u16* VtD = (u16*)(p.ws + OFF_VTD);
  u16* GL = (u16*)(p.ws + OFF_GL);
  const float* ropeA = (const float*)(p.ws + OFF_ROPE);
  const float* ropeB = ropeA + 64 * 16 * 2;
  const float aqg = p.in[9][l * 64 + lane], akg = p.in[10][l * 64 + lane];
  const float* bqg = p.in[11] + l * 384;
  const float* bkvg = p.in[12] + l * 256;
  const float* mu = p.in[15] + l * 1920;
  for (int tok = blockIdx.x * 4 + wave; tok < TC; tok += gridDim.x * 4) {
    const int bl = tok / TL, j = tok - bl * TL;
    const bool islat = j >= 256;
    const int jj = j - 256;
    const int grow = (jj >> 6) & 31, gcol = jj & 63;
    u16* pr = P + (size_t)tok * NP;
    const bool hasp = islat ? (jj > 0) : (j > 0);
    const bool hasn = islat ? (jj < 2047) : (j < 255);
    u16 xa[10], xq[6], xkv[4], xkr, gcur[2], gprv[2], gnxt[2];
#pragma unroll
    for (int h = 0; h < 10; ++h) xa[h] = pr[h * 64 + lane];
#pragma unroll
    for (int i = 0; i < 6; ++i) xq[i] = pr[PB_CQ + lane + 64 * i];
#pragma unroll
    for (int i = 0; i < 4; ++i) xkv[i] = pr[PB_CKV + lane + 64 * i];
    xkr = pr[PB_KR + (lane & 31)];
#pragma unroll
    for (int i = 0; i < 2; ++i) {
      const int c = lane + 64 * i;
      gcur[i] = pr[PC_GLO + c];
      gprv[i] = hasp ? pr[PC_GLO + c - NP] : (u16)0;
      gnxt[i] = hasn ? pr[PC_GLO + c + NP] : (u16)0;
    }
    float ca = 1.f, sa = 0.f, cb = 1.f, sb = 0.f;
    if (islat) {
      const int pos = (lane < 32) ? grow : gcol;
      ca = ropeA[(pos * 16 + (lane & 15)) * 2];
      sa = ropeA[(pos * 16 + (lane & 15)) * 2 + 1];
      const int posb = ((lane & 31) < 16) ? grow : gcol;
      cb = ropeB[(posb * 8 + (lane & 7)) * 2];
      sb = ropeB[(posb * 8 + (lane & 7)) * 2 + 1];
    }
#pragma unroll
    for (int h = 0; h < 10; ++h) {
      const float x = bf2f(xa[h]);
      const float ss = wave_sum(x * x);
      const float y = x * rsqrtf(ss * (1.f / 64.f) + 1e-6f) * (h < 8 ? aqg : akg);
      const float yp = __shfl_xor(y, 16);
      const float o = ((lane & 16) == 0) ? (y * ca - yp * sa) : (yp * sa + y * ca);
      if (h < 8) pr[h * 64 + lane] = f2bf(o);
      else KA[((size_t)(bl * 2 + (h - 8)) * TL + j) * 64 + lane] = f2bf(o);
    }
    {
      float x[6], ss = 0.f;
#pragma unroll
      for (int i = 0; i < 6; ++i) { x[i] = bf2f(xq[i]); ss += x[i] * x[i]; }
      ss = wave_sum(ss);
      const float rs = rsqrtf(ss * (1.f / 384.f) + 1e-6f);
#pragma unroll
      for (int i = 0; i < 6; ++i) pr[PB_CQ + lane + 64 * i] = f2bf(x[i] * rs * bqg[lane + 64 * i]);
    }
    {
      float x[4], ss = 0.f;
#pragma unroll
      for (int i = 0; i < 4; ++i) { x[i] = bf2f(xkv[i]); ss += x[i] * x[i]; }
      ss = wave_sum(ss);
      const float rs = rsqrtf(ss * (1.f / 256.f) + 1e-6f);
#pragma unroll
      for (int i = 0; i < 4; ++i) pr[PB_CKV + lane + 64 * i] = f2bf(x[i] * rs * bkvg[lane + 64 * i]);
    }
    {
      const float x = bf2f(xkr);
      const float xp = __shfl_xor(x, 8);
      const float o = ((lane & 8) == 0) ? (x * cb - xp * sb) : (xp * sb + x * cb);
      if (lane < 32) {
        const u16 ob = f2bf(o);
#pragma unroll
        for (int h = 0; h < 8; ++h) KB[((size_t)(bl * 8 + h) * TL + j) * 96 + 64 + lane] = ob;
      }
    }
#pragma unroll
    for (int i = 0; i < 2; ++i) {
      const int c = lane + 64 * i;
      const float cur = bf2f(gcur[i]);
      const float z = cur + (0.5f * (bf2f(gprv[i]) + bf2f(gnxt[i])) - cur) * mu[1792 + c];
      GL[(size_t)tok * 128 + c] = f2bf(sigmoidf_(z));
    }
  }
  for (int it = blockIdx.x; it < (TC / 64) * 10; it += gridDim.x) {
    int tg = it / 10, hh = it - tg * 10;
    int tok0 = tg * 64, bl = tok0 / TL, j0 = tok0 - bl * TL;
    if (hh < 2) transpose64(P + (size_t)tok0 * NP + PA_V + hh * 64, NP, VtA + ((size_t)(bl * 2 + hh) * 64) * TL + j0, TL, sm, tid);
    else transpose64(P + (size_t)tok0 * NP + PD_V + (hh - 2) * 64, NP, VtD + ((size_t)(bl * 8 + hh - 2) * 64) * TL + j0, TL, sm, tid);
  }
}

template <int DQK, int NQ, int MODE>
__device__ void flash_item(const u16* __restrict__ Qp, int ldq, const u16* __restrict__ Kp, int ldk, const u16* __restrict__ Vtp,
                           int ntiles, u16* __restrict__ Op, int ldo, float scale, bool ropeq, int qtok0,
                           const float* __restrict__ ropeB, int nat_r, const float* __restrict__ bias_g, unsigned char* smem, const int tid, const int abl) {
  constexpr int KS = DQK / 32;
  constexpr int DCH = DQK / 8;
  constexpr int KB_ = 64 * DQK * 2;
  constexpr int SBF = KB_ + 8192;
  constexpr int NS = (DQK == 64) ? 4 : 3;
  constexpr int LK = (64 * DCH) / 256, LPT = LK + 2;
  float* sBias = (float*)(smem + NS * SBF);
  const int lane = tid & 63, wave = tid >> 6, l15 = lane & 15, quad = lane >> 4;
  const float L2E = 1.4426950408889634f;
  int r0 = 0;
  if (MODE == 1) {
    r0 = min(max(nat_r - 4, 0), 24);
    for (int i = tid; i < 15 * 31; i += 256) sBias[i] = bias_g[i];
  }
  bf16x8 qf[NQ][KS];
#pragma unroll
  for (int qi = 0; qi < NQ; ++qi) {
    const int row = wave * 16 * NQ + qi * 16 + l15;
#pragma unroll
    for (int ks = 0; ks < KS; ++ks) qf[qi][ks] = *(const bf16x8*)(Qp + (size_t)row * ldq + ks * 32 + quad * 8);
    if (DQK == 96 && ropeq) {
      bf16x8 own = qf[qi][KS - 1];
      bf16x8 par = *(const bf16x8*)(Qp + (size_t)row * ldq + 64 + (quad ^ 1) * 8);
      const int qt = qtok0 + row;
      const int pos = (quad < 2) ? ((qt >> 6) & 31) : (qt & 63);
      bf16x8 res;
#pragma unroll
      for (int i = 0; i < 8; ++i) {
        float c = ropeB[(pos * 8 + i) * 2], s = ropeB[(pos * 8 + i) * 2 + 1];
        float xo = bf2f((u16)own[i]), xp = bf2f((u16)par[i]);
        float o = ((quad & 1) == 0) ? (xo * c - xp * s) : (xp * s + xo * c);
        res[i] = (short)f2bf(o);
      }
      qf[qi][KS - 1] = res;
    }
  }
  auto koff = [&](int t) -> int { return (MODE == 1) ? ((t < 8) ? (256 + (r0 + t) * 64) : ((t - 8) * 64)) : t * 64; };
  unsigned char* dstw = smem + __builtin_amdgcn_readfirstlane(tid >> 6) * 1024;
  auto issue = [&](int t, int buf) {
    const int ko = koff(t);
#pragma unroll
    for (int i = 0; i < LK; ++i) {
      const int L = tid + 256 * i;
      int row, c;
      if (DQK == 64) { row = L >> 3; c = (L & 7) ^ (row & 7); }
      else { row = L / 12; const int pp = L - row * 12; c = (pp & ~3) | ((pp & 3) ^ ((0x1230 >> (((row >> 2) & 3) * 4)) & 3)); }
      __builtin_amdgcn_global_load_lds((const unsigned*)(Kp + (size_t)(ko + row) * ldk + c * 8), (unsigned*)(dstw + buf * SBF + i * 4096), 16, 0, 0);
    }
#pragma unroll
    for (int i = 0; i < 2; ++i) {
      const int L = tid + 256 * i;
      const int d = L >> 3, c = (L & 7) ^ (d & 7);
      __builtin_amdgcn_global_load_lds((const unsigned*)(Vtp + (size_t)d * TL + ko + c * 8), (unsigned*)(dstw + buf * SBF + KB_ + i * 4096), 16, 0, 0);
    }
  };
  int koffs[KS];
#pragma unroll
  for (int ks = 0; ks < KS; ++ks) {
    const int c = ks * 4 + quad;
    if (DQK == 64) koffs[ks] = l15 * 128 + ((c ^ (l15 & 7)) * 16);
    else koffs[ks] = l15 * 192 + (((c & ~3) | ((c & 3) ^ ((0x1230 >> ((l15 >> 2) * 4)) & 3))) * 16);
  }
  int voffs[2][2];
#pragma unroll
  for (int kk = 0; kk < 2; ++kk)
#pragma unroll
    for (int ab = 0; ab < 2; ++ab) {
      const int keyb = ((2 * kk + ab) * 16 + quad * 4) * 2;
      const int c = keyb >> 4;
      voffs[kk][ab] = l15 * 128 + ((c ^ (l15 & 7)) * 16) + (keyb & 15);
    }
  f32x4 o[4][NQ];
  float m[NQ], lsum[NQ];
#pragma unroll
  for (int qi = 0; qi < NQ; ++qi) {
    m[qi] = -INFINITY; lsum[qi] = 0.f;
#pragma unroll
    for (int dt = 0; dt < 4; ++dt) o[dt][qi] = (f32x4){0.f, 0.f, 0.f, 0.f};
  }
  const int qc = wave * 16 + l15;
  const int st = min(max(qc - 8, 0), 48);
  GEMM_WAIT_VM(0);
#pragma unroll
  for (int s_ = 0; s_ < NS - 1; ++s_)
    if (s_ < ntiles) issue(s_, s_);
  int buf = 0;
  for (int t = 0; t < ntiles; ++t) {
    if (!(abl & 4)) {
      const int rem = ntiles - 1 - t;
      if (NS == 4) {
        if (rem >= 2) GEMM_WAIT_VM(8); else if (rem == 1) GEMM_WAIT_VM(4); else GEMM_WAIT_VM(0);
      } else {
        if (rem >= 1) GEMM_WAIT_VM(5); else GEMM_WAIT_VM(0);
      }
    }
    if (!(abl & 8)) raw_barrier();
    if (!(abl & 4) && t + NS - 1 < ntiles) { int nb = buf + NS - 1; if (nb >= NS) nb -= NS; issue(t + NS - 1, nb); }
    const unsigned char* k_s = smem + buf * SBF;
    const unsigned char* v_s = k_s + KB_;
    f32x4 s[4][NQ];
    {
      bf16x8 kf[4][KS];
#pragma unroll
      for (int kt = 0; kt < 4; ++kt)
#pragma unroll
        for (int ks = 0; ks < KS; ++ks) kf[kt][ks] = *(const bf16x8*)(k_s + kt * 16 * DQK * 2 + koffs[ks]);
      __builtin_amdgcn_sched_barrier(0);
#pragma unroll
      for (int kt = 0; kt < 4; ++kt) {
#pragma unroll
        for (int qi = 0; qi < NQ; ++qi) s[kt][qi] = (f32x4){0.f, 0.f, 0.f, 0.f};
#pragma unroll
        for (int ks = 0; ks < KS; ++ks)
#pragma unroll
          for (int qi = 0; qi < NQ; ++qi) s[kt][qi] = __builtin_amdgcn_mfma_f32_16x16x32_bf16(kf[kt][ks], qf[qi][ks], s[kt][qi], 0, 0, 0);
      }
    }
    uint2 vfa[2][4], vfb[2][4];
#pragma unroll
    for (int kk = 0; kk < 2; ++kk)
#pragma unroll
      for (int dt = 0; dt < 4; ++dt) {
        vfa[kk][dt] = *(const uint2*)(v_s + dt * 2048 + voffs[kk][0]);
        vfb[kk][dt] = *(const uint2*)(v_s + dt * 2048 + voffs[kk][1]);
      }
    __builtin_amdgcn_sched_barrier(0);
    const float c2 = scale * L2E;
    if (MODE == 1 && t < 8) {
      const int drow = r0 + t - nat_r + 7;
#pragma unroll
      for (int kt = 0; kt < 4; ++kt)
#pragma unroll
        for (int j = 0; j < 4; ++j) {
          int kc = kt * 16 + quad * 4 + j;
          bool valid = (kc >= st) && (kc < st + 16);
          int bi = drow * 31 + (kc - qc + 15);
          bi = valid ? bi : 0;
          float bv = sBias[bi];
          s[kt][0][j] = valid ? (s[kt][0][j] * c2 + bv * L2E) : -INFINITY;
        }
    }
    const bool pre = (MODE == 1 && t < 8);
    bf16x8 pb[NQ][2];
    if (abl & 1) {
#pragma unroll
      for (int qi = 0; qi < NQ; ++qi)
#pragma unroll
        for (int kk = 0; kk < 2; ++kk) {
          uint4 u = make_uint4(pack2(s[2 * kk][qi][0], s[2 * kk][qi][1]), pack2(s[2 * kk][qi][2], s[2 * kk][qi][3]),
                               pack2(s[2 * kk + 1][qi][0], s[2 * kk + 1][qi][1]), pack2(s[2 * kk + 1][qi][2], s[2 * kk + 1][qi][3]));
          pb[qi][kk] = __builtin_bit_cast(bf16x8, u);
        }
    } else
#pragma unroll
    for (int qi = 0; qi < NQ; ++qi) {
      float mx = fmaxf(fmaxf(s[0][qi][0], s[0][qi][1]), fmaxf(s[0][qi][2], s[0][qi][3]));
#pragma unroll
      for (int kt = 1; kt < 4; ++kt) mx = fmaxf(mx, fmaxf(fmaxf(s[kt][qi][0], s[kt][qi][1]), fmaxf(s[kt][qi][2], s[kt][qi][3])));
      mx = xq_max(mx);
      const float cc = pre ? 1.f : c2;
      const float mnew = fmaxf(m[qi], mx * cc);
      const bool grew = __builtin_amdgcn_ballot_w64(mnew > m[qi]) != 0;
      const float alpha = __builtin_amdgcn_exp2f(m[qi] - mnew);
      m[qi] = mnew;
      float ps = 0.f;
#pragma unroll
      for (int kt = 0; kt < 4; ++kt)
#pragma unroll
        for (int j = 0; j < 4; ++j) {
          float pv = __builtin_amdgcn_exp2f(s[kt][qi][j] * cc - mnew);
          s[kt][qi][j] = pv;
          ps += pv;
        }
      if (grew) {
        lsum[qi] *= alpha;
#pragma unroll
        for (int dt = 0; dt < 4; ++dt)
#pragma unroll
          for (int j = 0; j < 4; ++j) o[dt][qi][j] *= alpha;
      }
      lsum[qi] += ps;
#pragma unroll
      for (int kk = 0; kk < 2; ++kk) {
        uint4 u = make_uint4(pack2(s[2 * kk][qi][0], s[2 * kk][qi][1]), pack2(s[2 * kk][qi][2], s[2 * kk][qi][3]),
                             pack2(s[2 * kk + 1][qi][0], s[2 * kk + 1][qi][1]), pack2(s[2 * kk + 1][qi][2], s[2 * kk + 1][qi][3]));
        pb[qi][kk] = __builtin_bit_cast(bf16x8, u);
      }
    }
#pragma unroll
    for (int kk = 0; kk < 2; ++kk)
#pragma unroll
      for (int dt = 0; dt < 4; ++dt) {
        uint4 vv = make_uint4(vfa[kk][dt].x, vfa[kk][dt].y, vfb[kk][dt].x, vfb[kk][dt].y);
        bf16x8 av = __builtin_bit_cast(bf16x8, vv);
#pragma unroll
        for (int qi = 0; qi < NQ; ++qi) o[dt][qi] = __builtin_amdgcn_mfma_f32_16x16x32_bf16(av, pb[qi][kk], o[dt][qi], 0, 0, 0);
      }
    if (++buf == NS) buf = 0;
  }
  raw_barrier();
#pragma unroll
  for (int qi = 0; qi < NQ; ++qi) {
    float l = xq_sum(lsum[qi]);
    const float inv = 1.f / l;
    const int row = wave * 16 * NQ + qi * 16 + l15;
#pragma unroll
    for (int dt = 0; dt < 4; ++dt)
      *(uint2*)(Op + (size_t)row * ldo + dt * 16 + quad * 4) =
          make_uint2(pack2(o[dt][qi][0] * inv, o[dt][qi][1] * inv), pack2(o[dt][qi][2] * inv, o[dt][qi][3] * inv));
  }
}

__device__ void scan_item(const Params& p, int l, int bl, int h, int dir, int half, unsigned char* smem, const int tid, const int abl) {
  float* R = (float*)smem;
  float* V = R + 2048;
  float* KK = V + 2048;
  float* KD = KK + 2048;
  float* W = KD + 2048;
  float* T1 = W + 2048;
  float* Y = T1 + 2048;
  float* BONW = Y + 2048;
  u16* XW = (u16*)(BONW + 128);
  u16* XA = XW + 32 * 72;
  const int lane = tid & 63, wave = tid >> 6, l15 = lane & 15, quad = lane >> 4;
  const u16* P = (const u16*)(p.ws + OFF_P);
  u16* Yd = (u16*)(p.ws + (dir ? OFF_YB : OFF_YF));
  float* BON = (float*)(p.ws + OFF_BON);
  const u16* Wl = (const u16*)(p.ws + OFF_W) + (size_t)l * W_TOTAL;
  const float* mu = p.in[15] + l * 1920;
  const int nn = wave * 16 + l15;
  const float w0 = p.in[16][(l * 2 + dir) * 512 + h * 64 + nn];
  const float a0 = p.in[18][(l * 2 + dir) * 512 + h * 64 + nn];
  const float ka = p.in[22][l * 512 + h * 64 + nn];
  const float rk = p.in[23][l * 512 + h * 64 + nn];
  bf16x8 wdec[2], waaa[2];
#pragma unroll
  for (int ks = 0; ks < 2; ++ks) {
    wdec[ks] = *(const bf16x8*)(Wl + W_DEC + ((size_t)dir * 512 + h * 64 + nn) * 64 + ks * 32 + quad * 8);
    waaa[ks] = *(const bf16x8*)(Wl + W_AAA + ((size_t)dir * 512 + h * 64 + nn) * 64 + ks * 32 + quad * 8);
  }
  const int st_t = tid >> 3, part = tid & 7, n0 = part * 8;
  const int sl = lane & 7, srow = half * 32 + wave * 8 + (lane >> 3);
  v2f S2[4];
#pragma unroll
  for (int i = 0; i < 4; ++i) S2[i] = (v2f){0.f, 0.f};
  float* MU = (float*)(XA + 32 * 72);
  float* KKC = MU + 320;
  for (int i = tid; i < 384; i += 256) {
    int g = i >> 6, n = i & 63;
    float v;
    if (g == 0) v = mu[h * 64 + n];
    else if (g == 1) v = mu[1024 + h * 64 + n];
    else if (g == 2) v = mu[512 + h * 64 + n];
    else if (g == 3) v = mu[1536 + dir * 64 + n];
    else if (g == 4) v = mu[1664 + dir * 64 + n];
    else v = p.in[21][l * 512 + h * 64 + n];
    MU[i] = v;
  }
  uint4 raw[15];
  auto issue_raw = [&](int cidx) {
    const int seg = cidx >= 8;
    const int cc = seg ? cidx - 8 : cidx, nch = seg ? 64 : 8, len = seg ? 2048 : 256;
    const int tb = bl * TL + (seg ? 256 : 0);
    const int c = dir ? (nch - 1 - cc) : cc;
    const int pos = c * 32 + st_t;
    const bool hasp = pos > 0, hasn = pos < len - 1;
    const u16* rowp = P + (size_t)(tb + pos) * NP + n0;
    const int cols[5] = {PC_R + h * 64, PC_V + h * 64, PC_K + h * 64, PC_WLO + dir * 64, PC_ALO + dir * 64};
#pragma unroll
    for (int g = 0; g < 5; ++g) {
      raw[3 * g] = *(const uint4*)(rowp + cols[g]);
      raw[3 * g + 1] = make_uint4(0, 0, 0, 0);
      raw[3 * g + 2] = make_uint4(0, 0, 0, 0);
      if (hasp) raw[3 * g + 1] = *(const uint4*)(rowp + cols[g] - NP);
      if (hasn) raw[3 * g + 2] = *(const uint4*)(rowp + cols[g] + NP);
    }
  };
  issue_raw(0);
  __syncthreads();

  for (int cidx = 0; cidx < 72; ++cidx) {
    {
      const int seg = cidx >= 8;
      const int cc = seg ? cidx - 8 : cidx, nch = seg ? 64 : 8;
      const int tb = bl * TL + (seg ? 256 : 0);
      const int c = dir ? (nch - 1 - cc) : cc;
      const int pos0 = c * 32;
      {
#define SHIFT8(G, z)                                                                              \
  {                                                                                               \
    const uint4 c4 = raw[3 * (G)], p4 = raw[3 * (G) + 1], n4 = raw[3 * (G) + 2];                  \
    const float4 m0 = *(const float4*)(MU + (G)*64 + n0), m1 = *(const float4*)(MU + (G)*64 + n0 + 4); \
    const float mm[8] = {m0.x, m0.y, m0.z, m0.w, m1.x, m1.y, m1.z, m1.w};                          \
    const uint32_t cu[4] = {c4.x, c4.y, c4.z, c4.w}, pu[4] = {p4.x, p4.y, p4.z, p4.w}, nu[4] = {n4.x, n4.y, n4.z, n4.w}; \
    _Pragma("unroll") for (int i = 0; i < 4; ++i) {                                               \
      float c0 = lo2f(cu[i]), c1 = hi2f(cu[i]);                                                   \
      z[2 * i] = c0 + (0.5f * (lo2f(pu[i]) + lo2f(nu[i])) - c0) * mm[2 * i];                      \
      z[2 * i + 1] = c1 + (0.5f * (hi2f(pu[i]) + hi2f(nu[i])) - c1) * mm[2 * i + 1];              \
    }                                                                                             \
  }
        float z[8];
        SHIFT8(0, z);
        *(float4*)(R + st_t * 64 + n0) = make_float4(z[0], z[1], z[2], z[3]);
        *(float4*)(R + st_t * 64 + n0 + 4) = make_float4(z[4], z[5], z[6], z[7]);
        SHIFT8(1, z);
        *(float4*)(V + st_t * 64 + n0) = make_float4(z[0], z[1], z[2], z[3]);
        *(float4*)(V + st_t * 64 + n0 + 4) = make_float4(z[4], z[5], z[6], z[7]);
        SHIFT8(2, z);
        {
          const float4 k0 = *(const float4*)(KKC + n0), k1 = *(const float4*)(KKC + n0 + 4);
          const float kc[8] = {k0.x, k0.y, k0.z, k0.w, k1.x, k1.y, k1.z, k1.w};
          float q[8], ss = 0.f;
#pragma unroll
          for (int i = 0; i < 8; ++i) { q[i] = z[i] * kc[i]; ss += q[i] * q[i]; }
          *(float4*)(KD + st_t * 64 + n0) = make_float4(z[0], z[1], z[2], z[3]);
          *(float4*)(KD + st_t * 64 + n0 + 4) = make_float4(z[4], z[5], z[6], z[7]);
          ss = row8_sum(ss);
          const float inv = 1.f / fmaxf(sqrtf(ss), 1e-12f);
          *(float4*)(KK + st_t * 64 + n0) = make_float4(q[0] * inv, q[1] * inv, q[2] * inv, q[3] * inv);
          *(float4*)(KK + st_t * 64 + n0 + 4) = make_float4(q[4] * inv, q[5] * inv, q[6] * inv, q[7] * inv);
        }
        SHIFT8(3, z);
        {
          float th[8];
#pragma unroll
          for (int i = 0; i < 8; ++i) th[i] = 1.f - 2.f / (1.f + __expf(2.f * z[i]));
          *(uint4*)(XW + st_t * 72 + n0) = make_uint4(pack2(th[0], th[1]), pack2(th[2], th[3]), pack2(th[4], th[5]), pack2(th[6], th[7]));
        }
        SHIFT8(4, z);
        *(uint4*)(XA + st_t * 72 + n0) = make_uint4(pack2(z[0], z[1]), pack2(z[2], z[3]), pack2(z[4], z[5]), pack2(z[6], z[7]));
#undef SHIFT8
      }
      raw_barrier();
#pragma unroll
      for (int mt = 0; mt < 2; ++mt) {
        f32x4 aw = (f32x4){0.f, 0.f, 0.f, 0.f}, aa = (f32x4){0.f, 0.f, 0.f, 0.f};
#pragma unroll
        for (int ks = 0; ks < 2; ++ks) {
          bf16x8 xw = *(const bf16x8*)(XW + (mt * 16 + l15) * 72 + ks * 32 + quad * 8);
          bf16x8 xa = *(const bf16x8*)(XA + (mt * 16 + l15) * 72 + ks * 32 + quad * 8);
          aw = __builtin_amdgcn_mfma_f32_16x16x32_bf16(xw, wdec[ks], aw, 0, 0, 0);
          aa = __builtin_amdgcn_mfma_f32_16x16x32_bf16(xa, waaa[ks], aa, 0, 0, 0);
        }
#pragma unroll
        for (int j = 0; j < 4; ++j) {
          const int t = mt * 16 + quad * 4 + j;
          const float wv = __expf(-0.6065306597126334f / (1.f + __expf(-(w0 + aw[j]))));
          const float av = 1.f / (1.f + __expf(-(a0 + aa[j])));
          W[t * 64 + nn] = wv;
          T1[t * 64 + nn] = KK[t * 64 + nn] * av;
          const float kd = KD[t * 64 + nn] * (1.f + (av - 1.f) * ka);
          KD[t * 64 + nn] = kd;
          const float bon = row16_sum(R[t * 64 + nn] * kd * rk);
          if (l15 == 0) BONW[wave * 32 + t] = bon;
        }
      }
      if (cidx + 1 < 72) issue_raw(cidx + 1);
      raw_barrier();
      {
        float4 Akk0, Akk1, At0, At1, Ad0, Ad1, Aw0, Aw1, Ar0, Ar1, Bkk0, Bkk1, Bt0, Bt1, Bd0, Bd1, Bw0, Bw1, Br0, Br1;
        float Av, Bv;
#define SCAN_LOAD(X, I)                                                  \
  {                                                                      \
    const int o_ = (I) * 64 + sl * 8;                                    \
    X##kk0 = *(const float4*)(KK + o_); X##kk1 = *(const float4*)(KK + o_ + 4); \
    X##t0 = *(const float4*)(T1 + o_);  X##t1 = *(const float4*)(T1 + o_ + 4);  \
    X##d0 = *(const float4*)(KD + o_);  X##d1 = *(const float4*)(KD + o_ + 4);  \
    X##w0 = *(const float4*)(W + o_);   X##w1 = *(const float4*)(W + o_ + 4);   \
    X##r0 = *(const float4*)(R + o_);   X##r1 = *(const float4*)(R + o_ + 4);   \
    X##v = V[(I) * 64 + srow];                                           \
  }
#define SCAN_PRE(C, KDv, Wv)    \
  const v2f tmp##C = S2[C] * (Wv) + vv0 * (KDv);
#define SCAN_EL(C, T1v, Rv)                                              \
  {                                                                      \
    const v2f t1_ = T1v, r_ = Rv;                                        \
    S2[C] = tmp##C + nsa0 * t1_;                                         \
    if ((C) & 1) y1 += S2[C] * r_; else y0 += S2[C] * r_;                \
  }
#define SCAN_STEP(X, I)                                                  \
  {                                                                      \
    const v2f k0 = (v2f){X##kk0.x, X##kk0.y}, k1 = (v2f){X##kk0.z, X##kk0.w}, k2 = (v2f){X##kk1.x, X##kk1.y}, k3 = (v2f){X##kk1.z, X##kk1.w}; \
    v2f a0 = S2[0] * k0, a0b = S2[1] * k1;                               \
    a0 += S2[2] * k2; a0b += S2[3] * k3;                                 \
    a0 += a0b;                                                           \
    const v2f vv0 = (v2f){X##v, X##v};                                   \
    SCAN_PRE(0, ((v2f){X##d0.x, X##d0.y}), ((v2f){X##w0.x, X##w0.y}))    \
    SCAN_PRE(1, ((v2f){X##d0.z, X##d0.w}), ((v2f){X##w0.z, X##w0.w}))    \
    SCAN_PRE(2, ((v2f){X##d1.x, X##d1.y}), ((v2f){X##w1.x, X##w1.y}))    \
    SCAN_PRE(3, ((v2f){X##d1.z, X##d1.w}), ((v2f){X##w1.z, X##w1.w}))    \
    const float sa0 = row8_sum(a0.x + a0.y);                             \
    const v2f nsa0 = (v2f){-sa0, -sa0};                                  \
    v2f y0 = (v2f){0.f, 0.f}, y1 = (v2f){0.f, 0.f};                      \
    SCAN_EL(0, ((v2f){X##t0.x, X##t0.y}), ((v2f){X##r0.x, X##r0.y}))     \
    SCAN_EL(1, ((v2f){X##t0.z, X##t0.w}), ((v2f){X##r0.z, X##r0.w}))     \
    SCAN_EL(2, ((v2f){X##t1.x, X##t1.y}), ((v2f){X##r1.x, X##r1.y}))     \
    SCAN_EL(3, ((v2f){X##t1.z, X##t1.w}), ((v2f){X##r1.z, X##r1.w}))     \
    y0 += y1;                                                            \
    const float ys0 = row8_sum(y0.x + y0.y);                             \
    if (sl == 0) Y[(I) * 64 + srow] = ys0;                               \
  }
        SCAN_LOAD(A, dir ? 31 : 0);
        for (int s = 0; s < ((abl & 32) ? 0 : 32); s += 2) {
          const int i0 = dir ? (31 - s) : s, i1 = dir ? (30 - s) : (s + 1);
          SCAN_LOAD(B, i1);
          SCAN_STEP(A, i0);
          if (s + 2 < 32) { SCAN_LOAD(A, dir ? (29 - s) : (s + 2)); }
          SCAN_STEP(B, i1);
        }
#undef SCAN_LOAD
#undef SCAN_EL
#undef SCAN_PRE
#undef SCAN_STEP
      }
      raw_barrier();
      {
        const float* yp = Y + st_t * 64 + half * 32 + part * 4;
        const size_t tok = (size_t)(tb + pos0 + st_t);
        *(uint2*)(Yd + tok * 512 + h * 64 + half * 32 + part * 4) = make_uint2(pack2(yp[0], yp[1]), pack2(yp[2], yp[3]));
        if (part == 0 && half == 0) BON[tok * 16 + h * 2 + dir] = BONW[st_t] + BONW[32 + st_t] + BONW[64 + st_t] + BONW[96 + st_t];
      }
    }
  }
  __syncthreads();
}

__device__ void phase_mixers(const Params& p, int chunk, int l, bool with_ctx, int* counter, unsigned char* smem, u16* dum, int kmask) {
  int& s_item = *(int*)(smem + SMEM_BYTES + 16);
  u16* sm = (u16*)smem;
  u16* P = (u16*)(p.ws + OFF_P);
  const u16* KA = (const u16*)(p.ws + OFF_KA);
  const u16* VtA = (const u16*)(p.ws + OFF_VTA);
  const u16* QB = (const u16*)(p.ws + OFF_QB);
  const u16* KB = (const u16*)(p.ws + OFF_KB);
  const u16* VtB = (const u16*)(p.ws + OFF_VTB);
  const u16* VtD = (const u16*)(p.ws + OFF_VTD);
  const float* ropeB = (const float*)(p.ws + OFF_ROPE) + 64 * 16 * 2;
  const int n_scan = BC * 8 * 2 * 2;
  const int n_al = BC * 8 * 16;
  const int n_nat = BC * 8 * 32;
  const int n_cx = BC * 8 * 2;
  const int total = n_scan + 2 * n_al + n_nat + (with_ctx ? 3 * n_cx : 0);
  const float scaleB = 0.10206207261596575f;
  while (true) {
    const int tid = otid();
    if (tid == 0) s_item = atomicAdd(counter, 1);
    __syncthreads();
    int it = s_item;
    __syncthreads();
    if (it >= total) break;
    if (it < n_scan) {
      if (!(kmask & 1)) continue;
      int half = it & 1, dir = (it >> 1) & 1, h = (it >> 2) & 7, bl = it >> 5;
      __builtin_amdgcn_s_setprio(3);
      scan_item(p, l, bl, h, dir, half, smem, otid(), dum ? PR_ABL : 0);
      __builtin_amdgcn_s_setprio(0);
      continue;
    }
    it -= n_scan;
    int kind, h, bl, ntl;
    size_t tok0;
    bool rq = false;
    int qtok0 = 0, natr = 0;
    if (it < 2 * n_al) {
      kind = (it >= n_al) ? 1 : 0;
      int i2 = it - kind * n_al;
      int qt = i2 & 15; h = (i2 >> 4) & 7; bl = i2 >> 7;
      tok0 = (size_t)bl * TL + 256 + qt * 128; ntl = 36; rq = true; qtok0 = qt * 128;
    } else if (it < 2 * n_al + n_nat) {
      int i2 = it - 2 * n_al;
      kind = 3; natr = i2 & 31; h = (i2 >> 5) & 7; bl = i2 >> 8;
      tok0 = (size_t)bl * TL + 256 + natr * 64; ntl = 12;
    } else {
      int i2 = it - 2 * n_al - n_nat;
      kind = i2 / n_cx; i2 -= kind * n_cx;
      int qt = i2 & 1; h = (i2 >> 1) & 7; bl = i2 >> 4;
      tok0 = (size_t)bl * TL + qt * 128; ntl = 4;
    }
    {
      const int cls = (ntl == 36) ? (kind == 0 ? 2 : 4) : (ntl == 12 ? 8 : 16);
      if (!(kmask & cls)) continue;
    }
    if (kind == 1) {
      flash_item<96, 2, 0>(QB + tok0 * 768 + h * 96, 768, KB + (size_t)(bl * 8 + h) * TL * 96, 96, VtB + (size_t)(bl * 8 + h) * 64 * TL,
                           ntl, dum ? (dum + tok0 * 1536 + 512 + h * 64) : (P + tok0 * NP + O_B + h * 64), dum ? 1536 : NP, scaleB, rq, qtok0, ropeB, 0, nullptr, smem, otid(), dum ? PR_ABL : 0);
    } else if (kind == 3) {
      u16* q = P + tok0 * NP + PD_Q + h * 64;
      flash_item<64, 1, 1>(q, NP, P + (size_t)bl * TL * NP + PD_K + h * 64, NP, VtD + (size_t)(bl * 8 + h) * 64 * TL, ntl, dum ? (dum + tok0 * 1536 + 1024 + h * 64) : q, dum ? 1536 : NP, 0.125f,
                           false, 0, ropeB, natr, p.in[26] + (size_t)(l * 8 + h) * 15 * 31, smem, otid(), dum ? PR_ABL : 0);
    } else {
      u16* q = P + tok0 * NP + (kind == 0 ? PA_Q : PD_Q) + h * 64;
      const u16* kp = (kind == 0) ? (KA + (size_t)(bl * 2 + (h >> 2)) * TL * 64) : (P + (size_t)bl * TL * NP + PD_K + h * 64);
      const u16* vp = (kind == 0) ? (VtA + (size_t)(bl * 2 + (h >> 2)) * 64 * TL) : (VtD + (size_t)(bl * 8 + h) * 64 * TL);
      flash_item<64, 2, 0>(q, NP, kp, (kind == 0) ? 64 : NP, vp, ntl, dum ? (dum + tok0 * 1536 + (kind == 0 ? 0 : 1024) + h * 64) : q, dum ? 1536 : NP, 0.125f, false, 0, ropeB, 0, nullptr, smem, otid(), dum ? PR_ABL : 0);
    }
  }
}

__device__ void phase_cout(const Params& p, int l, bool latonly) {
  const int tid = otid();
  const int lane = tid & 63, wave = tid >> 6;
  u16* P = (u16*)(p.ws + OFF_P);
  const u16* YF = (const u16*)(p.ws + OFF_YF);
  const u16* YB = (const u16*)(p.ws + OFF_YB);
  const u16* G = (const u16*)(p.ws + OFF_G);
  const float* BON = (const float*)(p.ws + OFF_BON);
  const float* gnw = p.in[24] + l * 512;
  const float* gnb = p.in[25] + l * 512;
  const float* mu = p.in[15] + l * 1920 + 1024;
  for (int tok = blockIdx.x * 4 + wave; tok < TC; tok += gridDim.x * 4) {
    const int bl = tok / TL, j = tok - bl * TL;
    const bool islat = j >= 256;
    if (latonly && !islat) continue;
    const int jj = j - 256;
    const bool hasp = islat ? (jj > 0) : (j > 0);
    const bool hasn = islat ? (jj < 2047) : (j < 255);
    u16* pr = P + (size_t)tok * NP;
    u16 yf[8], yb[8], gg[8], vcu[8], vpu[8], vnu[8];
    float bon[8];
#pragma unroll
    for (int h = 0; h < 8; ++h) {
      const int col = h * 64 + lane;
      yf[h] = YF[(size_t)tok * 512 + col];
      yb[h] = YB[(size_t)tok * 512 + col];
      gg[h] = G[(size_t)tok * 512 + col];
      vcu[h] = pr[PC_V + col];
      vpu[h] = hasp ? pr[PC_V + col - NP] : (u16)0;
      vnu[h] = hasn ? pr[PC_V + col + NP] : (u16)0;
      bon[h] = BON[(size_t)tok * 16 + h * 2] + BON[(size_t)tok * 16 + h * 2 + 1];
    }
#pragma unroll
    for (int h = 0; h < 8; ++h) {
      const int col = h * 64 + lane;
      const float y = bf2f(yf[h]) + bf2f(yb[h]);
      const float mean = wave_sum(y) * (1.f / 64.f);
      const float d = y - mean;
      const float var = wave_sum(d * d) * (1.f / 64.f);
      const float yn = d * rsqrtf(var + 64e-5f) * gnw[col] + gnb[col];
      const float vc = bf2f(vcu[h]);
      const float vs = vc + (0.5f * (bf2f(vpu[h]) + bf2f(vnu[h])) - vc) * mu[col];
      const float oc = (yn + bon[h] * vs) * bf2f(gg[h]);
      pr[O_C + col] = f2bf(oc);
    }
  }
}

#ifndef PR_GEMM1
#define PR_GEMM1 0
#endif
#ifndef PR_MERGE
#define PR_MERGE 0
#endif
#ifndef PR_KIND
#define PR_KIND -1
#endif
__device__ void phase_probe(const Params& p, int l, int kind, unsigned char* smem) {
  u16* sm = (u16*)smem;
  u16* P = (u16*)(p.ws + OFF_P);
  u16* DUM = (u16*)(p.ws + OFF_YM);
  const float* ropeB = (const float*)(p.ws + OFF_ROPE) + 64 * 16 * 2;
  const int total = (kind == 0) ? 128 : (kind == 3 ? 2048 : 1024);
  for (int it = blockIdx.x; it < total; it += gridDim.x) {
    if (kind == 0) {
      int dir = it & 1, h = (it >> 1) & 7, bl = it >> 4;
      scan_item(p, l, bl, h, dir, 0, smem, otid(), 0);
      scan_item(p, l, bl, h, dir, 1, smem, otid(), 0);
    } else if (kind == 1) {
      int qt = it & 15, h = (it >> 4) & 7, bl = it >> 7;
      size_t tok0 = (size_t)bl * TL + 256 + qt * 128;
      flash_item<64, 2, 0>(P + tok0 * NP + PA_Q + h * 64, NP, (const u16*)(p.ws + OFF_KA) + (size_t)(bl * 2 + (h >> 2)) * TL * 64, 64,
                           (const u16*)(p.ws + OFF_VTA) + (size_t)(bl * 2 + (h >> 2)) * 64 * TL, 36, DUM + tok0 * 1024 + h * 64, 1024,
                           0.125f, false, 0, ropeB, 0, nullptr, smem, otid(), 0);
    } else if (kind == 2) {
      int qt = it & 15, h = (it >> 4) & 7, bl = it >> 7;
      size_t tok0 = (size_t)bl * TL + 256 + qt * 128;
      flash_item<96, 2, 0>((const u16*)(p.ws + OFF_QB) + tok0 * 768 + h * 96, 768, (const u16*)(p.ws + OFF_KB) + (size_t)(bl * 8 + h) * TL * 96,
                           96, (const u16*)(p.ws + OFF_VTB) + (size_t)(bl * 8 + h) * 64 * TL, 36, P + tok0 * NP + O_B + h * 64, NP,
                           0.10206207261596575f, true, qt * 128, ropeB, 0, nullptr, smem, otid(), 0);
    } else {
      int r = it & 31, h = (it >> 5) & 7, bl = it >> 8;
      size_t tok0 = (size_t)bl * TL + 256 + r * 64;
      flash_item<64, 1, 1>(P + tok0 * NP + PD_Q + h * 64, NP, P + (size_t)bl * TL * NP + PD_K + h * 64, NP,
                           (const u16*)(p.ws + OFF_VTD) + (size_t)(bl * 8 + h) * 64 * TL, 12, DUM + tok0 * 1024 + h * 64, 1024, 0.125f,
                           false, 0, ropeB, r, p.in[26] + (size_t)(l * 8 + h) * 15 * 31, smem, otid(), 0);
    }
  }
}

#define XB_TMO      128
#define XB_XCNT(j)  (256  + 64 * (j))
#define XB_XSUB(j)  (1280 + 64 * (j))
#define XB_XGEN(j)  (2304 + 64 * (j))
#define XB_TOP      3328
#define XB_TOPGEN   3392
#define XCD_BAR_WORDS 3456
#define XB_SPIN_CAP (1u << 18)
#define LAS __attribute__((address_space(3)))
DI unsigned xb_ld(unsigned* p) { return __hip_atomic_load(p, __ATOMIC_RELAXED, __HIP_MEMORY_SCOPE_AGENT); }
DI unsigned xb_add(unsigned* p, unsigned v) { return __hip_atomic_fetch_add(p, v, __ATOMIC_RELAXED, __HIP_MEMORY_SCOPE_AGENT); }
DI unsigned xb_xcc_id() { return (unsigned)__builtin_amdgcn_s_getreg((3 << 11) | 20) & 0xFu; }
#define XB_SPIN(cond, bar) do { unsigned _sp = 0; while (cond) { __builtin_amdgcn_s_sleep(1); \
    if ((++_sp & 255u) == 0u) { if (xb_ld(&(bar)[XB_TMO])) break; if (_sp > XB_SPIN_CAP) { atomicAdd(&(bar)[XB_TMO], 1u); break; } } } } while (0)
struct XcdBarrier { unsigned* bar; unsigned x; volatile LAS unsigned* st; };
DI XcdBarrier xcd_barrier_post(unsigned* bar, volatile LAS unsigned* st) {
  XcdBarrier b; b.bar = bar; b.x = xb_xcc_id(); b.st = st;
  if (threadIdx.x == 0) (void)xb_add(&bar[XB_XCNT(b.x)], 1u);
  return b;
}
DI void xcd_barrier_complete(unsigned* bar, unsigned x, unsigned& nloc, unsigned& nx) {
  const unsigned G = gridDim.x * gridDim.y * gridDim.z;
  unsigned sum, cnt, mine, sp = 0u;
  for (;;) {
    sum = 0u; cnt = 0u; mine = 0u;
#pragma unroll
    for (unsigned j = 0; j < 16; ++j) { const unsigned c = xb_ld(&bar[XB_XCNT(j)]); sum += c; cnt += (c > 0u) ? 1u : 0u; mine = (j == x) ? c : mine; }
    if (sum == G) break;
    __builtin_amdgcn_s_sleep(1);
    if ((++sp & 255u) == 0u) { if (xb_ld(&bar[XB_TMO])) break; if (sp > XB_SPIN_CAP) { atomicAdd(&bar[XB_TMO], 1u); break; } }
  }
  nloc = mine > 0u ? mine : 1u; nx = cnt > 0u ? cnt : 1u;
}
DI void xcd_barrier(const XcdBarrier& b) {
  asm volatile("s_waitcnt vmcnt(0)" ::: "memory");
  __syncthreads();
  if (threadIdx.x == 0) {
    unsigned* bar = b.bar;
    __builtin_amdgcn_s_waitcnt(0);
    unsigned nloc = b.st[0], nx = b.st[1];
    if (nloc == 0u) { xcd_barrier_complete(bar, b.x, nloc, nx); b.st[0] = nloc; b.st[1] = nx; }
    const unsigned old = xb_add(&bar[XB_XSUB(b.x)], 1u);
    const unsigned gen = old / nloc;
    if (old + 1u == (gen + 1u) * nloc) {
      __builtin_amdgcn_fence(__ATOMIC_RELEASE, "agent");
      asm volatile("s_waitcnt vmcnt(0)" ::: "memory");
      const unsigned og = xb_add(&bar[XB_TOP], 1u);
      const unsigned tg = og / nx;
      if (og + 1u == (tg + 1u) * nx) xb_add(&bar[XB_TOPGEN], 1u);
      else XB_SPIN(xb_ld(&bar[XB_TOPGEN]) == tg, bar);
      __builtin_amdgcn_fence(__ATOMIC_ACQUIRE, "agent");
      xb_add(&bar[XB_XGEN(b.x)], 1u);
      asm volatile("s_waitcnt vmcnt(0)" ::: "memory");
    } else {
      XB_SPIN(xb_ld(&bar[XB_XGEN(b.x)]) == gen, bar);
      __builtin_amdgcn_fence(__ATOMIC_ACQUIRE, "agent");
      asm volatile("s_waitcnt vmcnt(0)" ::: "memory");
    }
  }
  __syncthreads();
}

__global__ void __launch_bounds__(256, 2) fwd_megakernel(Params p) {
  extern __shared__ __attribute__((aligned(16))) unsigned char smem[];
  cg::grid_group grid = cg::this_grid();
  u16* sm = (u16*)smem;
  unsigned* xb_words = (unsigned*)(smem + SMEM_BYTES);
  if (threadIdx.x < 4) xb_words[threadIdx.x] = 0u;
  __syncthreads();
  const XcdBarrier xb = xcd_barrier_post((unsigned*)(p.ws + OFF_BAR), (volatile LAS unsigned*)xb_words);
  phase0(p, smem);
  grid.sync();
  u16* H = (u16*)(p.ws + OFF_H);
  u16* P = (u16*)(p.ws + OFF_P);
  int* ctr = (int*)(p.ws + OFF_CTR);
  for (int chunk = 0; chunk < NCHUNK; ++chunk) {
    for (int l = 0; l < 2; ++l) {
      const bool last = (l == 1);
      const u16* W = (const u16*)(p.ws + OFF_W) + (size_t)l * W_TOTAL;
      const float* mod = (const float*)(p.ws + OFF_MOD) + (size_t)l * 17 * 6144;
      phase_norm(p, chunk, l, 0, false);
      xcd_barrier(xb);
      for (int rep = 0; rep <= PR_GEMM1; ++rep) {
        gemm_phase<8, 4, true>(H, 1024, W + W_IN, 1024, NP, false, EpiStore{P, NP}, smem);
        xcd_barrier(xb);
      }
      phase_prep(p, l, sm);
      xcd_barrier(xb);
      gemm_phase<4, 4, true>(P + PB_CQ, NP, W + W_QUP, 384, 768, false, EpiStore{(u16*)(p.ws + OFF_QB), 768}, smem);
      gemm_phase<4, 4, false>(P + PB_CKV, NP, W + W_KVUP, 256, 1024, false, EpiKV{(u16*)(p.ws + OFF_KB), (u16*)(p.ws + OFF_VTB)}, smem);
      gemm_phase<4, 4, true>((const u16*)(p.ws + OFF_GL), 128, W + W_GATE, 128, 512, false, EpiStore{(u16*)(p.ws + OFF_G), 512}, smem);
      xcd_barrier(xb);
      if (PR_KIND >= 0) {
        phase_probe(p, l, PR_KIND, smem);
        xcd_barrier(xb);
      }
#ifdef PR_MIX
      if (chunk == 0) { phase_mixers(p, chunk, l, !last, ctr + 8 + l, smem, (u16*)(p.out + (size_t)BC * 2048 * 1024), PR_MIX); xcd_barrier(xb); }
#endif
      phase_mixers(p, chunk, l, !last, ctr + chunk * 2 + l, smem, nullptr, 31);
      xcd_barrier(xb);
      phase_cout(p, l, last);
      xcd_barrier(xb);
      for (int rep = 0; rep <= PR_MERGE; ++rep) {
        phase_merge(p, l, last, smem);
        xcd_barrier(xb);
      }
      if (last) gemm_phase<8, 4, true>((const u16*)(p.ws + OFF_YM), 1024, W + W_OUT, 1024, 1024, true, EpiResid{p, chunk, mod, 2048, false}, smem);
      else gemm_phase<4, 4, true>((const u16*)(p.ws + OFF_YM), 1024, W + W_OUT, 1024, 1024, false, EpiResid{p, chunk, mod, 2048, true}, smem);
      xcd_barrier(xb);
      phase_norm(p, chunk, l, 1, last);
      xcd_barrier(xb);
      gemm_phase<8, 4, true>(H, 1024, W + W_1, 1024, 4096, last, EpiRelu2{P}, smem);
      xcd_barrier(xb);
      if (last) gemm_phase<8, 4, true>(P, 4096, W + W_2, 4096, 1024, true, EpiResid{p, chunk, mod, 5120, false}, smem);
      else gemm_phase<4, 4, true>(P, 4096, W + W_2, 4096, 1024, false, EpiResid{p, chunk, mod, 5120, false}, smem);
      xcd_barrier(xb);
    }
    phase_final(p, chunk);
    xcd_barrier(xb);
  }
}

extern "C" void kernel_launch(void* const* d_in, const int* in_sizes, int n_in, void* d_out, int out_size, void* d_ws,
                              size_t ws_size, hipStream_t stream) {
  static int grid_blocks = 0;
  if (!grid_blocks) {
    int dev = 0, cus = 0, per_cu = 0;
    hipGetDevice(&dev);
    hipDeviceGetAttribute(&cus, hipDeviceAttributeMultiprocessorCount, dev);
    hipFuncSetAttribute((const void*)fwd_megakernel, hipFuncAttributeMaxDynamicSharedMemorySize, SMEM_DYN);
    hipOccupancyMaxActiveBlocksPerMultiprocessor(&per_cu, fwd_megakernel, 256, SMEM_DYN);
    if (per_cu > 2) per_cu = 2;
    if (per_cu < 1) per_cu = 1;
    grid_blocks = cus * per_cu;
  }
  if (ws_size < OFF_END) fprintf(stderr, "workspace too small: %zu < %zu\n", ws_size, (size_t)OFF_END);
  Params p{};
  for (int i = 0; i < 32; ++i) p.in[i] = (const float*)d_in[i];
  p.out = (float*)d_out;
  p.ws = (unsigned char*)d_ws;
  hipMemsetAsync(d_ws, 0, 1048576, stream);
  void* args[] = {&p};
  hipError_t e = hipLaunchCooperativeKernel((void*)fwd_megakernel, dim3(grid_blocks), dim3(256), args, SMEM_DYN, stream);
  if (e != hipSuccess) fprintf(stderr, "cooperative launch failed: %s (grid %d)\n", hipGetErrorString(e), grid_blocks);
}
```

```cpp
#include <hip/hip_runtime.h>
#include <hip/hip_cooperative_groups.h>
#include <stdint.h>
#include <cstdio>
namespace cg = cooperative_groups;

typedef unsigned short u16;
typedef __attribute__((ext_vector_type(8))) short bf16x8;
typedef __attribute__((ext_vector_type(4))) float f32x4;
typedef __attribute__((ext_vector_type(2))) float v2f;
#define DI __device__ __forceinline__

#ifndef PR_ABL
#define PR_ABL 0
#endif
constexpr int SMEM_BYTES = 73728;
constexpr int SMEM_DYN = SMEM_BYTES + 64;
constexpr int DM = 1024, TL = 2304;
constexpr int BC = 8, NCHUNK = 2, TC = BC * TL;
constexpr int NP = 4992;
constexpr int PA_Q = 0, PA_K = 512, PA_V = 640, PB_CQ = 768, PB_CKV = 1152, PB_KR = 1408;
constexpr int PC_R = 1440, PC_K = 1952, PC_V = 2464, PC_WLO = 2976, PC_ALO = 3104, PC_GLO = 3232;
constexpr int PD_Q = 3360, PD_K = 3872, PD_V = 4384;
constexpr int O_A = 0, O_B = 768, O_C = 1440, O_D = 3360;

constexpr int W_IN = 0, W_G = 5111808, W_QUP = 9306112, W_KVUP = 9601024, W_GATE = 9863168, W_DEC = 9928704,
              W_AAA = 9994240, W_BR = 10059776, W_OUT = 12156928, W_1 = 13205504, W_2 = 17399808, W_TOTAL = 21594112;

constexpr size_t OFF_MOD = 0;
constexpr size_t OFF_CTR = 835584;
constexpr size_t OFF_BAR = 851968;
constexpr size_t OFF_ROPE = 1048576;
constexpr size_t OFF_W = 2097152;
constexpr size_t OFF_H = OFF_W + (size_t)2 * W_TOTAL * 2;
constexpr size_t OFF_P = OFF_H + (size_t)TC * 1024 * 2;
constexpr size_t OFF_KA = OFF_P + (size_t)TC * NP * 2;
constexpr size_t OFF_VTA = OFF_KA + (size_t)BC * 2 * TL * 64 * 2;
constexpr size_t OFF_QB = OFF_VTA + (size_t)BC * 2 * TL * 64 * 2;
constexpr size_t OFF_KB = OFF_QB + (size_t)TC * 768 * 2;
constexpr size_t OFF_VTB = OFF_KB + (size_t)TC * 768 * 2;
constexpr size_t OFF_VTD = OFF_VTB + (size_t)TC * 512 * 2;
constexpr size_t OFF_GL = OFF_VTD + (size_t)TC * 512 * 2;
constexpr size_t OFF_G = OFF_GL + (size_t)TC * 128 * 2;
constexpr size_t OFF_YF = OFF_G + (size_t)TC * 512 * 2;
constexpr size_t OFF_YB = OFF_YF + (size_t)TC * 512 * 2;
constexpr size_t OFF_BON = OFF_YB + (size_t)TC * 512 * 2;
constexpr size_t OFF_XC = OFF_BON + (size_t)TC * 16 * 4;
constexpr size_t OFF_END = OFF_XC + (size_t)BC * 256 * 1024 * 4;
constexpr size_t OFF_YM = OFF_QB;

struct Params {
  const float* in[32];
  float* out;
  unsigned char* ws;
};

DI u16 f2bf(float f) { uint32_t u = __float_as_uint(f); u += 0x7fffu + ((u >> 16) & 1u); return (u16)(u >> 16); }
DI float bf2f(u16 h) { return __uint_as_float(((uint32_t)h) << 16); }
typedef __bf16 bf2_t __attribute__((ext_vector_type(2)));
DI uint32_t pack2(float a, float b) { v2f v = {a, b}; bf2_t r = __builtin_convertvector(v, bf2_t); return __builtin_bit_cast(uint32_t, r); }
DI float lo2f(uint32_t u) { return __uint_as_float(u << 16); }
DI float hi2f(uint32_t u) { return __uint_as_float(u & 0xffff0000u); }
DI float dpp_f(float v, const int ctrl_is_unused) { return v; }
#define DPP_ADD(v, ctrl) ((v) + __int_as_float(__builtin_amdgcn_update_dpp(0, __float_as_int(v), (ctrl), 0xF, 0xF, true)))
DI float row8_sum(float v) {
  v = DPP_ADD(v, 0xB1); v = DPP_ADD(v, 0x4E); v = DPP_ADD(v, 0x141);
  return v;
}
DI float row16_sum(float v) {
  v = DPP_ADD(v, 0xB1); v = DPP_ADD(v, 0x4E); v = DPP_ADD(v, 0x141); v = DPP_ADD(v, 0x140);
  return v;
}
DI float xq_sum(float v) {
  auto r = __builtin_amdgcn_permlane16_swap(__float_as_uint(v), __float_as_uint(v), false, false);
  v = __uint_as_float(r[0]) + __uint_as_float(r[1]);
  auto r2 = __builtin_amdgcn_permlane32_swap(__float_as_uint(v), __float_as_uint(v), false, false);
  return __uint_as_float(r2[0]) + __uint_as_float(r2[1]);
}
DI float xq_max(float v) {
  auto r = __builtin_amdgcn_permlane16_swap(__float_as_uint(v), __float_as_uint(v), false, false);
  v = fmaxf(__uint_as_float(r[0]), __uint_as_float(r[1]));
  auto r2 = __builtin_amdgcn_permlane32_swap(__float_as_uint(v), __float_as_uint(v), false, false);
  return fmaxf(__uint_as_float(r2[0]), __uint_as_float(r2[1]));
}
DI float wave_sum(float v) { return xq_sum(row16_sum(v)); }
DI float quad_sum(float v) {
  v += __int_as_float(__builtin_amdgcn_update_dpp(0, __float_as_int(v), 0xB1, 0xF, 0xF, true));
  v += __int_as_float(__builtin_amdgcn_update_dpp(0, __float_as_int(v), 0x4E, 0xF, 0xF, true));
  return v;
}
DI int otid() { int t = threadIdx.x; asm volatile("" : "+v"(t)); return t; }
DI float sigmoidf_(float x) { return 1.f / (1.f + __expf(-x)); }

DI float* x1_row(const Params& p, int chunk, int row) {
  int bl = row / TL, j = row - bl * TL;
  if (j < 256) return (float*)(p.ws + OFF_XC) + ((size_t)(bl * 256 + j)) * DM;
  return p.out + ((size_t)((chunk * BC + bl) * 2048 + (j - 256))) * DM;
}
DI const float* xin_row(const Params& p, int chunk, int row) {
  int bl = row / TL, j = row - bl * TL;
  int b = chunk * BC + bl;
  if (j < 256) return p.in[2] + ((size_t)(b * 256 + j)) * DM;
  return p.in[0] + ((size_t)(b * 2048 + (j - 256))) * DM;
}
DI int mod_row(int chunk, int row) {
  int bl = row / TL, j = row - bl * TL;
  return (j < 256) ? 16 : (chunk * BC + bl);
}

__constant__ int CONVTAB[16][8] = {
  {8, 1024 * 8992, 0, 1024, 8992, 0, 4896, W_IN},
  {8, 1024 * 8992, 0, 1024, 8992, 4896, 4096, W_G},
  {13, 384 * 768, 0, 384, 768, 0, 768, W_QUP},
  {14, 256 * 1024, 0, 256, 1024, 0, 1024, W_KVUP},
  {20, 128 * 512, 0, 128, 512, 0, 512, W_GATE},
  {17, 2 * 64 * 512, 0, 64, 512, 0, 512, W_DEC},
  {17, 2 * 64 * 512, 64 * 512, 64, 512, 0, 512, W_DEC + 512 * 64},
  {19, 2 * 64 * 512, 0, 64, 512, 0, 512, W_AAA},
  {19, 2 * 64 * 512, 64 * 512, 64, 512, 0, 512, W_AAA + 512 * 64},
  {27, 4 * 512 * 1024, 0, 512, 1024, 0, 1024, W_BR},
  {27, 4 * 512 * 1024, 512 * 1024, 512, 1024, 0, 1024, W_BR + 1024 * 512},
  {27, 4 * 512 * 1024, 2 * 512 * 1024, 512, 1024, 0, 1024, W_BR + 2 * 1024 * 512},
  {27, 4 * 512 * 1024, 3 * 512 * 1024, 512, 1024, 0, 1024, W_BR + 3 * 1024 * 512},
  {28, 1024 * 1024, 0, 1024, 1024, 0, 1024, W_OUT},
  {29, 1024 * 4096, 0, 1024, 4096, 0, 4096, W_1},
  {30, 4096 * 1024, 0, 4096, 1024, 0, 1024, W_2},
};
constexpr int CONV_TILES_PER_LAYER = 1232 + 1024 + 72 + 64 + 16 + 8 + 8 + 8 + 8 + 128 * 4 + 256 + 1024 + 1024;

__device__ void conv_tile(const float* __restrict__ src, int ld, int k0, int n0, int ncols, u16* __restrict__ dst, int K,
                          float* tile, const int tid) {
  {
    const int c4 = (tid & 15) * 4;
#pragma unroll
    for (int i = 0; i < 4; ++i) {
      int r = (tid >> 4) + 16 * i;
      float4 v = make_float4(0.f, 0.f, 0.f, 0.f);
      if (n0 + c4 < ncols) v = *(const float4*)(src + (size_t)(k0 + r) * ld + n0 + c4);
      tile[r * 65 + c4 + 0] = v.x; tile[r * 65 + c4 + 1] = v.y; tile[r * 65 + c4 + 2] = v.z; tile[r * 65 + c4 + 3] = v.w;
    }
  }
  __syncthreads();
  {
    const int n = tid >> 2, kc = (tid & 3) * 16;
    if (n0 + n < ncols) {
      uint32_t w[8];
#pragma unroll
      for (int i = 0; i < 8; ++i) w[i] = pack2(tile[(kc + 2 * i) * 65 + n], tile[(kc + 2 * i + 1) * 65 + n]);
      uint4* d = (uint4*)(dst + (size_t)(n0 + n) * K + k0 + kc);
      d[0] = make_uint4(w[0], w[1], w[2], w[3]);
      d[1] = make_uint4(w[4], w[5], w[6], w[7]);
    }
  }
  __syncthreads();
}

__device__ void phase0(const Params& p, unsigned char* smem) {
  float* fsm = (float*)smem;
  const int tid = otid();
  const int n_conv = 2 * CONV_TILES_PER_LAYER;
  const int n_pad = 2 * 48;
  const int n_ada = 2 * 16 * 24;
  const int total = n_conv + n_pad + n_ada + 1;
  u16* wbase = (u16*)(p.ws + OFF_W);
  for (int it = blockIdx.x; it < total; it += gridDim.x) {
    if (it < n_conv) {
      int l = it / CONV_TILES_PER_LAYER, r = it - l * CONV_TILES_PER_LAYER;
      int job = 0;
      for (; job < 16; ++job) {
        int nt = (CONVTAB[job][3] >> 6) * ((CONVTAB[job][6] + 63) >> 6);
        if (r < nt) break;
        r -= nt;
      }
      const int K = CONVTAB[job][3], ld = CONVTAB[job][4], col0 = CONVTAB[job][5], ncols = CONVTAB[job][6];
      const int nkt = K >> 6;
      const int kt = r % nkt, ntile = r / nkt;
      const float* src = p.in[CONVTAB[job][0]] + (size_t)l * CONVTAB[job][1] + CONVTAB[job][2] + col0;
      u16* dst = wbase + (size_t)l * W_TOTAL + CONVTAB[job][7];
      conv_tile(src, ld, kt * 64, ntile * 64, ncols, dst, K, fsm, tid);
    } else if (it < n_conv + n_pad) {
      int r = it - n_conv;
      int l = r / 48, q = r - l * 48;
      u16* dst = wbase + (size_t)l * W_TOTAL + W_IN + (size_t)(4896 + q * 2) * 1024;
      *(uint4*)(dst + tid * 8) = make_uint4(0, 0, 0, 0);
    } else if (it < n_conv + n_pad + n_ada) {
      int r = it - n_conv - n_pad;
      int l = r / 384; r -= l * 384;
      int kc = r / 24, nb = r - kc * 24;
      for (int idx = tid; idx < 17 * 64; idx += 256) {
        int rr = idx >> 6, k = idx & 63;
        float cv = (rr < 16) ? p.in[1][rr * 1024 + kc * 64 + k] : p.in[3][kc * 64 + k];
        fsm[idx] = cv / (1.f + expf(-cv));
      }
      __syncthreads();
      const int n = nb * 256 + tid;
      float acc[17];
#pragma unroll
      for (int i = 0; i < 17; ++i) acc[i] = 0.f;
      const float* wp = p.in[4] + ((size_t)l * 1024 + kc * 64) * 6144 + n;
#pragma unroll 4
      for (int k = 0; k < 64; ++k) {
        float w = wp[(size_t)k * 6144];
#pragma unroll
        for (int i = 0; i < 17; ++i) acc[i] += fsm[i * 64 + k] * w;
      }
      float bias = (kc == 0) ? p.in[5][l * 6144 + n] : 0.f;
      float* mod = (float*)(p.ws + OFF_MOD);
#pragma unroll
      for (int i = 0; i < 17; ++i) atomicAdd(&mod[(size_t)(l * 17 + i) * 6144 + n], acc[i] + bias);
      __syncthreads();
    } else {
      float* ra = (float*)(p.ws + OFF_ROPE);
      float* rb = ra + 64 * 16 * 2;
      for (int idx = tid; idx < 64 * 16; idx += 256) {
        int pos = idx >> 4, i = idx & 15;
        float inv = powf(10000.f, -(float)i / 16.f);
        float ang = (float)pos * inv;
        ra[idx * 2] = cosf(ang); ra[idx * 2 + 1] = sinf(ang);
      }
      for (int idx = tid; idx < 64 * 8; idx += 256) {
        int pos = idx >> 3, i = idx & 7;
        float inv = powf(10000.f, -(float)i / 8.f);
        float ang = (float)pos * inv;
        rb[idx * 2] = cosf(ang); rb[idx * 2 + 1] = sinf(ang);
      }
    }
  }
}

__device__ void phase_norm(const Params& p, int chunk, int l, int which, bool latonly) {
  const int tid = otid();
  const int lane = tid & 63, wave = tid >> 6;
  const float* g = p.in[which == 0 ? 6 : 7] + l * 1024;
  const float* mod = (const float*)(p.ws + OFF_MOD) + (size_t)l * 17 * 6144;
  u16* H = (u16*)(p.ws + OFF_H);
  for (int row = blockIdx.x * 4 + wave; row < TC; row += gridDim.x * 4) {
    int j = row % TL;
    if (latonly && j < 256) continue;
    const float* src = (which == 0 && l == 0) ? xin_row(p, chunk, row) : (const float*)x1_row(p, chunk, row);
    const float* mr = mod + (size_t)mod_row(chunk, row) * 6144 + which * 3072;
    float4 v[4];
    float ss = 0.f;
#pragma unroll
    for (int i = 0; i < 4; ++i) {
      v[i] = *(const float4*)(src + i * 256 + lane * 4);
      ss += v[i].x * v[i].x + v[i].y * v[i].y + v[i].z * v[i].z + v[i].w * v[i].w;
    }
    ss = wave_sum(ss);
    float rs = rsqrtf(ss * (1.f / 1024.f) + 1e-6f);
#pragma unroll
    for (int i = 0; i < 4; ++i) {
      int c = i * 256 + lane * 4;
      float4 gg = *(const float4*)(g + c);
      float4 sh = *(const float4*)(mr + c);
      float4 sc = *(const float4*)(mr + 1024 + c);
      float a0 = v[i].x * rs * gg.x * (1.f + sc.x) + sh.x;
      float a1 = v[i].y * rs * gg.y * (1.f + sc.y) + sh.y;
      float a2 = v[i].z * rs * gg.z * (1.f + sc.z) + sh.z;
      float a3 = v[i].w * rs * gg.w * (1.f + sc.w) + sh.w;
      *(uint2*)(H + (size_t)row * 1024 + c) = make_uint2(pack2(a0, a1), pack2(a2, a3));
    }
  }
}

__device__ void phase_final(const Params& p, int chunk) {
  const int tid = otid();
  const int lane = tid & 63, wave = tid >> 6;
  const float* g = p.in[31];
  for (int r = blockIdx.x * 4 + wave; r < BC * 2048; r += gridDim.x * 4) {
    float* px = p.out + ((size_t)chunk * BC * 2048 + r) * DM;
    float4 v[4];
    float ss = 0.f;
#pragma unroll
    for (int i = 0; i < 4; ++i) {
      v[i] = *(const float4*)(px + i * 256 + lane * 4);
      ss += v[i].x * v[i].x + v[i].y * v[i].y + v[i].z * v[i].z + v[i].w * v[i].w;
    }
    ss = wave_sum(ss);
    float rs = rsqrtf(ss * (1.f / 1024.f) + 1e-6f);
#pragma unroll
    for (int i = 0; i < 4; ++i) {
      int c = i * 256 + lane * 4;
      float4 gg = *(const float4*)(g + c);
      *(float4*)(px + c) = make_float4(v[i].x * rs * gg.x, v[i].y * rs * gg.y, v[i].z * rs * gg.z, v[i].w * rs * gg.w);
    }
  }
}

#define GEMM_WAIT_VM(n) asm volatile("s_waitcnt vmcnt(" #n ")" ::: "memory")
DI void raw_barrier() { asm volatile("s_waitcnt lgkmcnt(0)" ::: "memory"); __builtin_amdgcn_s_barrier(); }
template <int MI, int NI, bool TR>
DI void gemm_dma(const u16* __restrict__ A, int lda, const u16* __restrict__ Bt, int ldb, int K, f32x4 (&acc)[MI][NI],
                 unsigned char* smem, const int tid) {
  constexpr int BM = 32 * MI, BN = 32 * NI;
  constexpr int SB = (BM + BN) * 64;
  constexpr int NS = (73728 / SB) >= 4 ? 4 : 3;
  constexpr int LA = BM / 64, LB = BN / 64, LPT = LA + LB;
  static_assert(LPT == 3 || LPT == 4 || LPT == 6, "unexpected tile");
  const int lane = tid & 63, wave = tid >> 6, l15 = lane & 15, quad = lane >> 4;
  const int wm = wave >> 1, wn = wave & 1;
  const int drow = tid >> 2;
  const int g4 = (0x1230 >> (((drow >> 2) & 3) * 4)) & 3;
  const int dc = (tid & 3) ^ g4;
  const u16* Asrc = A + (size_t)drow * lda + dc * 8;
  const u16* Bsrc = Bt + (size_t)drow * ldb + dc * 8;
  unsigned char* dstw = smem + __builtin_amdgcn_readfirstlane(tid >> 6) * 1024;
  auto issue = [&](int kt, int buf) {
    const int ko = kt * 32;
#pragma unroll
    for (int j = 0; j < LA; ++j)
      __builtin_amdgcn_global_load_lds((const unsigned*)(Asrc + (size_t)(j * 64) * lda + ko), (unsigned*)(dstw + buf * SB + j * 4096), 16, 0, 0);
#pragma unroll
    for (int j = 0; j < LB; ++j)
      __builtin_amdgcn_global_load_lds((const unsigned*)(Bsrc + (size_t)(j * 64) * ldb + ko), (unsigned*)(dstw + buf * SB + (LA + j) * 4096), 16, 0, 0);
  };
  const int rg4 = (0x1230 >> ((l15 >> 2) * 4)) & 3;
  const int aoff = (wm * 16 * MI + l15) * 64 + ((quad ^ rg4) * 16);
  const int boff = BM * 64 + (wn * 16 * NI + l15) * 64 + ((quad ^ rg4) * 16);
  const int nk = K >> 5;
  GEMM_WAIT_VM(0);
#pragma unroll
  for (int s_ = 0; s_ < NS - 1; ++s_)
    if (s_ < nk) issue(s_, s_);
  int buf = 0;
  for (int kt = 0; kt < nk; ++kt) {
    const int rem = nk - 1 - kt;
    if (NS == 4) {
      if (rem >= 2) { if (LPT == 3) GEMM_WAIT_VM(6); else if (LPT == 4) GEMM_WAIT_VM(8); else GEMM_WAIT_VM(12); }
      else if (rem == 1) { if (LPT == 3) GEMM_WAIT_VM(3); else if (LPT == 4) GEMM_WAIT_VM(4); else GEMM_WAIT_VM(6); }
      else GEMM_WAIT_VM(0);
    } else {
      if (rem >= 1) { if (LPT == 3) GEMM_WAIT_VM(3); else if (LPT == 4) GEMM_WAIT_VM(4); else GEMM_WAIT_VM(6); }
      else GEMM_WAIT_VM(0);
    }
    raw_barrier();
    const unsigned char* st = smem + buf * SB;
    bf16x8 af[MI], bfr[NI];
#pragma unroll
    for (int mi = 0; mi < MI; ++mi) af[mi] = *(const bf16x8*)(st + aoff + mi * 1024);
#pragma unroll
    for (int ni = 0; ni < NI; ++ni) bfr[ni] = *(const bf16x8*)(st + boff + ni * 1024);
    __builtin_amdgcn_sched_barrier(0);
    if (kt + NS - 1 < nk) { int nb = buf + NS - 1; if (nb >= NS) nb -= NS; issue(kt + NS - 1, nb); }
    __builtin_amdgcn_sched_barrier(0);
    __builtin_amdgcn_s_setprio(1);
#pragma unroll
    for (int mi = 0; mi < MI; ++mi)
#pragma unroll
      for (int ni = 0; ni < NI; ++ni)
        acc[mi][ni] = TR ? __builtin_amdgcn_mfma_f32_16x16x32_bf16(bfr[ni], af[mi], acc[mi][ni], 0, 0, 0)
                         : __builtin_amdgcn_mfma_f32_16x16x32_bf16(af[mi], bfr[ni], acc[mi][ni], 0, 0, 0);
    __builtin_amdgcn_s_setprio(0);
    if (++buf == NS) buf = 0;
  }
  raw_barrier();
}

DI bool tile_map(int t, int nMg, int nNt, bool latonly, int MT, int& mt, int& nt) {
  int x = t & 7, rest = t >> 3;
  int ni = rest & 7, q = rest >> 3;
  int mg = q % nMg, ng = q / nMg;
  nt = ng * 8 + ni;
  if (nt >= nNt) return false;
  int mti = mg * 8 + x;
  if (MT == 128) mt = latonly ? ((mti >> 4) * 18 + 2 + (mti & 15)) : mti;
  else mt = latonly ? ((mti >> 3) * 9 + 1 + (mti & 7)) : mti;
  return true;
}

template <int MI, int NI, bool TR, class Epi>
__device__ void gemm_phase(const u16* A, int lda, const u16* Bt, int K, int N, bool latonly, Epi epi, unsigned char* smem) {
  constexpr int BM = 32 * MI, BN = 32 * NI;
  const int nMg = (BM == 128) ? (latonly ? 16 : 18) : (latonly ? 8 : 9);
  const int nNt = N / BN;
  const int total = 64 * nMg * ((nNt + 7) >> 3);
  const int tid = otid();
  const int lane = tid & 63, wave = tid >> 6, l15 = lane & 15, quad = lane >> 4;
  const int wm = wave >> 1, wn = wave & 1;
  for (int t = blockIdx.x; t < total; t += gridDim.x) {
    int mt, nt;
    if (!tile_map(t, nMg, nNt, latonly, BM, mt, nt)) continue;
    const int m0 = mt * BM, n0 = nt * BN;
    f32x4 acc[MI][NI];
#pragma unroll
    for (int mi = 0; mi < MI; ++mi)
#pragma unroll
      for (int ni = 0; ni < NI; ++ni) acc[mi][ni] = (f32x4){0.f, 0.f, 0.f, 0.f};
    gemm_dma<MI, NI, TR>(A + (size_t)m0 * lda, lda, Bt + (size_t)n0 * K, K, K, acc, smem, tid);
    if constexpr (Epi::BATCH) {
#pragma unroll
      for (int mi = 0; mi < MI; ++mi) epi.template row<NI>(m0 + wm * 16 * MI + mi * 16 + l15, n0 + wn * 16 * NI + quad * 4, acc[mi]);
    } else {
#pragma unroll
      for (int mi = 0; mi < MI; ++mi)
#pragma unroll
        for (int ni = 0; ni < NI; ++ni) {
          if (TR) epi(m0 + wm * 16 * MI + mi * 16 + l15, n0 + wn * 16 * NI + ni * 16 + quad * 4, acc[mi][ni]);
          else epi(m0 + wm * 16 * MI + mi * 16 + quad * 4, n0 + wn * 16 * NI + ni * 16 + l15, acc[mi][ni]);
        }
    }
  }
}

struct EpiStore {
  u16* C; int ldc;
  static constexpr bool BATCH = false;
  DI void operator()(int r, int c0, f32x4 v) const {
    *(uint2*)(C + (size_t)r * ldc + c0) = make_uint2(pack2(v[0], v[1]), pack2(v[2], v[3]));
  }
};
struct EpiKV {
  u16* KB; u16* VtB;
  static constexpr bool BATCH = false;
  DI void operator()(int r0, int c, f32x4 v) const {
    int bl = r0 / TL, j0 = r0 - bl * TL;
    int head = c >> 7, w = c & 127;
    if (w < 64) {
#pragma unroll
      for (int j = 0; j < 4; ++j) KB[((size_t)(bl * 8 + head) * TL + j0 + j) * 96 + w] = f2bf(v[j]);
    } else {
      *(uint2*)(VtB + ((size_t)(bl * 8 + head) * 64 + (w - 64)) * TL + j0) = make_uint2(pack2(v[0], v[1]), pack2(v[2], v[3]));
    }
  }
};
struct EpiRelu2 {
  u16* C;
  static constexpr bool BATCH = false;
  DI void operator()(int r, int c0, f32x4 v) const {
    float t0 = fmaxf(v[0], 0.f), t1 = fmaxf(v[1], 0.f), t2 = fmaxf(v[2], 0.f), t3 = fmaxf(v[3], 0.f);
    *(uint2*)(C + (size_t)r * 4096 + c0) = make_uint2(pack2(t0 * t0, t1 * t1), pack2(t2 * t2, t3 * t3));
  }
};
struct EpiResid {
  Params p; int chunk; const float* mod; int gofs; bool from_input;
  static constexpr bool BATCH = true;
  template <int NI>
  DI void row(int r, int c0, const f32x4 (&v)[NI]) const {
    const float* gtp = mod + (size_t)mod_row(chunk, r) * 6144 + gofs + c0;
    float* dst = x1_row(p, chunk, r) + c0;
    const float* src = from_input ? (xin_row(p, chunk, r) + c0) : (const float*)dst;
    float4 gt[NI], xin[NI];
#pragma unroll
    for (int ni = 0; ni < NI; ++ni) { gt[ni] = *(const float4*)(gtp + ni * 16); xin[ni] = *(const float4*)(src + ni * 16); }
#pragma unroll
    for (int ni = 0; ni < NI; ++ni)
      *(float4*)(dst + ni * 16) = make_float4(xin[ni].x + gt[ni].x * v[ni][0], xin[ni].y + gt[ni].y * v[ni][1],
                                              xin[ni].z + gt[ni].z * v[ni][2], xin[ni].w + gt[ni].w * v[ni][3]);
  }
};

__device__ void phase_merge(const Params& p, int l, bool latonly, unsigned char* smem) {
  const u16* H = (const u16*)(p.ws + OFF_H);
  const u16* P = (const u16*)(p.ws + OFF_P);
  const u16* W = (const u16*)(p.ws + OFF_W) + (size_t)l * W_TOTAL;
  u16* YM = (u16*)(p.ws + OFF_YM);
  const int nMg = latonly ? 16 : 18;
  const int nNt = 8;
  const int total = 64 * nMg;
  const int tid = otid();
  const int lane = tid & 63, wave = tid >> 6, l15 = lane & 15, quad = lane >> 4;
  const int wm = wave >> 1, wn = wave & 1;
  for (int t = blockIdx.x; t < total; t += gridDim.x) {
    int mt, nt;
    if (!tile_map(t, nMg, nNt, latonly, 128, mt, nt)) continue;
    const int m0 = mt * 128, n0 = nt * 128;
    uint2 yp[4][4];
#pragma unroll
    for (int mi = 0; mi < 4; ++mi)
#pragma unroll
      for (int ni = 0; ni < 4; ++ni) yp[mi][ni] = make_uint2(0u, 0u);
    for (int i = 0; i < 4; ++i) {
      const int ocol = (i == 0) ? O_A : (i == 1) ? O_B : (i == 2) ? O_C : O_D;
      uint2 gp[4][4];
      {
        f32x4 g[4][4];
#pragma unroll
        for (int mi = 0; mi < 4; ++mi)
#pragma unroll
          for (int ni = 0; ni < 4; ++ni) g[mi][ni] = (f32x4){0.f, 0.f, 0.f, 0.f};
        gemm_dma<4, 4, true>(H + (size_t)m0 * 1024, 1024, W + W_G + (size_t)(i * 1024 + n0) * 1024, 1024, 1024, g, smem, tid);
#pragma unroll
        for (int mi = 0; mi < 4; ++mi)
#pragma unroll
          for (int ni = 0; ni < 4; ++ni)
            gp[mi][ni] = make_uint2(pack2(sigmoidf_(g[mi][ni][0]), sigmoidf_(g[mi][ni][1])), pack2(sigmoidf_(g[mi][ni][2]), sigmoidf_(g[mi][ni][3])));
      }
      f32x4 b[4][4];
#pragma unroll
      for (int mi = 0; mi < 4; ++mi)
#pragma unroll
        for (int ni = 0; ni < 4; ++ni) b[mi][ni] = (f32x4){0.f, 0.f, 0.f, 0.f};
      gemm_dma<4, 4, true>(P + (size_t)m0 * NP + ocol, NP, W + W_BR + (size_t)(i * 1024 + n0) * 512, 512, 512, b, smem, tid);
#pragma unroll
      for (int mi = 0; mi < 4; ++mi)
#pragma unroll
        for (int ni = 0; ni < 4; ++ni) {
          const float y0 = lo2f(yp[mi][ni].x) + lo2f(gp[mi][ni].x) * b[mi][ni][0];
          const float y1 = hi2f(yp[mi][ni].x) + hi2f(gp[mi][ni].x) * b[mi][ni][1];
          const float y2 = lo2f(yp[mi][ni].y) + lo2f(gp[mi][ni].y) * b[mi][ni][2];
          const float y3 = hi2f(yp[mi][ni].y) + hi2f(gp[mi][ni].y) * b[mi][ni][3];
          yp[mi][ni] = make_uint2(pack2(y0, y1), pack2(y2, y3));
        }
    }
#pragma unroll
    for (int mi = 0; mi < 4; ++mi)
#pragma unroll
      for (int ni = 0; ni < 4; ++ni)
        *(uint2*)(YM + (size_t)(m0 + wm * 64 + mi * 16 + l15) * 1024 + n0 + wn * 64 + ni * 16 + quad * 4) = yp[mi][ni];
  }
}

__device__ void transpose64(const u16* __restrict__ src, int lds_, u16* __restrict__ dst, int ldd, u16* tile, const int tid) {
  {
    const int r = tid >> 2, c = (tid & 3) * 16;
    uint4 a = *(const uint4*)(src + (size_t)r * lds_ + c);
    uint4 b = *(const uint4*)(src + (size_t)r * lds_ + c + 8);
    uint32_t* t32 = (uint32_t*)(tile + r * 66 + c);
    t32[0] = a.x; t32[1] = a.y; t32[2] = a.z; t32[3] = a.w; t32[4] = b.x; t32[5] = b.y; t32[6] = b.z; t32[7] = b.w;
  }
  __syncthreads();
  {
    const int d = tid >> 2, tc = (tid & 3) * 16;
    uint32_t w[8];
#pragma unroll
    for (int i = 0; i < 8; ++i) w[i] = (uint32_t)tile[(tc + 2 * i) * 66 + d] | ((uint32_t)tile[(tc + 2 * i + 1) * 66 + d] << 16);
    uint4* o = (uint4*)(dst + (size_t)d * ldd + tc);
    o[0] = make_uint4(w[0], w[1], w[2], w[3]);
    o[1] = make_uint4(w[4], w[5], w[6], w[7]);
  }
  __syncthreads();
}

__device__ void phase_prep(const Params& p, int l, u16* sm) {
  const int tid = otid();
  const int lane = tid & 63, wave = tid >> 6;
  u16* P = (u16*)(p.ws + OFF_P);
  u16* KA = (u16*)(p.ws + OFF_KA);
  u16* VtA = (u16*)(p.ws + OFF_VTA);
  u16* KB = (u16*)(p.ws + OFF_KB);
  u16* VtD = (u16*)(p.ws + OFF_VTD);
  u16* GL = (u16*)(p.ws + OFF_GL);
  const float* ropeA = (const float*)(p.ws + OFF_ROPE);
  const float* ropeB = ropeA + 64 * 16 * 2;
  const float aqg = p.in[9][l * 64 + lane], akg = p.in[10][l * 64 + lane];
  const float* bqg = p.in[11] + l * 384;
  const float* bkvg = p.in[12] + l * 256;
  const float* mu = p.in[15] + l * 1920;
  for (int tok = blockIdx.x * 4 + wave; tok < TC; tok += gridDim.x * 4) {
    const int bl = tok / TL, j = tok - bl * TL;
    const bool islat = j >= 256;
    const int jj = j - 256;
    const int grow = (jj >> 6) & 31, gcol = jj & 63;
    u16* pr = P + (size_t)tok * NP;
    const bool hasp = islat ? (jj > 0) : (j > 0);
    const bool hasn = islat ? (jj < 2047) : (j < 255);
    u16 xa[10], xq[6], xkv[4], xkr, gcur[2], gprv[2], gnxt[2];
#pragma unroll
    for (int h = 0; h < 10; ++h) xa[h] = pr[h * 64 + lane];
#pragma unroll
    for (int i = 0; i < 6; ++i) xq[i] = pr[PB_CQ + lane + 64 * i];
#pragma unroll
    for (int i = 0; i < 4; ++i) xkv[i] = pr[PB_CKV + lane + 64 * i];
    xkr = pr[PB_KR + (lane & 31)];
#pragma unroll
    for (int i = 0; i < 2; ++i) {
      const int c = lane + 64 * i;
      gcur[i] = pr[PC_GLO + c];
      gprv[i] = hasp ? pr[PC_GLO + c - NP] : (u16)0;
      gnxt[i] = hasn ? pr[PC_GLO + c + NP] : (u16)0;
    }
    float ca = 1.f, sa = 0.f, cb = 1.f, sb = 0.f;
    if (islat) {
      const int pos = (lane < 32) ? grow : gcol;
      ca = ropeA[(pos * 16 + (lane & 15)) * 2];
      sa = ropeA[(pos * 16 + (lane & 15)) * 2 + 1];
      const int posb = ((lane & 31) < 16) ? grow : gcol;
      cb = ropeB[(posb * 8 + (lane & 7)) * 2];
      sb = ropeB[(posb * 8 + (lane & 7)) * 2 + 1];
    }
#pragma unroll
    for (int h = 0; h < 10; ++h) {
      const float x = bf2f(xa[h]);
      const float ss = wave_sum(x * x);
      const float y = x * rsqrtf(ss * (1.f / 64.f) + 1e-6f) * (h < 8 ? aqg : akg);
      const float yp = __shfl_xor(y, 16);
      const float o = ((lane & 16) == 0) ? (y * ca - yp * sa) : (yp * sa + y * ca);
      if (h < 8) pr[h * 64 + lane] = f2bf(o);
      else KA[((size_t)(bl * 2 + (h - 8)) * TL + j) * 64 + lane] = f2bf(o);
    }
    {
      float x[6], ss = 0.f;
#pragma unroll
      for (int i = 0; i < 6; ++i) { x[i] = bf2f(xq[i]); ss += x[i] * x[i]; }
      ss = wave_sum(ss);
      const float rs = rsqrtf(ss * (1.f / 384.f) + 1e-6f);
#pragma unroll
      for (int i = 0; i < 6; ++i) pr[PB_CQ + lane + 64 * i] = f2bf(x[i] * rs * bqg[lane + 64 * i]);
    }
    {
      float x[4], ss = 0.f;
#pragma unroll
      for (int i = 0; i < 4; ++i) { x[i] = bf2f(xkv[i]); ss += x[i] * x[i]; }
      ss = wave_sum(ss);
      const float rs = rsqrtf(ss * (1.f / 256.f) + 1e-6f);
#pragma unroll
      for (int i = 0; i < 4; ++i) pr[PB_CKV + lane + 64 * i] = f2bf(x[i] * rs * bkvg[lane + 64 * i]);
    }
    {
      const float x = bf2f(xkr);
      const float xp = __shfl_xor(x, 8);
      const float o = ((lane & 8) == 0) ? (x * cb - xp * sb) : (xp * sb + x * cb);
      if (lane < 32) {
        const u16 ob = f2bf(o);
#pragma unroll
        for (int h = 0; h < 8; ++h) KB[((size_t)(bl * 8 + h) * TL + j) * 96 + 64 + lane] = ob;
      }
    }
#pragma unroll
    for (int i = 0; i < 2; ++i) {
      const int c = lane + 64 * i;
      const float cur = bf2f(gcur[i]);
      const float z = cur + (0.5f * (bf2f(gprv[i]) + bf2f(gnxt[i])) - cur) * mu[1792 + c];
      GL[(size_t)tok * 128 + c] = f2bf(sigmoidf_(z));
    }
  }
  for (int it = blockIdx.x; it < (TC / 64) * 10; it += gridDim.x) {
    int tg = it / 10, hh = it - tg * 10;
    int tok0 = tg * 64, bl = tok0 / TL, j0 = tok0 - bl * TL;
    if (hh < 2) transpose64(P + (size_t)tok0 * NP + PA_V + hh * 64, NP, VtA + ((size_t)(bl * 2 + hh) * 64) * TL + j0, TL, sm, tid);
    else transpose64(P + (size_t)tok0 * NP + PD_V + (hh - 2) * 64, NP, VtD + ((size_t)(bl * 8 + hh - 2) * 64) * TL + j0, TL, sm, tid);
  }
}

template <int DQK, int NQ, int MODE>
__device__ void flash_item(const u16* __restrict__ Qp, int ldq, const u16* __restrict__ Kp, int ldk, const u16* __restrict__ Vtp,
                           int ntiles, u16* __restrict__ Op, int ldo, float scale, bool ropeq, int qtok0,
                           const float* __restrict__ ropeB, int nat_r, const float* __restrict__ bias_g, unsigned char* smem, const int tid, const int abl) {
  constexpr int KS = DQK / 32;
  constexpr int DCH = DQK / 8;
  constexpr int KB_ = 64 * DQK * 2;
  constexpr int SBF = KB_ + 8192;
  constexpr int NS = (DQK == 64) ? 4 : 3;
  constexpr int LK = (64 * DCH) / 256, LPT = LK + 2;
  float* sBias = (float*)(smem + NS * SBF);
  const int lane = tid & 63, wave = tid >> 6, l15 = lane & 15, quad = lane >> 4;
  const float L2E = 1.4426950408889634f;
  int r0 = 0;
  if (MODE == 1) {
    r0 = min(max(nat_r - 4, 0), 24);
    for (int i = tid; i < 15 * 31; i += 256) sBias[i] = bias_g[i];
  }
  bf16x8 qf[NQ][KS];
#pragma unroll
  for (int qi = 0; qi < NQ; ++qi) {
    const int row = wave * 16 * NQ + qi * 16 + l15;
#pragma unroll
    for (int ks = 0; ks < KS; ++ks) qf[qi][ks] = *(const bf16x8*)(Qp + (size_t)row * ldq + ks * 32 + quad * 8);
    if (DQK == 96 && ropeq) {
      bf16x8 own = qf[qi][KS - 1];
      bf16x8 par = *(const bf16x8*)(Qp + (size_t)row * ldq + 64 + (quad ^ 1) * 8);
      const int qt = qtok0 + row;
      const int pos = (quad < 2) ? ((qt >> 6) & 31) : (qt & 63);
      bf16x8 res;
#pragma unroll
      for (int i = 0; i < 8; ++i) {
        float c = ropeB[(pos * 8 + i) * 2], s = ropeB[(pos * 8 + i) * 2 + 1];
        float xo = bf2f((u16)own[i]), xp = bf2f((u16)par[i]);
        float o = ((quad & 1) == 0) ? (xo * c - xp * s) : (xp * s + xo * c);
        res[i] = (short)f2bf(o);
      }
      qf[qi][KS - 1] = res;
    }
  }
  auto koff = [&](int t) -> int { return (MODE == 1) ? ((t < 8) ? (256 + (r0 + t) * 64) : ((t - 8) * 64)) : t * 64; };
  unsigned char* dstw = smem + __builtin_amdgcn_readfirstlane(tid >> 6) * 1024;
  auto issue = [&](int t, int buf) {
    const int ko = koff(t);
#pragma unroll
    for (int i = 0; i < LK; ++i) {
      const int L = tid + 256 * i;
      int row, c;
      if (DQK == 64) { row = L >> 3; c = (L & 7) ^ (row & 7); }
      else { row = L / 12; const int pp = L - row * 12; c = (pp & ~3) | ((pp & 3) ^ ((0x1230 >> (((row >> 2) & 3) * 4)) & 3)); }
      __builtin_amdgcn_global_load_lds((const unsigned*)(Kp + (size_t)(ko + row) * ldk + c * 8), (unsigned*)(dstw + buf * SBF + i * 4096), 16, 0, 0);
    }
#pragma unroll
    for (int i = 0; i < 2; ++i) {
      const int L = tid + 256 * i;
      const int d = L >> 3, c = (L & 7) ^ (d & 7);
      __builtin_amdgcn_global_load_lds((const unsigned*)(Vtp + (size_t)d * TL + ko + c * 8), (unsigned*)(dstw + buf * SBF + KB_ + i * 4096), 16, 0, 0);
    }
  };
  int koffs[KS];
#pragma unroll
  for (int ks = 0; ks < KS; ++ks) {
    const int c = ks * 4 + quad;
    if (DQK == 64) koffs[ks] = l15 * 128 + ((c ^ (l15 & 7)) * 16);
    else koffs[ks] = l15 * 192 + (((c & ~3) | ((c & 3) ^ ((0x1230 >> ((l15 >> 2) * 4)) & 3))) * 16);
  }
  int voffs[2][2];
#pragma unroll
  for (int kk = 0; kk < 2; ++kk)
#pragma unroll
    for (int ab = 0; ab < 2; ++ab) {
      const int keyb = ((2 * kk + ab) * 16 + quad * 4) * 2;
      const int c = keyb >> 4;
      voffs[kk][ab] = l15 * 128 + ((c ^ (l15 & 7)) * 16) + (keyb & 15);
    }
  f32x4 o[4][NQ];
  float m[NQ], lsum[NQ];
#pragma unroll
  for (int qi = 0; qi < NQ; ++qi) {
    m[qi] = -INFINITY; lsum[qi] = 0.f;
#pragma unroll
    for (int dt = 0; dt < 4; ++dt) o[dt][qi] = (f32x4){0.f, 0.f, 0.f, 0.f};
  }
  const int qc = wave * 16 + l15;
  const int st = min(max(qc - 8, 0), 48);
  GEMM_WAIT_VM(0);
#pragma unroll
  for (int s_ = 0; s_ < NS - 1; ++s_)
    if (s_ < ntiles) issue(s_, s_);
  int buf = 0;
  for (int t = 0; t < ntiles; ++t) {
    if (!(abl & 4)) {
      const int rem = ntiles - 1 - t;
      if (NS == 4) {
        if (rem >= 2) GEMM_WAIT_VM(8); else if (rem == 1) GEMM_WAIT_VM(4); else GEMM_WAIT_VM(0);
      } else {
        if (rem >= 1) GEMM_WAIT_VM(5); else GEMM_WAIT_VM(0);
      }
    }
    if (!(abl & 8)) raw_barrier();
    if (!(abl & 4) && t + NS - 1 < ntiles) { int nb = buf + NS - 1; if (nb >= NS) nb -= NS; issue(t + NS - 1, nb); }
    const unsigned char* k_s = smem + buf * SBF;
    const unsigned char* v_s = k_s + KB_;
    f32x4 s[4][NQ];
    {
      bf16x8 kf[4][KS];
#pragma unroll
      for (int kt = 0; kt < 4; ++kt)
#pragma unroll
        for (int ks = 0; ks < KS; ++ks) kf[kt][ks] = *(const bf16x8*)(k_s + kt * 16 * DQK * 2 + koffs[ks]);
      __builtin_amdgcn_sched_barrier(0);
#pragma unroll
      for (int kt = 0; kt < 4; ++kt) {
#pragma unroll
        for (int qi = 0; qi < NQ; ++qi) s[kt][qi] = (f32x4){0.f, 0.f, 0.f, 0.f};
#pragma unroll
        for (int ks = 0; ks < KS; ++ks)
#pragma unroll
          for (int qi = 0; qi < NQ; ++qi) s[kt][qi] = __builtin_amdgcn_mfma_f32_16x16x32_bf16(kf[kt][ks], qf[qi][ks], s[kt][qi], 0, 0, 0);
      }
    }
    uint2 vfa[2][4], vfb[2][4];
#pragma unroll
    for (int kk = 0; kk < 2; ++kk)
#pragma unroll
      for (int dt = 0; dt < 4; ++dt) {
        vfa[kk][dt] = *(const uint2*)(v_s + dt * 2048 + voffs[kk][0]);
        vfb[kk][dt] = *(const uint2*)(v_s + dt * 2048 + voffs[kk][1]);
      }
    __builtin_amdgcn_sched_barrier(0);
    const float c2 = scale * L2E;
    if (MODE == 1 && t < 8) {
      const int drow = r0 + t - nat_r + 7;
#pragma unroll
      for (int kt = 0; kt < 4; ++kt)
#pragma unroll
        for (int j = 0; j < 4; ++j) {
          int kc = kt * 16 + quad * 4 + j;
          bool valid = (kc >= st) && (kc < st + 16);
          int bi = drow * 31 + (kc - qc + 15);
          bi = valid ? bi : 0;
          float bv = sBias[bi];
          s[kt][0][j] = valid ? (s[kt][0][j] * c2 + bv * L2E) : -INFINITY;
        }
    }
    const bool pre = (MODE == 1 && t < 8);
    bf16x8 pb[NQ][2];
    if (abl & 1) {
#pragma unroll
      for (int qi = 0; qi < NQ; ++qi)
#pragma unroll
        for (int kk = 0; kk < 2; ++kk) {
          uint4 u = make_uint4(pack2(s[2 * kk][qi][0], s[2 * kk][qi][1]), pack2(s[2 * kk][qi][2], s[2 * kk][qi][3]),
                               pack2(s[2 * kk + 1][qi][0], s[2 * kk + 1][qi][1]), pack2(s[2 * kk + 1][qi][2], s[2 * kk + 1][qi][3]));
          pb[qi][kk] = __builtin_bit_cast(bf16x8, u);
        }
    } else
#pragma unroll
    for (int qi = 0; qi < NQ; ++qi) {
      float mx = fmaxf(fmaxf(s[0][qi][0], s[0][qi][1]), fmaxf(s[0][qi][2], s[0][qi][3]));
#pragma unroll
      for (int kt = 1; kt < 4; ++kt) mx = fmaxf(mx, fmaxf(fmaxf(s[kt][qi][0], s[kt][qi][1]), fmaxf(s[kt][qi][2], s[kt][qi][3])));
      mx = xq_max(mx);
      const float cc = pre ? 1.f : c2;
      const float mnew = fmaxf(m[qi], mx * cc);
      const bool grew = __builtin_amdgcn_ballot_w64(mnew > m[qi]) != 0;
      const float alpha = __builtin_amdgcn_exp2f(m[qi] - mnew);
      m[qi] = mnew;
      float ps = 0.f;
#pragma unroll
      for (int kt = 0; kt < 4; ++kt)
#pragma unroll
        for (int j = 0; j < 4; ++j) {
          float pv = __builtin_amdgcn_exp2f(s[kt][qi][j] * cc - mnew);
          s[kt][qi][j] = pv;
          ps += pv;
        }
      if (grew) {
        lsum[qi] *= alpha;
#pragma unroll
        for (int dt = 0; dt < 4; ++dt)
#pragma unroll
          for (int j = 0; j < 4; ++j) o[dt][qi][j] *= alpha;
      }
      lsum[qi] += ps;
#pragma unroll
      for (int kk = 0; kk < 2; ++kk) {
        uint4 u = make_uint4(pack2(s[2 * kk][qi][0], s[2 * kk][qi][1]), pack2(s[2 * kk][qi][2], s[2 * kk][qi][3]),
                             pack2(s[2 * kk + 1][qi][0], s[2 * kk + 1][qi][1]), pack2(s[2 * kk + 1][qi][2], s[2 * kk + 1][qi][3]));
        pb[qi][kk] = __builtin_bit_cast(bf16x8, u);
      }
    }
#pragma unroll
    for (int kk = 0; kk < 2; ++kk)
#pragma unroll
      for (int dt = 0; dt < 4; ++dt) {
        uint4 vv = make_uint4(vfa[kk][dt].x, vfa[kk][dt].y, vfb[kk][dt].x, vfb[kk][dt].y);
        bf16x8 av = __builtin_bit_cast(bf16x8, vv);
#pragma unroll
        for (int qi = 0; qi < NQ; ++qi) o[dt][qi] = __builtin_amdgcn_mfma_f32_16x16x32_bf16(av, pb[qi][kk], o[dt][qi], 0, 0, 0);
      }
    if (++buf == NS) buf = 0;
  }
  raw_barrier();
#pragma unroll
  for (int qi = 0; qi < NQ; ++qi) {
    float l = xq_sum(lsum[qi]);
    const float inv = 1.f / l;
    const int row = wave * 16 * NQ + qi * 16 + l15;
#pragma unroll
    for (int dt = 0; dt < 4; ++dt)
      *(uint2*)(Op + (size_t)row * ldo + dt * 16 + quad * 4) =
          make_uint2(pack2(o[dt][qi][0] * inv, o[dt][qi][1] * inv), pack2(o[dt][qi][2] * inv, o[dt][qi][3] * inv));
  }
}

__device__ void scan_item(const Params& p, int l, int bl, int h, int dir, int half, unsigned char* smem, const int tid, const int abl) {
  float* R = (float*)smem;
  float* V = R + 2048;
  float* KK = V + 2048;
  float* KD = KK + 2048;
  float* W = KD + 2048;
  float* T1 = W + 2048;
  float* Y = T1 + 2048;
  float* BONW = Y + 2048;
  u16* XW = (u16*)(BONW + 128);
  u16* XA = XW + 32 * 72;
  const int lane = tid & 63, wave = tid >> 6, l15 = lane & 15, quad = lane >> 4;
  const u16* P = (const u16*)(p.ws + OFF_P);
  u16* Yd = (u16*)(p.ws + (dir ? OFF_YB : OFF_YF));
  float* BON = (float*)(p.ws + OFF_BON);
  const u16* Wl = (const u16*)(p.ws + OFF_W) + (size_t)l * W_TOTAL;
  const float* mu = p.in[15] + l * 1920;
  const int nn = wave * 16 + l15;
  const float w0 = p.in[16][(l * 2 + dir) * 512 + h * 64 + nn];
  const float a0 = p.in[18][(l * 2 + dir) * 512 + h * 64 + nn];
  const float ka = p.in[22][l * 512 + h * 64 + nn];
  const float rk = p.in[23][l * 512 + h * 64 + nn];
  bf16x8 wdec[2], waaa[2];
#pragma unroll
  for (int ks = 0; ks < 2; ++ks) {
    wdec[ks] = *(const bf16x8*)(Wl + W_DEC + ((size_t)dir * 512 + h * 64 + nn) * 64 + ks * 32 + quad * 8);
    waaa[ks] = *(const bf16x8*)(Wl + W_AAA + ((size_t)dir * 512 + h * 64 + nn) * 64 + ks * 32 + quad * 8);
  }
  const int st_t = tid >> 3, part = tid & 7, n0 = part * 8;
  const int sl = lane & 7, srow = half * 32 + wave * 8 + (lane >> 3);
  v2f S2[4];
#pragma unroll
  for (int i = 0; i < 4; ++i) S2[i] = (v2f){0.f, 0.f};
  float* MU = (float*)(XA + 32 * 72);
  float* KKC = MU + 320;
  for (int i = tid; i < 384; i += 256) {
    int g = i >> 6, n = i & 63;
    float v;
    if (g == 0) v = mu[h * 64 + n];
    else if (g == 1) v = mu[1024 + h * 64 + n];
    else if (g == 2) v = mu[512 + h * 64 + n];
    else if (g == 3) v = mu[1536 + dir * 64 + n];
    else if (g == 4) v = mu[1664 + dir * 64 + n];
    else v = p.in[21][l * 512 + h * 64 + n];
    MU[i] = v;
  }
  uint4 raw[15];
  auto issue_raw = [&](int cidx) {
    const int seg = cidx >= 8;
    const int cc = seg ? cidx - 8 : cidx, nch = seg ? 64 : 8, len = seg ? 2048 : 256;
    const int tb = bl * TL + (seg ? 256 : 0);
    const int c = dir ? (nch - 1 - cc) : cc;
    const int pos = c * 32 + st_t;
    const bool hasp = pos > 0, hasn = pos < len - 1;
    const u16* rowp = P + (size_t)(tb + pos) * NP + n0;
    const int cols[5] = {PC_R + h * 64, PC_V + h * 64, PC_K + h * 64, PC_WLO + dir * 64, PC_ALO + dir * 64};
#pragma unroll
    for (int g = 0; g < 5; ++g) {
      raw[3 * g] = *(const uint4*)(rowp + cols[g]);
      raw[3 * g + 1] = make_uint4(0, 0, 0, 0);
      raw[3 * g + 2] = make_uint4(0, 0, 0, 0);
      if (hasp) raw[3 * g + 1] = *(const uint4*)(rowp + cols[g] - NP);
      if (hasn) raw[3 * g + 2] = *(const uint4*)(rowp + cols[g] + NP);
    }
  };
  issue_raw(0);
  __syncthreads();

  for (int cidx = 0; cidx < 72; ++cidx) {
    {
      const int seg = cidx >= 8;
      const int cc = seg ? cidx - 8 : cidx, nch = seg ? 64 : 8;
      const int tb = bl * TL + (seg ? 256 : 0);
      const int c = dir ? (nch - 1 - cc) : cc;
      const int pos0 = c * 32;
      {
#define SHIFT8(G, z)                                                                              \
  {                                                                                               \
    const uint4 c4 = raw[3 * (G)], p4 = raw[3 * (G) + 1], n4 = raw[3 * (G) + 2];                  \
    const float4 m0 = *(const float4*)(MU + (G)*64 + n0), m1 = *(const float4*)(MU + (G)*64 + n0 + 4); \
    const float mm[8] = {m0.x, m0.y, m0.z, m0.w, m1.x, m1.y, m1.z, m1.w};                          \
    const uint32_t cu[4] = {c4.x, c4.y, c4.z, c4.w}, pu[4] = {p4.x, p4.y, p4.z, p4.w}, nu[4] = {n4.x, n4.y, n4.z, n4.w}; \
    _Pragma("unroll") for (int i = 0; i < 4; ++i) {                                               \
      float c0 = lo2f(cu[i]), c1 = hi2f(cu[i]);                                                   \
      z[2 * i] = c0 + (0.5f * (lo2f(pu[i]) + lo2f(nu[i])) - c0) * mm[2 * i];                      \
      z[2 * i + 1] = c1 + (0.5f * (hi2f(pu[i]) + hi2f(nu[i])) - c1) * mm[2 * i + 1];              \
    }                                                                                             \
  }
        float z[8];
        SHIFT8(0, z);
        *(float4*)(R + st_t * 64 + n0) = make_float4(z[0], z[1], z[2], z[3]);
        *(float4*)(R + st_t * 64 + n0 + 4) = make_float4(z[4], z[5], z[6], z[7]);
        SHIFT8(1, z);
        *(float4*)(V + st_t * 64 + n0) = make_float4(z[0], z[1], z[2], z[3]);
        *(float4*)(V + st_t * 64 + n0 + 4) = make_float4(z[4], z[5], z[6], z[7]);
        SHIFT8(2, z);
        {
          const float4 k0 = *(const float4*)(KKC + n0), k1 = *(const float4*)(KKC + n0 + 4);
          const float kc[8] = {k0.x, k0.y, k0.z, k0.w, k1.x, k1.y, k1.z, k1.w};
          float q[8], ss = 0.f;
#pragma unroll
          for (int i = 0; i < 8; ++i) { q[i] = z[i] * kc[i]; ss += q[i] * q[i]; }
          *(float4*)(KD + st_t * 64 + n0) = make_float4(z[0], z[1], z[2], z[3]);
          *(float4*)(KD + st_t * 64 + n0 + 4) = make_float4(z[4], z[5], z[6], z[7]);
          ss = row8_sum(ss);
          const float inv = 1.f / fmaxf(sqrtf(ss), 1e-12f);
          *(float4*)(KK + st_t * 64 + n0) = make_float4(q[0] * inv, q[1] * inv, q[2] * inv, q[3] * inv);
          *(float4*)(KK + st_t * 64 + n0 + 4) = make_float4(q[4] * inv, q[5] * inv, q[6] * inv, q[7] * inv);
        }
        SHIFT8(3, z);
        {
          float th[8];
#pragma unroll
          for (int i = 0; i < 8; ++i) th[i] = 1.f - 2.f / (1.f + __expf(2.f * z[i]));
          *(uint4*)(XW + st_t * 72 + n0) = make_uint4(pack2(th[0], th[1]), pack2(th[2], th[3]), pack2(th[4], th[5]), pack2(th[6], th[7]));
        }
        SHIFT8(4, z);
        *(uint4*)(XA + st_t * 72 + n0) = make_uint4(pack2(z[0], z[1]), pack2(z[2], z[3]), pack2(z[4], z[5]), pack2(z[6], z[7]));
#undef SHIFT8
      }
      raw_barrier();
#pragma unroll
      for (int mt = 0; mt < 2; ++mt) {
        f32x4 aw = (f32x4){0.f, 0.f, 0.f, 0.f}, aa = (f32x4){0.f, 0.f, 0.f, 0.f};
#pragma unroll
        for (int ks = 0; ks < 2; ++ks) {
          bf16x8 xw = *(const bf16x8*)(XW + (mt * 16 + l15) * 72 + ks * 32 + quad * 8);
          bf16x8 xa = *(const bf16x8*)(XA + (mt * 16 + l15) * 72 + ks * 32 + quad * 8);
          aw = __builtin_amdgcn_mfma_f32_16x16x32_bf16(xw, wdec[ks], aw, 0, 0, 0);
          aa = __builtin_amdgcn_mfma_f32_16x16x32_bf16(xa, waaa[ks], aa, 0, 0, 0);
        }
#pragma unroll
        for (int j = 0; j < 4; ++j) {
          const int t = mt * 16 + quad * 4 + j;
          const float wv = __expf(-0.6065306597126334f / (1.f + __expf(-(w0 + aw[j]))));
          const float av = 1.f / (1.f + __expf(-(a0 + aa[j])));
          W[t * 64 + nn] = wv;
          T1[t * 64 + nn] = KK[t * 64 + nn] * av;
          const float kd = KD[t * 64 + nn] * (1.f + (av - 1.f) * ka);
          KD[t * 64 + nn] = kd;
          const float bon = row16_sum(R[t * 64 + nn] * kd * rk);
          if (l15 == 0) BONW[wave * 32 + t] = bon;
        }
      }
      if (cidx + 1 < 72) issue_raw(cidx + 1);
      raw_barrier();
      {
        float4 Akk0, Akk1, At0, At1, Ad0, Ad1, Aw0, Aw1, Ar0, Ar1, Bkk0, Bkk1, Bt0, Bt1, Bd0, Bd1, Bw0, Bw1, Br0, Br1;
        float Av, Bv;
#define SCAN_LOAD(X, I)                                                  \
  {                                                                      \
    const int o_ = (I) * 64 + sl * 8;                                    \
    X##kk0 = *(const float4*)(KK + o_); X##kk1 = *(const float4*)(KK + o_ + 4); \
    X##t0 = *(const float4*)(T1 + o_);  X##t1 = *(const float4*)(T1 + o_ + 4);  \
    X##d0 = *(const float4*)(KD + o_);  X##d1 = *(const float4*)(KD + o_ + 4);  \
    X##w0 = *(const float4*)(W + o_);   X##w1 = *(const float4*)(W + o_ + 4);   \
    X##r0 = *(const float4*)(R + o_);   X##r1 = *(const float4*)(R + o_ + 4);   \
    X##v = V[(I) * 64 + srow];                                           \
  }
#define SCAN_PRE(C, KDv, Wv)    \
  const v2f tmp##C = S2[C] * (Wv) + vv0 * (KDv);
#define SCAN_EL(C, T1v, Rv)                                              \
  {                                                                      \
    const v2f t1_ = T1v, r_ = Rv;                                        \
    S2[C] = tmp##C + nsa0 * t1_;                                         \
    if ((C) & 1) y1 += S2[C] * r_; else y0 += S2[C] * r_;                \
  }
#define SCAN_STEP(X, I)                                                  \
  {                                                                      \
    const v2f k0 = (v2f){X##kk0.x, X##kk0.y}, k1 = (v2f){X##kk0.z, X##kk0.w}, k2 = (v2f){X##kk1.x, X##kk1.y}, k3 = (v2f){X##kk1.z, X##kk1.w}; \
    v2f a0 = S2[0] * k0, a0b = S2[1] * k1;                               \
    a0 += S2[2] * k2; a0b += S2[3] * k3;                                 \
    a0 += a0b;                                                           \
    const v2f vv0 = (v2f){X##v, X##v};                                   \
    SCAN_PRE(0, ((v2f){X##d0.x, X##d0.y}), ((v2f){X##w0.x, X##w0.y}))    \
    SCAN_PRE(1, ((v2f){X##d0.z, X##d0.w}), ((v2f){X##w0.z, X##w0.w}))    \
    SCAN_PRE(2, ((v2f){X##d1.x, X##d1.y}), ((v2f){X##w1.x, X##w1.y}))    \
    SCAN_PRE(3, ((v2f){X##d1.z, X##d1.w}), ((v2f){X##w1.z, X##w1.w}))    \
    const float sa0 = row8_sum(a0.x + a0.y);                             \
    const v2f nsa0 = (v2f){-sa0, -sa0};                                  \
    v2f y0 = (v2f){0.f, 0.f}, y1 = (v2f){0.f, 0.f};                      \
    SCAN_EL(0, ((v2f){X##t0.x, X##t0.y}), ((v2f){X##r0.x, X##r0.y}))     \
    SCAN_EL(1, ((v2f){X##t0.z, X##t0.w}), ((v2f){X##r0.z, X##r0.w}))     \
    SCAN_EL(2, ((v2f){X##t1.x, X##t1.y}), ((v2f){X##r1.x, X##r1.y}))     \
    SCAN_EL(3, ((v2f){X##t1.z, X##t1.w}), ((v2f){X##r1.z, X##r1.w}))     \
    y0 += y1;                                                            \
    const float ys0 = row8_sum(y0.x + y0.y);                             \
    if (sl == 0) Y[(I) * 64 + srow] = ys0;                               \
  }
        SCAN_LOAD(A, dir ? 31 : 0);
        for (int s = 0; s < ((abl & 32) ? 0 : 32); s += 2) {
          const int i0 = dir ? (31 - s) : s, i1 = dir ? (30 - s) : (s + 1);
          SCAN_LOAD(B, i1);
          SCAN_STEP(A, i0);
          if (s + 2 < 32) { SCAN_LOAD(A, dir ? (29 - s) : (s + 2)); }
          SCAN_STEP(B, i1);
        }
#undef SCAN_LOAD
#undef SCAN_EL
#undef SCAN_PRE
#undef SCAN_STEP
      }
      raw_barrier();
      {
        const float* yp = Y + st_t * 64 + half * 32 + part * 4;
        const size_t tok = (size_t)(tb + pos0 + st_t);
        *(uint2*)(Yd + tok * 512 + h * 64 + half * 32 + part * 4) = make_uint2(pack2(yp[0], yp[1]), pack2(yp[2], yp[3]));
        if (part == 0 && half == 0) BON[tok * 16 + h * 2 + dir] = BONW[st_t] + BONW[32 + st_t] + BONW[64 + st_t] + BONW[96 + st_t];
      }
    }
  }
  __syncthreads();
}

__device__ void phase_mixers(const Params& p, int chunk, int l, bool with_ctx, int* counter, unsigned char* smem, u16* dum, int kmask) {
  int& s_item = *(int*)(smem + SMEM_BYTES + 16);
  u16* sm = (u16*)smem;
  u16* P = (u16*)(p.ws + OFF_P);
  const u16* KA = (const u16*)(p.ws + OFF_KA);
  const u16* VtA = (const u16*)(p.ws + OFF_VTA);
  const u16* QB = (const u16*)(p.ws + OFF_QB);
  const u16* KB = (const u16*)(p.ws + OFF_KB);
  const u16* VtB = (const u16*)(p.ws + OFF_VTB);
  const u16* VtD = (const u16*)(p.ws + OFF_VTD);
  const float* ropeB = (const float*)(p.ws + OFF_ROPE) + 64 * 16 * 2;
  const int n_scan = 8 * 2 * 2;
  const int n_al = 8 * 16;
  const int n_nat = 8 * 32;
  const int n_cx = 8 * 2;
  const int total = n_scan + 2 * n_al + n_nat + (with_ctx ? 3 * n_cx : 0);
  const float scaleB = 0.10206207261596575f;
  const int my_xcd = (int)(__builtin_amdgcn_s_getreg((3 << 11) | 20) & 7u);
  for (int qq = 0; qq < 8; ++qq) {
   const int bl = (my_xcd + qq) & 7;
   int* qctr = counter + bl * 64;
   while (true) {
    const int tid = otid();
    if (tid == 0) s_item = atomicAdd(qctr, 1);
    __syncthreads();
    int it = s_item;
    __syncthreads();
    if (it >= total) break;
    if (it < n_scan) {
      if (!(kmask & 1)) continue;
      int half = it & 1, dir = (it >> 1) & 1, h = (it >> 2) & 7;
      __builtin_amdgcn_s_setprio(3);
      scan_item(p, l, bl, h, dir, half, smem, otid(), dum ? PR_ABL : 0);
      __builtin_amdgcn_s_setprio(0);
      continue;
    }
    it -= n_scan;
    int kind, h, ntl;
    size_t tok0;
    bool rq = false;
    int qtok0 = 0, natr = 0;
    if (it < 2 * n_al) {
      kind = (it >= n_al) ? 1 : 0;
      int i2 = it - kind * n_al;
      int qt = i2 & 15; h = (i2 >> 4) & 7;
      tok0 = (size_t)bl * TL + 256 + qt * 128; ntl = 36; rq = true; qtok0 = qt * 128;
    } else if (it < 2 * n_al + n_nat) {
      int i2 = it - 2 * n_al;
      kind = 3; natr = i2 & 31; h = (i2 >> 5) & 7;
      tok0 = (size_t)bl * TL + 256 + natr * 64; ntl = 12;
    } else {
      int i2 = it - 2 * n_al - n_nat;
      kind = i2 / n_cx; i2 -= kind * n_cx;
      int qt = i2 & 1; h = (i2 >> 1) & 7;
      tok0 = (size_t)bl * TL + qt * 128; ntl = 4;
    }
    {
      const int cls = (ntl == 36) ? (kind == 0 ? 2 : 4) : (ntl == 12 ? 8 : 16);
      if (!(kmask & cls)) continue;
    }
    if (kind == 1) {
      flash_item<96, 2, 0>(QB + tok0 * 768 + h * 96, 768, KB + (size_t)(bl * 8 + h) * TL * 96, 96, VtB + (size_t)(bl * 8 + h) * 64 * TL,
                           ntl, dum ? (dum + tok0 * 1536 + 512 + h * 64) : (P + tok0 * NP + O_B + h * 64), dum ? 1536 : NP, scaleB, rq, qtok0, ropeB, 0, nullptr, smem, otid(), dum ? PR_ABL : 0);
    } else if (kind == 3) {
      u16* q = P + tok0 * NP + PD_Q + h * 64;
      flash_item<64, 1, 1>(q, NP, P + (size_t)bl * TL * NP + PD_K + h * 64, NP, VtD + (size_t)(bl * 8 + h) * 64 * TL, ntl, dum ? (dum + tok0 * 1536 + 1024 + h * 64) : q, dum ? 1536 : NP, 0.125f,
                           false, 0, ropeB, natr, p.in[26] + (size_t)(l * 8 + h) * 15 * 31, smem, otid(), dum ? PR_ABL : 0);
    } else {
      u16* q = P + tok0 * NP + (kind == 0 ? PA_Q : PD_Q) + h * 64;
      const u16* kp = (kind == 0) ? (KA + (size_t)(bl * 2 + (h >> 2)) * TL * 64) : (P + (size_t)bl * TL * NP + PD_K + h * 64);
      const u16* vp = (kind == 0) ? (VtA + (size_t)(bl * 2 + (h >> 2)) * 64 * TL) : (VtD + (size_t)(bl * 8 + h) * 64 * TL);
      flash_item<64, 2, 0>(q, NP, kp, (kind == 0) ? 64 : NP, vp, ntl, dum ? (dum + tok0 * 1536 + (kind == 0 ? 0 : 1024) + h * 64) : q, dum ? 1536 : NP, 0.125f, false, 0, ropeB, 0, nullptr, smem, otid(), dum ? PR_ABL : 0);
    }
   }
  }
}

__device__ void phase_cout(const Params& p, int l, bool latonly) {
  const int tid = otid();
  const int lane = tid & 63, wave = tid >> 6;
  u16* P = (u16*)(p.ws + OFF_P);
  const u16* YF = (const u16*)(p.ws + OFF_YF);
  const u16* YB = (const u16*)(p.ws + OFF_YB);
  const u16* G = (const u16*)(p.ws + OFF_G);
  const float* BON = (const float*)(p.ws + OFF_BON);
  const float* gnw = p.in[24] + l * 512;
  const float* gnb = p.in[25] + l * 512;
  const float* mu = p.in[15] + l * 1920 + 1024;
  for (int tok = blockIdx.x * 4 + wave; tok < TC; tok += gridDim.x * 4) {
    const int bl = tok / TL, j = tok - bl * TL;
    const bool islat = j >= 256;
    if (latonly && !islat) continue;
    const int jj = j - 256;
    const bool hasp = islat ? (jj > 0) : (j > 0);
    const bool hasn = islat ? (jj < 2047) : (j < 255);
    u16* pr = P + (size_t)tok * NP;
    u16 yf[8], yb[8], gg[8], vcu[8], vpu[8], vnu[8];
    float bon[8];
#pragma unroll
    for (int h = 0; h < 8; ++h) {
      const int col = h * 64 + lane;
      yf[h] = YF[(size_t)tok * 512 + col];
      yb[h] = YB[(size_t)tok * 512 + col];
      gg[h] = G[(size_t)tok * 512 + col];
      vcu[h] = pr[PC_V + col];
      vpu[h] = hasp ? pr[PC_V + col - NP] : (u16)0;
      vnu[h] = hasn ? pr[PC_V + col + NP] : (u16)0;
      bon[h] = BON[(size_t)tok * 16 + h * 2] + BON[(size_t)tok * 16 + h * 2 + 1];
    }
#pragma unroll
    for (int h = 0; h < 8; ++h) {
      const int col = h * 64 + lane;
      const float y = bf2f(yf[h]) + bf2f(yb[h]);
      const float mean = wave_sum(y) * (1.f / 64.f);
      const float d = y - mean;
      const float var = wave_sum(d * d) * (1.f / 64.f);
      const float yn = d * rsqrtf(var + 64e-5f) * gnw[col] + gnb[col];
      const float vc = bf2f(vcu[h]);
      const float vs = vc + (0.5f * (bf2f(vpu[h]) + bf2f(vnu[h])) - vc) * mu[col];
      const float oc = (yn + bon[h] * vs) * bf2f(gg[h]);
      pr[O_C + col] = f2bf(oc);
    }
  }
}

#ifndef PR_GEMM1
#define PR_GEMM1 0
#endif
#ifndef PR_MERGE
#define PR_MERGE 0
#endif
#ifndef PR_KIND
#define PR_KIND -1
#endif
__device__ void phase_probe(const Params& p, int l, int kind, unsigned char* smem) {
  u16* sm = (u16*)smem;
  u16* P = (u16*)(p.ws + OFF_P);
  u16* DUM = (u16*)(p.ws + OFF_YM);
  const float* ropeB = (const float*)(p.ws + OFF_ROPE) + 64 * 16 * 2;
  const int total = (kind == 0) ? 128 : (kind == 3 ? 2048 : 1024);
  for (int it = blockIdx.x; it < total; it += gridDim.x) {
    if (kind == 0) {
      int dir = it & 1, h = (it >> 1) & 7, bl = it >> 4;
      scan_item(p, l, bl, h, dir, 0, smem, otid(), 0);
      scan_item(p, l, bl, h, dir, 1, smem, otid(), 0);
    } else if (kind == 1) {
      int qt = it & 15, h = (it >> 4) & 7, bl = it >> 7;
      size_t tok0 = (size_t)bl * TL + 256 + qt * 128;
      flash_item<64, 2, 0>(P + tok0 * NP + PA_Q + h * 64, NP, (const u16*)(p.ws + OFF_KA) + (size_t)(bl * 2 + (h >> 2)) * TL * 64, 64,
                           (const u16*)(p.ws + OFF_VTA) + (size_t)(bl * 2 + (h >> 2)) * 64 * TL, 36, DUM + tok0 * 1024 + h * 64, 1024,
                           0.125f, false, 0, ropeB, 0, nullptr, smem, otid(), 0);
    } else if (kind == 2) {
      int qt = it & 15, h = (it >> 4) & 7, bl = it >> 7;
      size_t tok0 = (size_t)bl * TL + 256 + qt * 128;
      flash_item<96, 2, 0>((const u16*)(p.ws + OFF_QB) + tok0 * 768 + h * 96, 768, (const u16*)(p.ws + OFF_KB) + (size_t)(bl * 8 + h) * TL * 96,
                           96, (const u16*)(p.ws + OFF_VTB) + (size_t)(bl * 8 + h) * 64 * TL, 36, P + tok0 * NP + O_B + h * 64, NP,
                           0.10206207261596575f, true, qt * 128, ropeB, 0, nullptr, smem, otid(), 0);
    } else {
      int r = it & 31, h = (it >> 5) & 7, bl = it >> 8;
      size_t tok0 = (size_t)bl * TL + 256 + r * 64;
      flash_item<64, 1, 1>(P + tok0 * NP + PD_Q + h * 64, NP, P + (size_t)bl * TL * NP + PD_K + h * 64, NP,
                           (const u16*)(p.ws + OFF_VTD) + (size_t)(bl * 8 + h) * 64 * TL, 12, DUM + tok0 * 1024 + h * 64, 1024, 0.125f,
                           false, 0, ropeB, r, p.in[26] + (size_t)(l * 8 + h) * 15 * 31, smem, otid(), 0);
    }
  }
}

#define XB_TMO      128
#define XB_XCNT(j)  (256  + 64 * (j))
#define XB_XSUB(j)  (1280 + 64 * (j))
#define XB_XGEN(j)  (2304 + 64 * (j))
#define XB_TOP      3328
#define XB_TOPGEN   3392
#define XCD_BAR_WORDS 3456
#define XB_SPIN_CAP (1u << 18)
#define LAS __attribute__((address_space(3)))
DI unsigned xb_ld(unsigned* p) { return __hip_atomic_load(p, __ATOMIC_RELAXED, __HIP_MEMORY_SCOPE_AGENT); }
DI unsigned xb_add(unsigned* p, unsigned v) { return __hip_atomic_fetch_add(p, v, __ATOMIC_RELAXED, __HIP_MEMORY_SCOPE_AGENT); }
DI unsigned xb_xcc_id() { return (unsigned)__builtin_amdgcn_s_getreg((3 << 11) | 20) & 0xFu; }
#define XB_SPIN(cond, bar) do { unsigned _sp = 0; while (cond) { __builtin_amdgcn_s_sleep(1); \
    if ((++_sp & 255u) == 0u) { if (xb_ld(&(bar)[XB_TMO])) break; if (_sp > XB_SPIN_CAP) { atomicAdd(&(bar)[XB_TMO], 1u); break; } } } } while (0)
struct XcdBarrier { unsigned* bar; unsigned x; volatile LAS unsigned* st; };
DI XcdBarrier xcd_barrier_post(unsigned* bar, volatile LAS unsigned* st) {
  XcdBarrier b; b.bar = bar; b.x = xb_xcc_id(); b.st = st;
  if (threadIdx.x == 0) (void)xb_add(&bar[XB_XCNT(b.x)], 1u);
  return b;
}
DI void xcd_barrier_complete(unsigned* bar, unsigned x, unsigned& nloc, unsigned& nx) {
  const unsigned G = gridDim.x * gridDim.y * gridDim.z;
  unsigned sum, cnt, mine, sp = 0u;
  for (;;) {
    sum = 0u; cnt = 0u; mine = 0u;
#pragma unroll
    for (unsigned j = 0; j < 16; ++j) { const unsigned c = xb_ld(&bar[XB_XCNT(j)]); sum += c; cnt += (c > 0u) ? 1u : 0u; mine = (j == x) ? c : mine; }
    if (sum == G) break;
    __builtin_amdgcn_s_sleep(1);
    if ((++sp & 255u) == 0u) { if (xb_ld(&bar[XB_TMO])) break; if (sp > XB_SPIN_CAP) { atomicAdd(&bar[XB_TMO], 1u); break; } }
  }
  nloc = mine > 0u ? mine : 1u; nx = cnt > 0u ? cnt : 1u;
}
DI void xcd_barrier(const XcdBarrier& b) {
  asm volatile("s_waitcnt vmcnt(0)" ::: "memory");
  __syncthreads();
  if (threadIdx.x == 0) {
    unsigned* bar = b.bar;
    __builtin_amdgcn_s_waitcnt(0);
    unsigned nloc = b.st[0], nx = b.st[1];
    if (nloc == 0u) { xcd_barrier_complete(bar, b.x, nloc, nx); b.st[0] = nloc; b.st[1] = nx; }
    const unsigned old = xb_add(&bar[XB_XSUB(b.x)], 1u);
    const unsigned gen = old / nloc;
    if (old + 1u == (gen + 1u) * nloc) {
      __builtin_amdgcn_fence(__ATOMIC_RELEASE, "agent");
      asm volatile("s_waitcnt vmcnt(0)" ::: "memory");
      const unsigned og = xb_add(&bar[XB_TOP], 1u);
      const unsigned tg = og / nx;
      if (og + 1u == (tg + 1u) * nx) xb_add(&bar[XB_TOPGEN], 1u);
      else XB_SPIN(xb_ld(&bar[XB_TOPGEN]) == tg, bar);
      __builtin_amdgcn_fence(__ATOMIC_ACQUIRE, "agent");
      xb_add(&bar[XB_XGEN(b.x)], 1u);
      asm volatile("s_waitcnt vmcnt(0)" ::: "memory");
    } else {
      XB_SPIN(xb_ld(&bar[XB_XGEN(b.x)]) == gen, bar);
      __builtin_amdgcn_fence(__ATOMIC_ACQUIRE, "agent");
      asm volatile("s_waitcnt vmcnt(0)" ::: "memory");
    }
  }
  __syncthreads();
}

__global__ void __launch_bounds__(256, 2) fwd_megakernel(Params p) {
  extern __shared__ __attribute__((aligned(16))) unsigned char smem[];
  cg::grid_group grid = cg::this_grid();
  u16* sm = (u16*)smem;
  unsigned* xb_words = (unsigned*)(smem + SMEM_BYTES);
  if (threadIdx.x < 4) xb_words[threadIdx.x] = 0u;
  __syncthreads();
  const XcdBarrier xb = xcd_barrier_post((unsigned*)(p.ws + OFF_BAR), (volatile LAS unsigned*)xb_words);
  phase0(p, smem);
  grid.sync();
  u16* H = (u16*)(p.ws + OFF_H);
  u16* P = (u16*)(p.ws + OFF_P);
  int* ctr = (int*)(p.ws + OFF_CTR);
  for (int chunk = 0; chunk < NCHUNK; ++chunk) {
    for (int l = 0; l < 2; ++l) {
      const bool last = (l == 1);
      const u16* W = (const u16*)(p.ws + OFF_W) + (size_t)l * W_TOTAL;
      const float* mod = (const float*)(p.ws + OFF_MOD) + (size_t)l * 17 * 6144;
      phase_norm(p, chunk, l, 0, false);
      xcd_barrier(xb);
      for (int rep = 0; rep <= PR_GEMM1; ++rep) {
        gemm_phase<8, 4, true>(H, 1024, W + W_IN, 1024, NP, false, EpiStore{P, NP}, smem);
        xcd_barrier(xb);
      }
      phase_prep(p, l, sm);
      xcd_barrier(xb);
      gemm_phase<4, 4, true>(P + PB_CQ, NP, W + W_QUP, 384, 768, false, EpiStore{(u16*)(p.ws + OFF_QB), 768}, smem);
      gemm_phase<4, 4, false>(P + PB_CKV, NP, W + W_KVUP, 256, 1024, false, EpiKV{(u16*)(p.ws + OFF_KB), (u16*)(p.ws + OFF_VTB)}, smem);
      gemm_phase<4, 4, true>((const u16*)(p.ws + OFF_GL), 128, W + W_GATE, 128, 512, false, EpiStore{(u16*)(p.ws + OFF_G), 512}, smem);
      xcd_barrier(xb);
      if (PR_KIND >= 0) {
        phase_probe(p, l, PR_KIND, smem);
        xcd_barrier(xb);
      }
#ifdef PR_MIX
      if (chunk == 0) { phase_mixers(p, chunk, l, !last, ctr + (4 + l) * 512, smem, (u16*)(p.out + (size_t)BC * 2048 * 1024), PR_MIX); xcd_barrier(xb); }
#endif
      phase_mixers(p, chunk, l, !last, ctr + (chunk * 2 + l) * 512, smem, nullptr, 31);
      xcd_barrier(xb);
      phase_cout(p, l, last);
      xcd_barrier(xb);
      for (int rep = 0; rep <= PR_MERGE; ++rep) {
        phase_merge(p, l, last, smem);
        xcd_barrier(xb);
      }
      if (last) gemm_phase<8, 4, true>((const u16*)(p.ws + OFF_YM), 1024, W + W_OUT, 1024, 1024, true, EpiResid{p, chunk, mod, 2048, false}, smem);
      else gemm_phase<4, 4, true>((const u16*)(p.ws + OFF_YM), 1024, W + W_OUT, 1024, 1024, false, EpiResid{p, chunk, mod, 2048, true}, smem);
      xcd_barrier(xb);
      phase_norm(p, chunk, l, 1, last);
      xcd_barrier(xb);
      gemm_phase<8, 4, true>(H, 1024, W + W_1, 1024, 4096, last, EpiRelu2{P}, smem);
      xcd_barrier(xb);
      if (last) gemm_phase<8, 4, true>(P, 4096, W + W_2, 4096, 1024, true, EpiResid{p, chunk, mod, 5120, false}, smem);
      else gemm_phase<4, 4, true>(P, 4096, W + W_2, 4096, 1024, false, EpiResid{p, chunk, mod, 5120, false}, smem);
      xcd_barrier(xb);
    }
    phase_final(p, chunk);
    xcd_barrier(xb);
  }
}

extern "C" void kernel_launch(void* const* d_in, const int* in_sizes, int n_in, void* d_out, int out_size, void* d_ws,
                              size_t ws_size, hipStream_t stream) {
  static int grid_blocks = 0;
  if (!grid_blocks) {
    int dev = 0, cus = 0, per_cu = 0;
    hipGetDevice(&dev);
    hipDeviceGetAttribute(&cus, hipDeviceAttributeMultiprocessorCount, dev);
    hipFuncSetAttribute((const void*)fwd_megakernel, hipFuncAttributeMaxDynamicSharedMemorySize, SMEM_DYN);
    hipOccupancyMaxActiveBlocksPerMultiprocessor(&per_cu, fwd_megakernel, 256, SMEM_DYN);
    if (per_cu > 2) per_cu = 2;
    if (per_cu < 1) per_cu = 1;
    grid_blocks = cus * per_cu;
  }
  if (ws_size < OFF_END) fprintf(stderr, "workspace too small: %zu < %zu\n", ws_size, (size_t)OFF_END);
  Params p{};
  for (int i = 0; i < 32; ++i) p.in[i] = (const float*)d_in[i];
  p.out = (float*)d_out;
  p.ws = (unsigned char*)d_ws;
  hipMemsetAsync(d_ws, 0, 1048576, stream);
  void* args[] = {&p};
  hipError_t e = hipLaunchCooperativeKernel((void*)fwd_megakernel, dim3(grid_blocks), dim3(256), args, SMEM_DYN, stream);
  if (e != hipSuccess) fprintf(stderr, "cooperative launch failed: %s (grid %d)\n", hipGetErrorString(e), grid_blocks);
}
```

```cpp
#include <hip/hip_runtime.h>
#include <hip/hip_cooperative_groups.h>
#include <stdint.h>
#include <cstdio>
namespace cg = cooperative_groups;

typedef unsigned short u16;
typedef __attribute__((ext_vector_type(8))) short bf16x8;
typedef __attribute__((ext_vector_type(4))) float f32x4;
typedef __attribute__((ext_vector_type(2))) float v2f;
#define DI __device__ __forceinline__

#ifndef PR_ABL
#define PR_ABL 0
#endif
constexpr int SMEM_BYTES = 73728;
constexpr int SMEM_DYN = SMEM_BYTES + 64;
constexpr int DM = 1024, TL = 2304;
constexpr int BC = 8, NCHUNK = 2, TC = BC * TL;
constexpr int NP = 4992;
constexpr int PA_Q = 0, PA_K = 512, PA_V = 640, PB_CQ = 768, PB_CKV = 1152, PB_KR = 1408;
constexpr int PC_R = 1440, PC_K = 1952, PC_V = 2464, PC_WLO = 2976, PC_ALO = 3104, PC_GLO = 3232;
constexpr int PD_Q = 3360, PD_K = 3872, PD_V = 4384;
constexpr int O_A = 0, O_B = 768, O_C = 1440, O_D = 3360;

constexpr int W_IN = 0, W_G = 5111808, W_QUP = 9306112, W_KVUP = 9601024, W_GATE = 9863168, W_DEC = 9928704,
              W_AAA = 9994240, W_BR = 10059776, W_OUT = 12156928, W_1 = 13205504, W_2 = 17399808, W_TOTAL = 21594112;

constexpr size_t OFF_MOD = 0;
constexpr size_t OFF_CTR = 835584;
constexpr size_t OFF_BAR = 851968;
constexpr size_t OFF_ROPE = 1048576;
constexpr size_t OFF_W = 2097152;
constexpr size_t OFF_H = OFF_W + (size_t)2 * W_TOTAL * 2;
constexpr size_t OFF_P = OFF_H + (size_t)TC * 1024 * 2;
constexpr size_t OFF_KA = OFF_P + (size_t)TC * NP * 2;
constexpr size_t OFF_VTA = OFF_KA + (size_t)BC * 2 * TL * 64 * 2;
constexpr size_t OFF_QB = OFF_VTA + (size_t)BC * 2 * TL * 64 * 2;
constexpr size_t OFF_KB = OFF_QB + (size_t)TC * 768 * 2;
constexpr size_t OFF_VTB = OFF_KB + (size_t)TC * 768 * 2;
constexpr size_t OFF_VTD = OFF_VTB + (size_t)TC * 512 * 2;
constexpr size_t OFF_GL = OFF_VTD + (size_t)TC * 512 * 2;
constexpr size_t OFF_G = OFF_GL + (size_t)TC * 128 * 2;
constexpr size_t OFF_YF = OFF_G + (size_t)TC * 512 * 2;
constexpr size_t OFF_YB = OFF_YF + (size_t)TC * 512 * 2;
constexpr size_t OFF_BON = OFF_YB + (size_t)TC * 512 * 2;
constexpr size_t OFF_XC = OFF_BON + (size_t)TC * 16 * 4;
constexpr size_t OFF_END = OFF_XC + (size_t)BC * 256 * 1024 * 4;
constexpr size_t OFF_YM = OFF_QB;

struct Params {
  const float* in[32];
  float* out;
  unsigned char* ws;
};

DI u16 f2bf(float f) { uint32_t u = __float_as_uint(f); u += 0x7fffu + ((u >> 16) & 1u); return (u16)(u >> 16); }
DI float bf2f(u16 h) { return __uint_as_float(((uint32_t)h) << 16); }
typedef __bf16 bf2_t __attribute__((ext_vector_type(2)));
DI uint32_t pack2(float a, float b) { v2f v = {a, b}; bf2_t r = __builtin_convertvector(v, bf2_t); return __builtin_bit_cast(uint32_t, r); }
DI float lo2f(uint32_t u) { return __uint_as_float(u << 16); }
DI float hi2f(uint32_t u) { return __uint_as_float(u & 0xffff0000u); }
DI float dpp_f(float v, const int ctrl_is_unused) { return v; }
#define DPP_ADD(v, ctrl) ((v) + __int_as_float(__builtin_amdgcn_update_dpp(0, __float_as_int(v), (ctrl), 0xF, 0xF, true)))
DI float row8_sum(float v) {
  v = DPP_ADD(v, 0xB1); v = DPP_ADD(v, 0x4E); v = DPP_ADD(v, 0x141);
  return v;
}
DI float row16_sum(float v) {
  v = DPP_ADD(v, 0xB1); v = DPP_ADD(v, 0x4E); v = DPP_ADD(v, 0x141); v = DPP_ADD(v, 0x140);
  return v;
}
DI float xq_sum(float v) {
  auto r = __builtin_amdgcn_permlane16_swap(__float_as_uint(v), __float_as_uint(v), false, false);
  v = __uint_as_float(r[0]) + __uint_as_float(r[1]);
  auto r2 = __builtin_amdgcn_permlane32_swap(__float_as_uint(v), __float_as_uint(v), false, false);
  return __uint_as_float(r2[0]) + __uint_as_float(r2[1]);
}
DI float xq_max(float v) {
  auto r = __builtin_amdgcn_permlane16_swap(__float_as_uint(v), __float_as_uint(v), false, false);
  v = fmaxf(__uint_as_float(r[0]), __uint_as_float(r[1]));
  auto r2 = __builtin_amdgcn_permlane32_swap(__float_as_uint(v), __float_as_uint(v), false, false);
  return fmaxf(__uint_as_float(r2[0]), __uint_as_float(r2[1]));
}
DI float wave_sum(float v) { return xq_sum(row16_sum(v)); }
DI float quad_sum(float v) {
  v += __int_as_float(__builtin_amdgcn_update_dpp(0, __float_as_int(v), 0xB1, 0xF, 0xF, true));
  v += __int_as_float(__builtin_amdgcn_update_dpp(0, __float_as_int(v), 0x4E, 0xF, 0xF, true));
  return v;
}
DI int otid() { int t = threadIdx.x; asm volatile("" : "+v"(t)); return t; }
DI float sigmoidf_(float x) { return 1.f / (1.f + __expf(-x)); }

DI float* x1_row(const Params& p, int chunk, int row) {
  int bl = row / TL, j = row - bl * TL;
  if (j < 256) return (float*)(p.ws + OFF_XC) + ((size_t)(bl * 256 + j)) * DM;
  return p.out + ((size_t)((chunk * BC + bl) * 2048 + (j - 256))) * DM;
}
DI const float* xin_row(const Params& p, int chunk, int row) {
  int bl = row / TL, j = row - bl * TL;
  int b = chunk * BC + bl;
  if (j < 256) return p.in[2] + ((size_t)(b * 256 + j)) * DM;
  return p.in[0] + ((size_t)(b * 2048 + (j - 256))) * DM;
}
DI int mod_row(int chunk, int row) {
  int bl = row / TL, j = row - bl * TL;
  return (j < 256) ? 16 : (chunk * BC + bl);
}

__constant__ int CONVTAB[16][8] = {
  {8, 1024 * 8992, 0, 1024, 8992, 0, 4896, W_IN},
  {8, 1024 * 8992, 0, 1024, 8992, 4896, 4096, W_G},
  {13, 384 * 768, 0, 384, 768, 0, 768, W_QUP},
  {14, 256 * 1024, 0, 256, 1024, 0, 1024, W_KVUP},
  {20, 128 * 512, 0, 128, 512, 0, 512, W_GATE},
  {17, 2 * 64 * 512, 0, 64, 512, 0, 512, W_DEC},
  {17, 2 * 64 * 512, 64 * 512, 64, 512, 0, 512, W_DEC + 512 * 64},
  {19, 2 * 64 * 512, 0, 64, 512, 0, 512, W_AAA},
  {19, 2 * 64 * 512, 64 * 512, 64, 512, 0, 512, W_AAA + 512 * 64},
  {27, 4 * 512 * 1024, 0, 512, 1024, 0, 1024, W_BR},
  {27, 4 * 512 * 1024, 512 * 1024, 512, 1024, 0, 1024, W_BR + 1024 * 512},
  {27, 4 * 512 * 1024, 2 * 512 * 1024, 512, 1024, 0, 1024, W_BR + 2 * 1024 * 512},
  {27, 4 * 512 * 1024, 3 * 512 * 1024, 512, 1024, 0, 1024, W_BR + 3 * 1024 * 512},
  {28, 1024 * 1024, 0, 1024, 1024, 0, 1024, W_OUT},
  {29, 1024 * 4096, 0, 1024, 4096, 0, 4096, W_1},
  {30, 4096 * 1024, 0, 4096, 1024, 0, 1024, W_2},
};
constexpr int CONV_TILES_PER_LAYER = 1232 + 1024 + 72 + 64 + 16 + 8 + 8 + 8 + 8 + 128 * 4 + 256 + 1024 + 1024;

__device__ void conv_tile(const float* __restrict__ src, int ld, int k0, int n0, int ncols, u16* __restrict__ dst, int K,
                          float* tile, const int tid) {
  {
    const int c4 = (tid & 15) * 4;
#pragma unroll
    for (int i = 0; i < 4; ++i) {
      int r = (tid >> 4) + 16 * i;
      float4 v = make_float4(0.f, 0.f, 0.f, 0.f);
      if (n0 + c4 < ncols) v = *(const float4*)(src + (size_t)(k0 + r) * ld + n0 + c4);
      tile[r * 65 + c4 + 0] = v.x; tile[r * 65 + c4 + 1] = v.y; tile[r * 65 + c4 + 2] = v.z; tile[r * 65 + c4 + 3] = v.w;
    }
  }
  __syncthreads();
  {
    const int n = tid >> 2, kc = (tid & 3) * 16;
    if (n0 + n < ncols) {
      uint32_t w[8];
#pragma unroll
      for (int i = 0; i < 8; ++i) w[i] = pack2(tile[(kc + 2 * i) * 65 + n], tile[(kc + 2 * i + 1) * 65 + n]);
      uint4* d = (uint4*)(dst + (size_t)(n0 + n) * K + k0 + kc);
      d[0] = make_uint4(w[0], w[1], w[2], w[3]);
      d[1] = make_uint4(w[4], w[5], w[6], w[7]);
    }
  }
  __syncthreads();
}

__device__ void phase0(const Params& p, unsigned char* smem) {
  float* fsm = (float*)smem;
  const int tid = otid();
  const int n_conv = 2 * CONV_TILES_PER_LAYER;
  const int n_pad = 2 * 48;
  const int n_ada = 2 * 16 * 24;
  const int total = n_conv + n_pad + n_ada + 1;
  u16* wbase = (u16*)(p.ws + OFF_W);
  for (int it = blockIdx.x; it < total; it += gridDim.x) {
    if (it < n_conv) {
      int l = it / CONV_TILES_PER_LAYER, r = it - l * CONV_TILES_PER_LAYER;
      int job = 0;
      for (; job < 16; ++job) {
        int nt = (CONVTAB[job][3] >> 6) * ((CONVTAB[job][6] + 63) >> 6);
        if (r < nt) break;
        r -= nt;
      }
      const int K = CONVTAB[job][3], ld = CONVTAB[job][4], col0 = CONVTAB[job][5], ncols = CONVTAB[job][6];
      const int nkt = K >> 6;
      const int kt = r % nkt, ntile = r / nkt;
      const float* src = p.in[CONVTAB[job][0]] + (size_t)l * CONVTAB[job][1] + CONVTAB[job][2] + col0;
      u16* dst = wbase + (size_t)l * W_TOTAL + CONVTAB[job][7];
      conv_tile(src, ld, kt * 64, ntile * 64, ncols, dst, K, fsm, tid);
    } else if (it < n_conv + n_pad) {
      int r = it - n_conv;
      int l = r / 48, q = r - l * 48;
      u16* dst = wbase + (size_t)l * W_TOTAL + W_IN + (size_t)(4896 + q * 2) * 1024;
      *(uint4*)(dst + tid * 8) = make_uint4(0, 0, 0, 0);
    } else if (it < n_conv + n_pad + n_ada) {
      int r = it - n_conv - n_pad;
      int l = r / 384; r -= l * 384;
      int kc = r / 24, nb = r - kc * 24;
      for (int idx = tid; idx < 17 * 64; idx += 256) {
        int rr = idx >> 6, k = idx & 63;
        float cv = (rr < 16) ? p.in[1][rr * 1024 + kc * 64 + k] : p.in[3][kc * 64 + k];
        fsm[idx] = cv / (1.f + expf(-cv));
      }
      __syncthreads();
      const int n = nb * 256 + tid;
      float acc[17];
#pragma unroll
      for (int i = 0; i < 17; ++i) acc[i] = 0.f;
      const float* wp = p.in[4] + ((size_t)l * 1024 + kc * 64) * 6144 + n;
#pragma unroll 4
      for (int k = 0; k < 64; ++k) {
        float w = wp[(size_t)k * 6144];
#pragma unroll
        for (int i = 0; i < 17; ++i) acc[i] += fsm[i * 64 + k] * w;
      }
      float bias = (kc == 0) ? p.in[5][l * 6144 + n] : 0.f;
      float* mod = (float*)(p.ws + OFF_MOD);
#pragma unroll
      for (int i = 0; i < 17; ++i) atomicAdd(&mod[(size_t)(l * 17 + i) * 6144 + n], acc[i] + bias);
      __syncthreads();
    } else {
      float* ra = (float*)(p.ws + OFF_ROPE);
      float* rb = ra + 64 * 16 * 2;
      for (int idx = tid; idx < 64 * 16; idx += 256) {
        int pos = idx >> 4, i = idx & 15;
        float inv = powf(10000.f, -(float)i / 16.f);
        float ang = (float)pos * inv;
        ra[idx * 2] = cosf(ang); ra[idx * 2 + 1] = sinf(ang);
      }
      for (int idx = tid; idx < 64 * 8; idx += 256) {
        int pos = idx >> 3, i = idx & 7;
        float inv = powf(10000.f, -(float)i / 8.f);
        float ang = (float)pos * inv;
        rb[idx * 2] = cosf(ang); rb[idx * 2 + 1] = sinf(ang);
      }
    }
  }
}

__device__ void phase_norm(const Params& p, int chunk, int l, int which, bool latonly) {
  const int tid = otid();
  const int lane = tid & 63, wave = tid >> 6;
  const float* g = p.in[which == 0 ? 6 : 7] + l * 1024;
  const float* mod = (const float*)(p.ws + OFF_MOD) + (size_t)l * 17 * 6144;
  u16* H = (u16*)(p.ws + OFF_H);
  for (int row = blockIdx.x * 4 + wave; row < TC; row += gridDim.x * 4) {
    int j = row % TL;
    if (latonly && j < 256) continue;
    const float* src = (which == 0 && l == 0) ? xin_row(p, chunk, row) : (const float*)x1_row(p, chunk, row);
    const float* mr = mod + (size_t)mod_row(chunk, row) * 6144 + which * 3072;
    float4 v[4];
    float ss = 0.f;
#pragma unroll
    for (int i = 0; i < 4; ++i) {
      v[i] = *(const float4*)(src + i * 256 + lane * 4);
      ss += v[i].x * v[i].x + v[i].y * v[i].y + v[i].z * v[i].z + v[i].w * v[i].w;
    }
    ss = wave_sum(ss);
    float rs = rsqrtf(ss * (1.f / 1024.f) + 1e-6f);
#pragma unroll
    for (int i = 0; i < 4; ++i) {
      int c = i * 256 + lane * 4;
      float4 gg = *(const float4*)(g + c);
      float4 sh = *(const float4*)(mr + c);
      float4 sc = *(const float4*)(mr + 1024 + c);
      float a0 = v[i].x * rs * gg.x * (1.f + sc.x) + sh.x;
      float a1 = v[i].y * rs * gg.y * (1.f + sc.y) + sh.y;
      float a2 = v[i].z * rs * gg.z * (1.f + sc.z) + sh.z;
      float a3 = v[i].w * rs * gg.w * (1.f + sc.w) + sh.w;
      *(uint2*)(H + (size_t)row * 1024 + c) = make_uint2(pack2(a0, a1), pack2(a2, a3));
    }
  }
}

__device__ void phase_final(const Params& p, int chunk) {
  const int tid = otid();
  const int lane = tid & 63, wave = tid >> 6;
  const float* g = p.in[31];
  for (int r = blockIdx.x * 4 + wave; r < BC * 2048; r += gridDim.x * 4) {
    float* px = p.out + ((size_t)chunk * BC * 2048 + r) * DM;
    float4 v[4];
    float ss = 0.f;
#pragma unroll
    for (int i = 0; i < 4; ++i) {
      v[i] = *(const float4*)(px + i * 256 + lane * 4);
      ss += v[i].x * v[i].x + v[i].y * v[i].y + v[i].z * v[i].z + v[i].w * v[i].w;
    }
    ss = wave_sum(ss);
    float rs = rsqrtf(ss * (1.f / 1024.f) + 1e-6f);
#pragma unroll
    for (int i = 0; i < 4; ++i) {
      int c = i * 256 + lane * 4;
      float4 gg = *(const float4*)(g + c);
      *(float4*)(px + c) = make_float4(v[i].x * rs * gg.x, v[i].y * rs * gg.y, v[i].z * rs * gg.z, v[i].w * rs * gg.w);
    }
  }
}

#define GEMM_WAIT_VM(n) asm volatile("s_waitcnt vmcnt(" #n ")" ::: "memory")
DI void raw_barrier() { asm volatile("s_waitcnt lgkmcnt(0)" ::: "memory"); __builtin_amdgcn_s_barrier(); }
template <int MI, int NI, bool TR, bool PERM = false>
DI void gemm_dma(const u16* __restrict__ A, int lda, const u16* __restrict__ Bt, int ldb, int K, f32x4 (&acc)[MI][NI],
                 unsigned char* smem, const int tid) {
  constexpr int BM = 32 * MI, BN = 32 * NI;
  constexpr int SB = (BM + BN) * 64;
  constexpr int NS = (73728 / SB) >= 4 ? 4 : 3;
  constexpr int LA = BM / 64, LB = BN / 64, LPT = LA + LB;
  static_assert(LPT == 3 || LPT == 4 || LPT == 6, "unexpected tile");
  const int lane = tid & 63, wave = tid >> 6, l15 = lane & 15, quad = lane >> 4;
  const int wm = wave >> 1, wn = wave & 1;
  const int drow = tid >> 2;
  const int g4 = (0x1230 >> (((drow >> 2) & 3) * 4)) & 3;
  const int dc = (tid & 3) ^ g4;
  const u16* Asrc = A + (size_t)drow * lda + dc * 8;
  const int rho = drow & 31;
  const int brow_src = PERM ? ((drow & 32) + 8 * ((rho & 15) >> 2) + 4 * (rho >> 4) + (rho & 3)) : drow;
  const u16* Bsrc = Bt + (size_t)brow_src * ldb + dc * 8;
  unsigned char* dstw = smem + __builtin_amdgcn_readfirstlane(tid >> 6) * 1024;
  auto issue = [&](int kt, int buf) {
    const int ko = kt * 32;
#pragma unroll
    for (int j = 0; j < LA; ++j)
      __builtin_amdgcn_global_load_lds((const unsigned*)(Asrc + (size_t)(j * 64) * lda + ko), (unsigned*)(dstw + buf * SB + j * 4096), 16, 0, 0);
#pragma unroll
    for (int j = 0; j < LB; ++j)
      __builtin_amdgcn_global_load_lds((const unsigned*)(Bsrc + (size_t)(j * 64) * ldb + ko), (unsigned*)(dstw + buf * SB + (LA + j) * 4096), 16, 0, 0);
  };
  const int rg4 = (0x1230 >> ((l15 >> 2) * 4)) & 3;
  const int aoff = (wm * 16 * MI + l15) * 64 + ((quad ^ rg4) * 16);
  const int boff = BM * 64 + (wn * 16 * NI + l15) * 64 + ((quad ^ rg4) * 16);
  const int nk = K >> 5;
  GEMM_WAIT_VM(0);
#pragma unroll
  for (int s_ = 0; s_ < NS - 1; ++s_)
    if (s_ < nk) issue(s_, s_);
  int buf = 0;
  for (int kt = 0; kt < nk; ++kt) {
    const int rem = nk - 1 - kt;
    if (NS == 4) {
      if (rem >= 2) { if (LPT == 3) GEMM_WAIT_VM(6); else if (LPT == 4) GEMM_WAIT_VM(8); else GEMM_WAIT_VM(12); }
      else if (rem == 1) { if (LPT == 3) GEMM_WAIT_VM(3); else if (LPT == 4) GEMM_WAIT_VM(4); else GEMM_WAIT_VM(6); }
      else GEMM_WAIT_VM(0);
    } else {
      if (rem >= 1) { if (LPT == 3) GEMM_WAIT_VM(3); else if (LPT == 4) GEMM_WAIT_VM(4); else GEMM_WAIT_VM(6); }
      else GEMM_WAIT_VM(0);
    }
    raw_barrier();
    const unsigned char* st = smem + buf * SB;
    bf16x8 af[MI], bfr[NI];
#pragma unroll
    for (int mi = 0; mi < MI; ++mi) af[mi] = *(const bf16x8*)(st + aoff + mi * 1024);
#pragma unroll
    for (int ni = 0; ni < NI; ++ni) bfr[ni] = *(const bf16x8*)(st + boff + ni * 1024);
    __builtin_amdgcn_sched_barrier(0);
    if (kt + NS - 1 < nk) { int nb = buf + NS - 1; if (nb >= NS) nb -= NS; issue(kt + NS - 1, nb); }
    __builtin_amdgcn_sched_barrier(0);
    __builtin_amdgcn_s_setprio(1);
#pragma unroll
    for (int mi = 0; mi < MI; ++mi)
#pragma unroll
      for (int ni = 0; ni < NI; ++ni)
        acc[mi][ni] = TR ? __builtin_amdgcn_mfma_f32_16x16x32_bf16(bfr[ni], af[mi], acc[mi][ni], 0, 0, 0)
                         : __builtin_amdgcn_mfma_f32_16x16x32_bf16(af[mi], bfr[ni], acc[mi][ni], 0, 0, 0);
    __builtin_amdgcn_s_setprio(0);
    if (++buf == NS) buf = 0;
  }
  raw_barrier();
}

DI bool tile_map(int t, int nMg, int nNt, bool latonly, int MT, int& mt, int& nt) {
  int x = t & 7, rest = t >> 3;
  int ni = rest & 7, q = rest >> 3;
  int mg = q % nMg, ng = q / nMg;
  nt = ng * 8 + ni;
  if (nt >= nNt) return false;
  int mti = mg * 8 + x;
  if (MT == 128) mt = latonly ? ((mti >> 4) * 18 + 2 + (mti & 15)) : mti;
  else mt = latonly ? ((mti >> 3) * 9 + 1 + (mti & 7)) : mti;
  return true;
}

template <int MI, int NI, bool TR, class Epi>
__device__ void gemm_phase(const u16* A, int lda, const u16* Bt, int K, int N, bool latonly, Epi epi, unsigned char* smem) {
  constexpr int BM = 32 * MI, BN = 32 * NI;
  const int nMg = (BM == 128) ? (latonly ? 16 : 18) : (latonly ? 8 : 9);
  const int nNt = N / BN;
  const int total = 64 * nMg * ((nNt + 7) >> 3);
  const int tid = otid();
  const int lane = tid & 63, wave = tid >> 6, l15 = lane & 15, quad = lane >> 4;
  const int wm = wave >> 1, wn = wave & 1;
  for (int t = blockIdx.x; t < total; t += gridDim.x) {
    int mt, nt;
    if (!tile_map(t, nMg, nNt, latonly, BM, mt, nt)) continue;
    const int m0 = mt * BM, n0 = nt * BN;
    f32x4 acc[MI][NI];
#pragma unroll
    for (int mi = 0; mi < MI; ++mi)
#pragma unroll
      for (int ni = 0; ni < NI; ++ni) acc[mi][ni] = (f32x4){0.f, 0.f, 0.f, 0.f};
    gemm_dma<MI, NI, TR, Epi::PERM>(A + (size_t)m0 * lda, lda, Bt + (size_t)n0 * K, K, K, acc, smem, tid);
    if constexpr (Epi::PERM) {
#pragma unroll
      for (int mi = 0; mi < MI; ++mi)
#pragma unroll
        for (int pr = 0; pr < NI / 2; ++pr)
          epi.pair(m0 + wm * 16 * MI + mi * 16 + l15, n0 + wn * 16 * NI + pr * 32 + 8 * quad, acc[mi][2 * pr], acc[mi][2 * pr + 1]);
    } else if constexpr (Epi::BATCH) {
#pragma unroll
      for (int mi = 0; mi < MI; ++mi) epi.template row<NI>(m0 + wm * 16 * MI + mi * 16 + l15, n0 + wn * 16 * NI + quad * 4, acc[mi]);
    } else {
#pragma unroll
      for (int mi = 0; mi < MI; ++mi)
#pragma unroll
        for (int ni = 0; ni < NI; ++ni) {
          if (TR) epi(m0 + wm * 16 * MI + mi * 16 + l15, n0 + wn * 16 * NI + ni * 16 + quad * 4, acc[mi][ni]);
          else epi(m0 + wm * 16 * MI + mi * 16 + quad * 4, n0 + wn * 16 * NI + ni * 16 + l15, acc[mi][ni]);
        }
    }
  }
}

struct EpiStore {
  u16* C; int ldc;
  static constexpr bool BATCH = false, PERM = true;
  DI void pair(int r, int c0, f32x4 a, f32x4 b) const {
    *(uint4*)(C + (size_t)r * ldc + c0) = make_uint4(pack2(a[0], a[1]), pack2(a[2], a[3]), pack2(b[0], b[1]), pack2(b[2], b[3]));
  }
  DI void operator()(int r, int c0, f32x4 v) const {
    *(uint2*)(C + (size_t)r * ldc + c0) = make_uint2(pack2(v[0], v[1]), pack2(v[2], v[3]));
  }
};
struct EpiKV {
  u16* KB; u16* VtB;
  static constexpr bool BATCH = false, PERM = false;
  DI void operator()(int r0, int c, f32x4 v) const {
    int bl = r0 / TL, j0 = r0 - bl * TL;
    int head = c >> 7, w = c & 127;
    if (w < 64) {
#pragma unroll
      for (int j = 0; j < 4; ++j) KB[((size_t)(bl * 8 + head) * TL + j0 + j) * 96 + w] = f2bf(v[j]);
    } else {
      *(uint2*)(VtB + ((size_t)(bl * 8 + head) * 64 + (w - 64)) * TL + j0) = make_uint2(pack2(v[0], v[1]), pack2(v[2], v[3]));
    }
  }
};
struct EpiRelu2 {
  u16* C;
  static constexpr bool BATCH = false, PERM = true;
  DI void pair(int r, int c0, f32x4 a, f32x4 b) const {
    float t[8];
#pragma unroll
    for (int i = 0; i < 4; ++i) { t[i] = fmaxf(a[i], 0.f); t[4 + i] = fmaxf(b[i], 0.f); }
    *(uint4*)(C + (size_t)r * 4096 + c0) = make_uint4(pack2(t[0] * t[0], t[1] * t[1]), pack2(t[2] * t[2], t[3] * t[3]),
                                                     pack2(t[4] * t[4], t[5] * t[5]), pack2(t[6] * t[6], t[7] * t[7]));
  }
  DI void operator()(int r, int c0, f32x4 v) const {
    float t0 = fmaxf(v[0], 0.f), t1 = fmaxf(v[1], 0.f), t2 = fmaxf(v[2], 0.f), t3 = fmaxf(v[3], 0.f);
    *(uint2*)(C + (size_t)r * 4096 + c0) = make_uint2(pack2(t0 * t0, t1 * t1), pack2(t2 * t2, t3 * t3));
  }
};
struct EpiResid {
  Params p; int chunk; const float* mod; int gofs; bool from_input;
  static constexpr bool BATCH = true, PERM = false;
  template <int NI>
  DI void row(int r, int c0, const f32x4 (&v)[NI]) const {
    const float* gtp = mod + (size_t)mod_row(chunk, r) * 6144 + gofs + c0;
    float* dst = x1_row(p, chunk, r) + c0;
    const float* src = from_input ? (xin_row(p, chunk, r) + c0) : (const float*)dst;
    float4 gt[NI], xin[NI];
#pragma unroll
    for (int ni = 0; ni < NI; ++ni) { gt[ni] = *(const float4*)(gtp + ni * 16); xin[ni] = *(const float4*)(src + ni * 16); }
#pragma unroll
    for (int ni = 0; ni < NI; ++ni)
      *(float4*)(dst + ni * 16) = make_float4(xin[ni].x + gt[ni].x * v[ni][0], xin[ni].y + gt[ni].y * v[ni][1],
                                              xin[ni].z + gt[ni].z * v[ni][2], xin[ni].w + gt[ni].w * v[ni][3]);
  }
};

__device__ void phase_merge(const Params& p, int l, bool latonly, unsigned char* smem) {
  const u16* H = (const u16*)(p.ws + OFF_H);
  const u16* P = (const u16*)(p.ws + OFF_P);
  const u16* W = (const u16*)(p.ws + OFF_W) + (size_t)l * W_TOTAL;
  u16* YM = (u16*)(p.ws + OFF_YM);
  const int nMg = latonly ? 16 : 18;
  const int nNt = 8;
  const int total = 64 * nMg;
  const int tid = otid();
  const int lane = tid & 63, wave = tid >> 6, l15 = lane & 15, quad = lane >> 4;
  const int wm = wave >> 1, wn = wave & 1;
  for (int t = blockIdx.x; t < total; t += gridDim.x) {
    int mt, nt;
    if (!tile_map(t, nMg, nNt, latonly, 128, mt, nt)) continue;
    const int m0 = mt * 128, n0 = nt * 128;
    uint2 yp[4][4];
#pragma unroll
    for (int mi = 0; mi < 4; ++mi)
#pragma unroll
      for (int ni = 0; ni < 4; ++ni) yp[mi][ni] = make_uint2(0u, 0u);
    for (int i = 0; i < 4; ++i) {
      const int ocol = (i == 0) ? O_A : (i == 1) ? O_B : (i == 2) ? O_C : O_D;
      uint2 gp[4][4];
      {
        f32x4 g[4][4];
#pragma unroll
        for (int mi = 0; mi < 4; ++mi)
#pragma unroll
          for (int ni = 0; ni < 4; ++ni) g[mi][ni] = (f32x4){0.f, 0.f, 0.f, 0.f};
        gemm_dma<4, 4, true>(H + (size_t)m0 * 1024, 1024, W + W_G + (size_t)(i * 1024 + n0) * 1024, 1024, 1024, g, smem, tid);
#pragma unroll
        for (int mi = 0; mi < 4; ++mi)
#pragma unroll
          for (int ni = 0; ni < 4; ++ni)
            gp[mi][ni] = make_uint2(pack2(sigmoidf_(g[mi][ni][0]), sigmoidf_(g[mi][ni][1])), pack2(sigmoidf_(g[mi][ni][2]), sigmoidf_(g[mi][ni][3])));
      }
      f32x4 b[4][4];
#pragma unroll
      for (int mi = 0; mi < 4; ++mi)
#pragma unroll
        for (int ni = 0; ni < 4; ++ni) b[mi][ni] = (f32x4){0.f, 0.f, 0.f, 0.f};
      gemm_dma<4, 4, true>(P + (size_t)m0 * NP + ocol, NP, W + W_BR + (size_t)(i * 1024 + n0) * 512, 512, 512, b, smem, tid);
#pragma unroll
      for (int mi = 0; mi < 4; ++mi)
#pragma unroll
        for (int ni = 0; ni < 4; ++ni) {
          const float y0 = lo2f(yp[mi][ni].x) + lo2f(gp[mi][ni].x) * b[mi][ni][0];
          const float y1 = hi2f(yp[mi][ni].x) + hi2f(gp[mi][ni].x) * b[mi][ni][1];
          const float y2 = lo2f(yp[mi][ni].y) + lo2f(gp[mi][ni].y) * b[mi][ni][2];
          const float y3 = hi2f(yp[mi][ni].y) + hi2f(gp[mi][ni].y) * b[mi][ni][3];
          yp[mi][ni] = make_uint2(pack2(y0, y1), pack2(y2, y3));
        }
    }
#pragma unroll
    for (int mi = 0; mi < 4; ++mi)
#pragma unroll
      for (int ni = 0; ni < 4; ++ni)
        *(uint2*)(YM + (size_t)(m0 + wm * 64 + mi * 16 + l15) * 1024 + n0 + wn * 64 + ni * 16 + quad * 4) = yp[mi][ni];
  }
}

__device__ void transpose64(const u16* __restrict__ src, int lds_, u16* __restrict__ dst, int ldd, u16* tile, const int tid) {
  {
    const int r = tid >> 2, c = (tid & 3) * 16;
    uint4 a = *(const uint4*)(src + (size_t)r * lds_ + c);
    uint4 b = *(const uint4*)(src + (size_t)r * lds_ + c + 8);
    uint32_t* t32 = (uint32_t*)(tile + r * 66 + c);
    t32[0] = a.x; t32[1] = a.y; t32[2] = a.z; t32[3] = a.w; t32[4] = b.x; t32[5] = b.y; t32[6] = b.z; t32[7] = b.w;
  }
  __syncthreads();
  {
    const int d = tid >> 2, tc = (tid & 3) * 16;
    uint32_t w[8];
#pragma unroll
    for (int i = 0; i < 8; ++i) w[i] = (uint32_t)tile[(tc + 2 * i) * 66 + d] | ((uint32_t)tile[(tc + 2 * i + 1) * 66 + d] << 16);
    uint4* o = (uint4*)(dst + (size_t)d * ldd + tc);
    o[0] = make_uint4(w[0], w[1], w[2], w[3]);
    o[1] = make_uint4(w[4], w[5], w[6], w[7]);
  }
  __syncthreads();
}

__device__ void phase_prep(const Params& p, int l, u16* sm) {
  const int tid = otid();
  const int lane = tid & 63, wave = tid >> 6;
  u16* P = (u16*)(p.ws + OFF_P);
  u16* KA = (u16*)(p.ws + OFF_KA);
  u16* VtA = (u16*)(p.ws + OFF_VTA);
  u16* KB = (u16*)(p.ws + OFF_KB);
  u16* VtD = (u16*)(p.ws + OFF_VTD);
  u16* GL = (u16*)(p.ws + OFF_GL);
  const float* ropeA = (const float*)(p.ws + OFF_ROPE);
  const float* ropeB = ropeA + 64 * 16 * 2;
  const float aqg = p.in[9][l * 64 + lane], akg = p.in[10][l * 64 + lane];
  const float* bqg = p.in[11] + l * 384;
  const float* bkvg = p.in[12] + l * 256;
  const float* mu = p.in[15] + l * 1920;
  for (int tok = blockIdx.x * 4 + wave; tok < TC; tok += gridDim.x * 4) {
    const int bl = tok / TL, j = tok - bl * TL;
    const bool islat = j >= 256;
    const int jj = j - 256;
    const int grow = (jj >> 6) & 31, gcol = jj & 63;
    u16* pr = P + (size_t)tok * NP;
    const bool hasp = islat ? (jj > 0) : (j > 0);
    const bool hasn = islat ? (jj < 2047) : (j < 255);
    u16 xa[10], xq[6], xkv[4], xkr, gcur[2], gprv[2], gnxt[2];
#pragma unroll
    for (int h = 0; h < 10; ++h) xa[h] = pr[h * 64 + lane];
#pragma unroll
    for (int i = 0; i < 6; ++i) xq[i] = pr[PB_CQ + lane + 64 * i];
#pragma unroll
    for (int i = 0; i < 4; ++i) xkv[i] = pr[PB_CKV + lane + 64 * i];
    xkr = pr[PB_KR + (lane & 31)];
#pragma unroll
    for (int i = 0; i < 2; ++i) {
      const int c = lane + 64 * i;
      gcur[i] = pr[PC_GLO + c];
      gprv[i] = hasp ? pr[PC_GLO + c - NP] : (u16)0;
      gnxt[i] = hasn ? pr[PC_GLO + c + NP] : (u16)0;
    }
    float ca = 1.f, sa = 0.f, cb = 1.f, sb = 0.f;
    if (islat) {
      const int pos = (lane < 32) ? grow : gcol;
      ca = ropeA[(pos * 16 + (lane & 15)) * 2];
      sa = ropeA[(pos * 16 + (lane & 15)) * 2 + 1];
      const int posb = ((lane & 31) < 16) ? grow : gcol;
      cb = ropeB[(posb * 8 + (lane & 7)) * 2];
      sb = ropeB[(posb * 8 + (lane & 7)) * 2 + 1];
    }
#pragma unroll
    for (int h = 0; h < 10; ++h) {
      const float x = bf2f(xa[h]);
      const float ss = wave_sum(x * x);
      const float y = x * rsqrtf(ss * (1.f / 64.f) + 1e-6f) * (h < 8 ? aqg : akg);
      const float yp = __shfl_xor(y, 16);
      const float o = ((lane & 16) == 0) ? (y * ca - yp * sa) : (yp * sa + y * ca);
      if (h < 8) pr[h * 64 + lane] = f2bf(o);
      else KA[((size_t)(bl * 2 + (h - 8)) * TL + j) * 64 + lane] = f2bf(o);
    }
    {
      float x[6], ss = 0.f;
#pragma unroll
      for (int i = 0; i < 6; ++i) { x[i] = bf2f(xq[i]); ss += x[i] * x[i]; }
      ss = wave_sum(ss);
      const float rs = rsqrtf(ss * (1.f / 384.f) + 1e-6f);
#pragma unroll
      for (int i = 0; i < 6; ++i) pr[PB_CQ + lane + 64 * i] = f2bf(x[i] * rs * bqg[lane + 64 * i]);
    }
    {
      float x[4], ss = 0.f;
#pragma unroll
      for (int i = 0; i < 4; ++i) { x[i] = bf2f(xkv[i]); ss += x[i] * x[i]; }
      ss = wave_sum(ss);
      const float rs = rsqrtf(ss * (1.f / 256.f) + 1e-6f);
#pragma unroll
      for (int i = 0; i < 4; ++i) pr[PB_CKV + lane + 64 * i] = f2bf(x[i] * rs * bkvg[lane + 64 * i]);
    }
    {
      const float x = bf2f(xkr);
      const float xp = __shfl_xor(x, 8);
      const float o = ((lane & 8) == 0) ? (x * cb - xp * sb) : (xp * sb + x * cb);
      if (lane < 32) {
        const u16 ob = f2bf(o);
#pragma unroll
        for (int h = 0; h < 8; ++h) KB[((size_t)(bl * 8 + h) * TL + j) * 96 + 64 + lane] = ob;
      }
    }
#pragma unroll
    for (int i = 0; i < 2; ++i) {
      const int c = lane + 64 * i;
      const float cur = bf2f(gcur[i]);
      const float z = cur + (0.5f * (bf2f(gprv[i]) + bf2f(gnxt[i])) - cur) * mu[1792 + c];
      GL[(size_t)tok * 128 + c] = f2bf(sigmoidf_(z));
    }
  }
  for (int it = blockIdx.x; it < (TC / 64) * 10; it += gridDim.x) {
    int tg = it / 10, hh = it - tg * 10;
    int tok0 = tg * 64, bl = tok0 / TL, j0 = tok0 - bl * TL;
    if (hh < 2) transpose64(P + (size_t)tok0 * NP + PA_V + hh * 64, NP, VtA + ((size_t)(bl * 2 + hh) * 64) * TL + j0, TL, sm, tid);
    else transpose64(P + (size_t)tok0 * NP + PD_V + (hh - 2) * 64, NP, VtD + ((size_t)(bl * 8 + hh - 2) * 64) * TL + j0, TL, sm, tid);
  }
}

template <int DQK, int NQ, int MODE>
__device__ void flash_item(const u16* __restrict__ Qp, int ldq, const u16* __restrict__ Kp, int ldk, const u16* __restrict__ Vtp,
                           int ntiles, u16* __restrict__ Op, int ldo, float scale, bool ropeq, int qtok0,
                           const float* __restrict__ ropeB, int nat_r, const float* __restrict__ bias_g, unsigned char* smem, const int tid, const int abl) {
  constexpr int KS = DQK / 32;
  constexpr int DCH = DQK / 8;
  constexpr int KB_ = 64 * DQK * 2;
  constexpr int SBF = KB_ + 8192;
  constexpr int NS = (DQK == 64) ? 4 : 3;
  constexpr int LK = (64 * DCH) / 256, LPT = LK + 2;
  float* sBias = (float*)(smem + NS * SBF);
  const int lane = tid & 63, wave = tid >> 6, l15 = lane & 15, quad = lane >> 4;
  const float L2E = 1.4426950408889634f;
  int r0 = 0;
  if (MODE == 1) {
    r0 = min(max(nat_r - 4, 0), 24);
    for (int i = tid; i < 15 * 31; i += 256) sBias[i] = bias_g[i];
  }
  bf16x8 qf[NQ][KS];
#pragma unroll
  for (int qi = 0; qi < NQ; ++qi) {
    const int row = wave * 16 * NQ + qi * 16 + l15;
#pragma unroll
    for (int ks = 0; ks < KS; ++ks) qf[qi][ks] = *(const bf16x8*)(Qp + (size_t)row * ldq + ks * 32 + quad * 8);
    if (DQK == 96 && ropeq) {
      bf16x8 own = qf[qi][KS - 1];
      bf16x8 par = *(const bf16x8*)(Qp + (size_t)row * ldq + 64 + (quad ^ 1) * 8);
      const int qt = qtok0 + row;
      const int pos = (quad < 2) ? ((qt >> 6) & 31) : (qt & 63);
      bf16x8 res;
#pragma unroll
      for (int i = 0; i < 8; ++i) {
        float c = ropeB[(pos * 8 + i) * 2], s = ropeB[(pos * 8 + i) * 2 + 1];
        float xo = bf2f((u16)own[i]), xp = bf2f((u16)par[i]);
        float o = ((quad & 1) == 0) ? (xo * c - xp * s) : (xp * s + xo * c);
        res[i] = (short)f2bf(o);
      }
      qf[qi][KS - 1] = res;
    }
  }
  auto koff = [&](int t) -> int { return (MODE == 1) ? ((t < 8) ? (256 + (r0 + t) * 64) : ((t - 8) * 64)) : t * 64; };
  unsigned char* dstw = smem + __builtin_amdgcn_readfirstlane(tid >> 6) * 1024;
  auto issue = [&](int t, int buf) {
    const int ko = koff(t);
#pragma unroll
    for (int i = 0; i < LK; ++i) {
      const int L = tid + 256 * i;
      int row, c;
      if (DQK == 64) { row = L >> 3; c = (L & 7) ^ (row & 7); }
      else { row = L / 12; const int pp = L - row * 12; c = (pp & ~3) | ((pp & 3) ^ ((0x1230 >> (((row >> 2) & 3) * 4)) & 3)); }
      __builtin_amdgcn_global_load_lds((const unsigned*)(Kp + (size_t)(ko + row) * ldk + c * 8), (unsigned*)(dstw + buf * SBF + i * 4096), 16, 0, 0);
    }
#pragma unroll
    for (int i = 0; i < 2; ++i) {
      const int L = tid + 256 * i;
      const int d = L >> 3, c = (L & 7) ^ (d & 7);
      __builtin_amdgcn_global_load_lds((const unsigned*)(Vtp + (size_t)d * TL + ko + c * 8), (unsigned*)(dstw + buf * SBF + KB_ + i * 4096), 16, 0, 0);
    }
  };
  int koffs[KS];
#pragma unroll
  for (int ks = 0; ks < KS; ++ks) {
    const int c = ks * 4 + quad;
    if (DQK == 64) koffs[ks] = l15 * 128 + ((c ^ (l15 & 7)) * 16);
    else koffs[ks] = l15 * 192 + (((c & ~3) | ((c & 3) ^ ((0x1230 >> ((l15 >> 2) * 4)) & 3))) * 16);
  }
  int voffs[2][2];
#pragma unroll
  for (int kk = 0; kk < 2; ++kk)
#pragma unroll
    for (int ab = 0; ab < 2; ++ab) {
      const int keyb = ((2 * kk + ab) * 16 + quad * 4) * 2;
      const int c = keyb >> 4;
      voffs[kk][ab] = l15 * 128 + ((c ^ (l15 & 7)) * 16) + (keyb & 15);
    }
  f32x4 o[4][NQ];
  float m[NQ], lsum[NQ];
#pragma unroll
  for (int qi = 0; qi < NQ; ++qi) {
    m[qi] = -INFINITY; lsum[qi] = 0.f;
#pragma unroll
    for (int dt = 0; dt < 4; ++dt) o[dt][qi] = (f32x4){0.f, 0.f, 0.f, 0.f};
  }
  const int qc = wave * 16 + l15;
  const int st = min(max(qc - 8, 0), 48);
  GEMM_WAIT_VM(0);
#pragma unroll
  for (int s_ = 0; s_ < NS - 1; ++s_)
    if (s_ < ntiles) issue(s_, s_);
  int buf = 0;
  for (int t = 0; t < ntiles; ++t) {
    if (!(abl & 4)) {
      const int rem = ntiles - 1 - t;
      if (NS == 4) {
        if (rem >= 2) GEMM_WAIT_VM(8); else if (rem == 1) GEMM_WAIT_VM(4); else GEMM_WAIT_VM(0);
      } else {
        if (rem >= 1) GEMM_WAIT_VM(5); else GEMM_WAIT_VM(0);
      }
    }
    if (!(abl & 8)) raw_barrier();
    if (!(abl & 4) && t + NS - 1 < ntiles) { int nb = buf + NS - 1; if (nb >= NS) nb -= NS; issue(t + NS - 1, nb); }
    const unsigned char* k_s = smem + buf * SBF;
    const unsigned char* v_s = k_s + KB_;
    f32x4 s[4][NQ];
    {
      bf16x8 kf[4][KS];
#pragma unroll
      for (int kt = 0; kt < 4; ++kt)
#pragma unroll
        for (int ks = 0; ks < KS; ++ks) kf[kt][ks] = *(const bf16x8*)(k_s + kt * 16 * DQK * 2 + koffs[ks]);
      __builtin_amdgcn_sched_barrier(0);
#pragma unroll
      for (int kt = 0; kt < 4; ++kt) {
#pragma unroll
        for (int qi = 0; qi < NQ; ++qi) s[kt][qi] = (f32x4){0.f, 0.f, 0.f, 0.f};
#pragma unroll
        for (int ks = 0; ks < KS; ++ks)
#pragma unroll
          for (int qi = 0; qi < NQ; ++qi) s[kt][qi] = __builtin_amdgcn_mfma_f32_16x16x32_bf16(kf[kt][ks], qf[qi][ks], s[kt][qi], 0, 0, 0);
      }
    }
    uint2 vfa[2][4], vfb[2][4];
#pragma unroll
    for (int kk = 0; kk < 2; ++kk)
#pragma unroll
      for (int dt = 0; dt < 4; ++dt) {
        vfa[kk][dt] = *(const uint2*)(v_s + dt * 2048 + voffs[kk][0]);
        vfb[kk][dt] = *(const uint2*)(v_s + dt * 2048 + voffs[kk][1]);
      }
    __builtin_amdgcn_sched_barrier(0);
    const float c2 = scale * L2E;
    if (MODE == 1 && t < 8) {
      const int drow = r0 + t - nat_r + 7;
#pragma unroll
      for (int kt = 0; kt < 4; ++kt)
#pragma unroll
        for (int j = 0; j < 4; ++j) {
          int kc = kt * 16 + quad * 4 + j;
          bool valid = (kc >= st) && (kc < st + 16);
          int bi = drow * 31 + (kc - qc + 15);
          bi = valid ? bi : 0;
          float bv = sBias[bi];
          s[kt][0][j] = valid ? (s[kt][0][j] * c2 + bv * L2E) : -INFINITY;
        }
    }
    const bool pre = (MODE == 1 && t < 8);
    bf16x8 pb[NQ][2];
    if (abl & 1) {
#pragma unroll
      for (int qi = 0; qi < NQ; ++qi)
#pragma unroll
        for (int kk = 0; kk < 2; ++kk) {
          uint4 u = make_uint4(pack2(s[2 * kk][qi][0], s[2 * kk][qi][1]), pack2(s[2 * kk][qi][2], s[2 * kk][qi][3]),
                               pack2(s[2 * kk + 1][qi][0], s[2 * kk + 1][qi][1]), pack2(s[2 * kk + 1][qi][2], s[2 * kk + 1][qi][3]));
          pb[qi][kk] = __builtin_bit_cast(bf16x8, u);
        }
    } else
#pragma unroll
    for (int qi = 0; qi < NQ; ++qi) {
      float mx = fmaxf(fmaxf(s[0][qi][0], s[0][qi][1]), fmaxf(s[0][qi][2], s[0][qi][3]));
#pragma unroll
      for (int kt = 1; kt < 4; ++kt) mx = fmaxf(mx, fmaxf(fmaxf(s[kt][qi][0], s[kt][qi][1]), fmaxf(s[kt][qi][2], s[kt][qi][3])));
      mx = xq_max(mx);
      const float cc = pre ? 1.f : c2;
      const float mnew = fmaxf(m[qi], mx * cc);
      const bool grew = __builtin_amdgcn_ballot_w64(mnew > m[qi]) != 0;
      const float alpha = __builtin_amdgcn_exp2f(m[qi] - mnew);
      m[qi] = mnew;
      float ps = 0.f;
#pragma unroll
      for (int kt = 0; kt < 4; ++kt)
#pragma unroll
        for (int j = 0; j < 4; ++j) {
          float pv = __builtin_amdgcn_exp2f(s[kt][qi][j] * cc - mnew);
          s[kt][qi][j] = pv;
          ps += pv;
        }
      if (grew) {
        lsum[qi] *= alpha;
#pragma unroll
        for (int dt = 0; dt < 4; ++dt)
#pragma unroll
          for (int j = 0; j < 4; ++j) o[dt][qi][j] *= alpha;
      }
      lsum[qi] += ps;
#pragma unroll
      for (int kk = 0; kk < 2; ++kk) {
        uint4 u = make_uint4(pack2(s[2 * kk][qi][0], s[2 * kk][qi][1]), pack2(s[2 * kk][qi][2], s[2 * kk][qi][3]),
                             pack2(s[2 * kk + 1][qi][0], s[2 * kk + 1][qi][1]), pack2(s[2 * kk + 1][qi][2], s[2 * kk + 1][qi][3]));
        pb[qi][kk] = __builtin_bit_cast(bf16x8, u);
      }
    }
#pragma unroll
    for (int kk = 0; kk < 2; ++kk)
#pragma unroll
      for (int dt = 0; dt < 4; ++dt) {
        uint4 vv = make_uint4(vfa[kk][dt].x, vfa[kk][dt].y, vfb[kk][dt].x, vfb[kk][dt].y);
        bf16x8 av = __builtin_bit_cast(bf16x8, vv);
#pragma unroll
        for (int qi = 0; qi < NQ; ++qi) o[dt][qi] = __builtin_amdgcn_mfma_f32_16x16x32_bf16(av, pb[qi][kk], o[dt][qi], 0, 0, 0);
      }
    if (++buf == NS) buf = 0;
  }
  raw_barrier();
#pragma unroll
  for (int qi = 0; qi < NQ; ++qi) {
    float l = xq_sum(lsum[qi]);
    const float inv = 1.f / l;
    const int row = wave * 16 * NQ + qi * 16 + l15;
#pragma unroll
    for (int dt = 0; dt < 4; ++dt)
      *(uint2*)(Op + (size_t)row * ldo + dt * 16 + quad * 4) =
          make_uint2(pack2(o[dt][qi][0] * inv, o[dt][qi][1] * inv), pack2(o[dt][qi][2] * inv, o[dt][qi][3] * inv));
  }
}

__device__ void scan_item(const Params& p, int l, int bl, int h, int dir, int half, unsigned char* smem, const int tid, const int abl) {
  float* R = (float*)smem;
  float* V = R + 2048;
  float* KK = V + 2048;
  float* KD = KK + 2048;
  float* W = KD + 2048;
  float* T1 = W + 2048;
  float* Y = T1 + 2048;
  float* BONW = Y + 2048;
  u16* XW = (u16*)(BONW + 128);
  u16* XA = XW + 32 * 72;
  const int lane = tid & 63, wave = tid >> 6, l15 = lane & 15, quad = lane >> 4;
  const u16* P = (const u16*)(p.ws + OFF_P);
  u16* Yd = (u16*)(p.ws + (dir ? OFF_YB : OFF_YF));
  float* BON = (float*)(p.ws + OFF_BON);
  const u16* Wl = (const u16*)(p.ws + OFF_W) + (size_t)l * W_TOTAL;
  const float* mu = p.in[15] + l * 1920;
  const int nn = wave * 16 + l15;
  const float w0 = p.in[16][(l * 2 + dir) * 512 + h * 64 + nn];
  const float a0 = p.in[18][(l * 2 + dir) * 512 + h * 64 + nn];
  const float ka = p.in[22][l * 512 + h * 64 + nn];
  const float rk = p.in[23][l * 512 + h * 64 + nn];
  bf16x8 wdec[2], waaa[2];
#pragma unroll
  for (int ks = 0; ks < 2; ++ks) {
    wdec[ks] = *(const bf16x8*)(Wl + W_DEC + ((size_t)dir * 512 + h * 64 + nn) * 64 + ks * 32 + quad * 8);
    waaa[ks] = *(const bf16x8*)(Wl + W_AAA + ((size_t)dir * 512 + h * 64 + nn) * 64 + ks * 32 + quad * 8);
  }
  const int st_t = tid >> 3, part = tid & 7, n0 = part * 8;
  const int sl = lane & 7, srow = half * 32 + wave * 8 + (lane >> 3);
  v2f S2[4];
#pragma unroll
  for (int i = 0; i < 4; ++i) S2[i] = (v2f){0.f, 0.f};
  float* MU = (float*)(XA + 32 * 72);
  float* KKC = MU + 320;
  for (int i = tid; i < 384; i += 256) {
    int g = i >> 6, n = i & 63;
    float v;
    if (g == 0) v = mu[h * 64 + n];
    else if (g == 1) v = mu[1024 + h * 64 + n];
    else if (g == 2) v = mu[512 + h * 64 + n];
    else if (g == 3) v = mu[1536 + dir * 64 + n];
    else if (g == 4) v = mu[1664 + dir * 64 + n];
    else v = p.in[21][l * 512 + h * 64 + n];
    MU[i] = v;
  }
  uint4 raw[15];
  auto issue_raw = [&](int cidx) {
    const int seg = cidx >= 8;
    const int cc = seg ? cidx - 8 : cidx, nch = seg ? 64 : 8, len = seg ? 2048 : 256;
    const int tb = bl * TL + (seg ? 256 : 0);
    const int c = dir ? (nch - 1 - cc) : cc;
    const int pos = c * 32 + st_t;
    const bool hasp = pos > 0, hasn = pos < len - 1;
    const u16* rowp = P + (size_t)(tb + pos) * NP + n0;
    const int cols[5] = {PC_R + h * 64, PC_V + h * 64, PC_K + h * 64, PC_WLO + dir * 64, PC_ALO + dir * 64};
#pragma unroll
    for (int g = 0; g < 5; ++g) {
      raw[3 * g] = *(const uint4*)(rowp + cols[g]);
      raw[3 * g + 1] = make_uint4(0, 0, 0, 0);
      raw[3 * g + 2] = make_uint4(0, 0, 0, 0);
      if (hasp) raw[3 * g + 1] = *(const uint4*)(rowp + cols[g] - NP);
      if (hasn) raw[3 * g + 2] = *(const uint4*)(rowp + cols[g] + NP);
    }
  };
  issue_raw(0);
  __syncthreads();

  for (int cidx = 0; cidx < 72; ++cidx) {
    {
      const int seg = cidx >= 8;
      const int cc = seg ? cidx - 8 : cidx, nch = seg ? 64 : 8;
      const int tb = bl * TL + (seg ? 256 : 0);
      const int c = dir ? (nch - 1 - cc) : cc;
      const int pos0 = c * 32;
      {
#define SHIFT8(G, z)                                                                              \
  {                                                                                               \
    const uint4 c4 = raw[3 * (G)], p4 = raw[3 * (G) + 1], n4 = raw[3 * (G) + 2];                  \
    const float4 m0 = *(const float4*)(MU + (G)*64 + n0), m1 = *(const float4*)(MU + (G)*64 + n0 + 4); \
    const float mm[8] = {m0.x, m0.y, m0.z, m0.w, m1.x, m1.y, m1.z, m1.w};                          \
    const uint32_t cu[4] = {c4.x, c4.y, c4.z, c4.w}, pu[4] = {p4.x, p4.y, p4.z, p4.w}, nu[4] = {n4.x, n4.y, n4.z, n4.w}; \
    _Pragma("unroll") for (int i = 0; i < 4; ++i) {                                               \
      float c0 = lo2f(cu[i]), c1 = hi2f(cu[i]);                                                   \
      z[2 * i] = c0 + (0.5f * (lo2f(pu[i]) + lo2f(nu[i])) - c0) * mm[2 * i];                      \
      z[2 * i + 1] = c1 + (0.5f * (hi2f(pu[i]) + hi2f(nu[i])) - c1) * mm[2 * i + 1];              \
    }                                                                                             \
  }
        float z[8];
        SHIFT8(0, z);
        *(float4*)(R + st_t * 64 + n0) = make_float4(z[0], z[1], z[2], z[3]);
        *(float4*)(R + st_t * 64 + n0 + 4) = make_float4(z[4], z[5], z[6], z[7]);
        SHIFT8(1, z);
        *(float4*)(V + st_t * 64 + n0) = make_float4(z[0], z[1], z[2], z[3]);
        *(float4*)(V + st_t * 64 + n0 + 4) = make_float4(z[4], z[5], z[6], z[7]);
        SHIFT8(2, z);
        {
          const float4 k0 = *(const float4*)(KKC + n0), k1 = *(const float4*)(KKC + n0 + 4);
          const float kc[8] = {k0.x, k0.y, k0.z, k0.w, k1.x, k1.y, k1.z, k1.w};
          float q[8], ss = 0.f;
#pragma unroll
          for (int i = 0; i < 8; ++i) { q[i] = z[i] * kc[i]; ss += q[i] * q[i]; }
          *(float4*)(KD + st_t * 64 + n0) = make_float4(z[0], z[1], z[2], z[3]);
          *(float4*)(KD + st_t * 64 + n0 + 4) = make_float4(z[4], z[5], z[6], z[7]);
          ss = row8_sum(ss);
          const float inv = 1.f / fmaxf(sqrtf(ss), 1e-12f);
          *(float4*)(KK + st_t * 64 + n0) = make_float4(q[0] * inv, q[1] * inv, q[2] * inv, q[3] * inv);
          *(float4*)(KK + st_t * 64 + n0 + 4) = make_float4(q[4] * inv, q[5] * inv, q[6] * inv, q[7] * inv);
        }
        SHIFT8(3, z);
        {
          float th[8];
#pragma unroll
          for (int i = 0; i < 8; ++i) th[i] = 1.f - 2.f / (1.f + __expf(2.f * z[i]));
          *(uint4*)(XW + st_t * 72 + n0) = make_uint4(pack2(th[0], th[1]), pack2(th[2], th[3]), pack2(th[4], th[5]), pack2(th[6], th[7]));
        }
        SHIFT8(4, z);
        *(uint4*)(XA + st_t * 72 + n0) = make_uint4(pack2(z[0], z[1]), pack2(z[2], z[3]), pack2(z[4], z[5]), pack2(z[6], z[7]));
#undef SHIFT8
      }
      raw_barrier();
#pragma unroll
      for (int mt = 0; mt < 2; ++mt) {
        f32x4 aw = (f32x4){0.f, 0.f, 0.f, 0.f}, aa = (f32x4){0.f, 0.f, 0.f, 0.f};
#pragma unroll
        for (int ks = 0; ks < 2; ++ks) {
          bf16x8 xw = *(const bf16x8*)(XW + (mt * 16 + l15) * 72 + ks * 32 + quad * 8);
          bf16x8 xa = *(const bf16x8*)(XA + (mt * 16 + l15) * 72 + ks * 32 + quad * 8);
          aw = __builtin_amdgcn_mfma_f32_16x16x32_bf16(xw, wdec[ks], aw, 0, 0, 0);
          aa = __builtin_amdgcn_mfma_f32_16x16x32_bf16(xa, waaa[ks], aa, 0, 0, 0);
        }
#pragma unroll
        for (int j = 0; j < 4; ++j) {
          const int t = mt * 16 + quad * 4 + j;
          const float wv = __expf(-0.6065306597126334f / (1.f + __expf(-(w0 + aw[j]))));
          const float av = 1.f / (1.f + __expf(-(a0 + aa[j])));
          W[t * 64 + nn] = wv;
          T1[t * 64 + nn] = KK[t * 64 + nn] * av;
          const float kd = KD[t * 64 + nn] * (1.f + (av - 1.f) * ka);
          KD[t * 64 + nn] = kd;
          const float bon = row16_sum(R[t * 64 + nn] * kd * rk);
          if (l15 == 0) BONW[wave * 32 + t] = bon;
        }
      }
      if (cidx + 1 < 72) issue_raw(cidx + 1);
      raw_barrier();
      {
        float4 Akk0, Akk1, At0, At1, Ad0, Ad1, Aw0, Aw1, Ar0, Ar1, Bkk0, Bkk1, Bt0, Bt1, Bd0, Bd1, Bw0, Bw1, Br0, Br1;
        float Av, Bv;
#define SCAN_LOAD(X, I)                                                  \
  {                                                                      \
    const int o_ = (I) * 64 + sl * 8;                                    \
    X##kk0 = *(const float4*)(KK + o_); X##kk1 = *(const float4*)(KK + o_ + 4); \
    X##t0 = *(const float4*)(T1 + o_);  X##t1 = *(const float4*)(T1 + o_ + 4);  \
    X##d0 = *(const float4*)(KD + o_);  X##d1 = *(const float4*)(KD + o_ + 4);  \
    X##w0 = *(const float4*)(W + o_);   X##w1 = *(const float4*)(W + o_ + 4);   \
    X##r0 = *(const float4*)(R + o_);   X##r1 = *(const float4*)(R + o_ + 4);   \
    X##v = V[(I) * 64 + srow];                                           \
  }
#define SCAN_PRE(C, KDv, Wv)    \
  const v2f tmp##C = S2[C] * (Wv) + vv0 * (KDv);
#define SCAN_EL(C, T1v, Rv)                                              \
  {                                                                      \
    const v2f t1_ = T1v, r_ = Rv;                                        \
    S2[C] = tmp##C + nsa0 * t1_;                                         \
    if ((C) & 1) y1 += S2[C] * r_; else y0 += S2[C] * r_;                \
  }
#define SCAN_STEP(X, I)                                                  \
  {                                                                      \
    const v2f k0 = (v2f){X##kk0.x, X##kk0.y}, k1 = (v2f){X##kk0.z, X##kk0.w}, k2 = (v2f){X##kk1.x, X##kk1.y}, k3 = (v2f){X##kk1.z, X##kk1.w}; \
    v2f a0 = S2[0] * k0, a0b = S2[1] * k1;                               \
    a0 += S2[2] * k2; a0b += S2[3] * k3;                                 \
    a0 += a0b;                                                           \
    const v2f vv0 = (v2f){X##v, X##v};                                   \
    SCAN_PRE(0, ((v2f){X##d0.x, X##d0.y}), ((v2f){X##w0.x, X##w0.y}))    \
    SCAN_PRE(1, ((v2f){X##d0.z, X##d0.w}), ((v2f){X##w0.z, X##w0.w}))    \
    SCAN_PRE(2, ((v2f){X##d1.x, X##d1.y}), ((v2f){X##w1.x, X##w1.y}))    \
    SCAN_PRE(3, ((v2f){X##d1.z, X##d1.w}), ((v2f){X##w1.z, X##w1.w}))    \
    const float sa0 = row8_sum(a0.x + a0.y);                             \
    const v2f nsa0 = (v2f){-sa0, -sa0};                                  \
    v2f y0 = (v2f){0.f, 0.f}, y1 = (v2f){0.f, 0.f};                      \
    SCAN_EL(0, ((v2f){X##t0.x, X##t0.y}), ((v2f){X##r0.x, X##r0.y}))     \
    SCAN_EL(1, ((v2f){X##t0.z, X##t0.w}), ((v2f){X##r0.z, X##r0.w}))     \
    SCAN_EL(2, ((v2f){X##t1.x, X##t1.y}), ((v2f){X##r1.x, X##r1.y}))     \
    SCAN_EL(3, ((v2f){X##t1.z, X##t1.w}), ((v2f){X##r1.z, X##r1.w}))     \
    y0 += y1;                                                            \
    const float ys0 = row8_sum(y0.x + y0.y);                             \
    if (sl == 0) Y[(I) * 64 + srow] = ys0;                               \
  }
        SCAN_LOAD(A, dir ? 31 : 0);
        for (int s = 0; s < ((abl & 32) ? 0 : 32); s += 2) {
          const int i0 = dir ? (31 - s) : s, i1 = dir ? (30 - s) : (s + 1);
          SCAN_LOAD(B, i1);
          SCAN_STEP(A, i0);
          if (s + 2 < 32) { SCAN_LOAD(A, dir ? (29 - s) : (s + 2)); }
          SCAN_STEP(B, i1);
        }
#undef SCAN_LOAD
#undef SCAN_EL
#undef SCAN_PRE
#undef SCAN_STEP
      }
      raw_barrier();
      {
        const float* yp = Y + st_t * 64 + half * 32 + part * 4;
        const size_t tok = (size_t)(tb + pos0 + st_t);
        *(uint2*)(Yd + tok * 512 + h * 64 + half * 32 + part * 4) = make_uint2(pack2(yp[0], yp[1]), pack2(yp[2], yp[3]));
        if (part == 0 && half == 0) BON[tok * 16 + h * 2 + dir] = BONW[st_t] + BONW[32 + st_t] + BONW[64 + st_t] + BONW[96 + st_t];
      }
    }
  }
  __syncthreads();
}

__device__ void phase_mixers(const Params& p, int chunk, int l, bool with_ctx, int* counter, unsigned char* smem, u16* dum, int kmask) {
  int& s_item = *(int*)(smem + SMEM_BYTES + 16);
  u16* sm = (u16*)smem;
  u16* P = (u16*)(p.ws + OFF_P);
  const u16* KA = (const u16*)(p.ws + OFF_KA);
  const u16* VtA = (const u16*)(p.ws + OFF_VTA);
  const u16* QB = (const u16*)(p.ws + OFF_QB);
  const u16* KB = (const u16*)(p.ws + OFF_KB);
  const u16* VtB = (const u16*)(p.ws + OFF_VTB);
  const u16* VtD = (const u16*)(p.ws + OFF_VTD);
  const float* ropeB = (const float*)(p.ws + OFF_ROPE) + 64 * 16 * 2;
  const int n_scan = 8 * 2 * 2;
  const int n_al = 8 * 16;
  const int n_nat = 8 * 32;
  const int n_cx = 8 * 2;
  const int total = n_scan + 2 * n_al + n_nat + (with_ctx ? 3 * n_cx : 0);
  const float scaleB = 0.10206207261596575f;
  const int my_xcd = (int)(__builtin_amdgcn_s_getreg((3 << 11) | 20) & 7u);
  for (int qq = 0; qq < 8; ++qq) {
   const int bl = (my_xcd + qq) & 7;
   int* qctr = counter + bl * 64;
   while (true) {
    const int tid = otid();
    if (tid == 0) s_item = atomicAdd(qctr, 1);
    __syncthreads();
    int it = s_item;
    __syncthreads();
    if (it >= total) break;
    if (it < n_scan) {
      if (!(kmask & 1)) continue;
      int half = it & 1, dir = (it >> 1) & 1, h = (it >> 2) & 7;
      __builtin_amdgcn_s_setprio(3);
      scan_item(p, l, bl, h, dir, half, smem, otid(), dum ? PR_ABL : 0);
      __builtin_amdgcn_s_setprio(0);
      continue;
    }
    it -= n_scan;
    int kind, h, ntl;
    size_t tok0;
    bool rq = false;
    int qtok0 = 0, natr = 0;
    if (it < 2 * n_al) {
      kind = (it >= n_al) ? 1 : 0;
      int i2 = it - kind * n_al;
      int qt = i2 & 15; h = (i2 >> 4) & 7;
      tok0 = (size_t)bl * TL + 256 + qt * 128; ntl = 36; rq = true; qtok0 = qt * 128;
    } else if (it < 2 * n_al + n_nat) {
      int i2 = it - 2 * n_al;
      kind = 3; natr = i2 & 31; h = (i2 >> 5) & 7;
      tok0 = (size_t)bl * TL + 256 + natr * 64; ntl = 12;
    } else {
      int i2 = it - 2 * n_al - n_nat;
      kind = i2 / n_cx; i2 -= kind * n_cx;
      int qt = i2 & 1; h = (i2 >> 1) & 7;
      tok0 = (size_t)bl * TL + qt * 128; ntl = 4;
    }
    {
      const int cls = (ntl == 36) ? (kind == 0 ? 2 : 4) : (ntl == 12 ? 8 : 16);
      if (!(kmask & cls)) continue;
    }
    if (kind == 1) {
      flash_item<96, 2, 0>(QB + tok0 * 768 + h * 96, 768, KB + (size_t)(bl * 8 + h) * TL * 96, 96, VtB + (size_t)(bl * 8 + h) * 64 * TL,
                           ntl, dum ? (dum + tok0 * 1536 + 512 + h * 64) : (P + tok0 * NP + O_B + h * 64), dum ? 1536 : NP, scaleB, rq, qtok0, ropeB, 0, nullptr, smem, otid(), dum ? PR_ABL : 0);
    } else if (kind == 3) {
      u16* q = P + tok0 * NP + PD_Q + h * 64;
      flash_item<64, 1, 1>(q, NP, P + (size_t)bl * TL * NP + PD_K + h * 64, NP, VtD + (size_t)(bl * 8 + h) * 64 * TL, ntl, dum ? (dum + tok0 * 1536 + 1024 + h * 64) : q, dum ? 1536 : NP, 0.125f,
                           false, 0, ropeB, natr, p.in[26] + (size_t)(l * 8 + h) * 15 * 31, smem, otid(), dum ? PR_ABL : 0);
    } else {
      u16* q = P + tok0 * NP + (kind == 0 ? PA_Q : PD_Q) + h * 64;
      const u16* kp = (kind == 0) ? (KA + (size_t)(bl * 2 + (h >> 2)) * TL * 64) : (P + (size_t)bl * TL * NP + PD_K + h * 64);
      const u16* vp = (kind == 0) ? (VtA + (size_t)(bl * 2 + (h >> 2)) * 64 * TL) : (VtD + (size_t)(bl * 8 + h) * 64 * TL);
      flash_item<64, 2, 0>(q, NP, kp, (kind == 0) ? 64 : NP, vp, ntl, dum ? (dum + tok0 * 1536 + (kind == 0 ? 0 : 1024) + h * 64) : q, dum ? 1536 : NP, 0.125f, false, 0, ropeB, 0, nullptr, smem, otid(), dum ? PR_ABL : 0);
    }
   }
  }
}

__device__ void phase_cout(const Params& p, int l, bool latonly) {
  const int tid = otid();
  const int lane = tid & 63, wave = tid >> 6;
  u16* P = (u16*)(p.ws + OFF_P);
  const u16* YF = (const u16*)(p.ws + OFF_YF);
  const u16* YB = (const u16*)(p.ws + OFF_YB);
  const u16* G = (const u16*)(p.ws + OFF_G);
  const float* BON = (const float*)(p.ws + OFF_BON);
  const float* gnw = p.in[24] + l * 512;
  const float* gnb = p.in[25] + l * 512;
  const float* mu = p.in[15] + l * 1920 + 1024;
  for (int tok = blockIdx.x * 4 + wave; tok < TC; tok += gridDim.x * 4) {
    const int bl = tok / TL, j = tok - bl * TL;
    const bool islat = j >= 256;
    if (latonly && !islat) continue;
    const int jj = j - 256;
    const bool hasp = islat ? (jj > 0) : (j > 0);
    const bool hasn = islat ? (jj < 2047) : (j < 255);
    u16* pr = P + (size_t)tok * NP;
    u16 yf[8], yb[8], gg[8], vcu[8], vpu[8], vnu[8];
    float bon[8];
#pragma unroll
    for (int h = 0; h < 8; ++h) {
      const int col = h * 64 + lane;
      yf[h] = YF[(size_t)tok * 512 + col];
      yb[h] = YB[(size_t)tok * 512 + col];
      gg[h] = G[(size_t)tok * 512 + col];
      vcu[h] = pr[PC_V + col];
      vpu[h] = hasp ? pr[PC_V + col - NP] : (u16)0;
      vnu[h] = hasn ? pr[PC_V + col + NP] : (u16)0;
      bon[h] = BON[(size_t)tok * 16 + h * 2] + BON[(size_t)tok * 16 + h * 2 + 1];
    }
#pragma unroll
    for (int h = 0; h < 8; ++h) {
      const int col = h * 64 + lane;
      const float y = bf2f(yf[h]) + bf2f(yb[h]);
      const float mean = wave_sum(y) * (1.f / 64.f);
      const float d = y - mean;
      const float var = wave_sum(d * d) * (1.f / 64.f);
      const float yn = d * rsqrtf(var + 64e-5f) * gnw[col] + gnb[col];
      const float vc = bf2f(vcu[h]);
      const float vs = vc + (0.5f * (bf2f(vpu[h]) + bf2f(vnu[h])) - vc) * mu[col];
      const float oc = (yn + bon[h] * vs) * bf2f(gg[h]);
      pr[O_C + col] = f2bf(oc);
    }
  }
}

#ifndef PR_GEMM1
#define PR_GEMM1 0
#endif
#ifndef PR_MERGE
#define PR_MERGE 0
#endif
#ifndef PR_KIND
#define PR_KIND -1
#endif
__device__ void phase_probe(const Params& p, int l, int kind, unsigned char* smem) {
  u16* sm = (u16*)smem;
  u16* P = (u16*)(p.ws + OFF_P);
  u16* DUM = (u16*)(p.ws + OFF_YM);
  const float* ropeB = (const float*)(p.ws + OFF_ROPE) + 64 * 16 * 2;
  const int total = (kind == 0) ? 128 : (kind == 3 ? 2048 : 1024);
  for (int it = blockIdx.x; it < total; it += gridDim.x) {
    if (kind == 0) {
      int dir = it & 1, h = (it >> 1) & 7, bl = it >> 4;
      scan_item(p, l, bl, h, dir, 0, smem, otid(), 0);
      scan_item(p, l, bl, h, dir, 1, smem, otid(), 0);
    } else if (kind == 1) {
      int qt = it & 15, h = (it >> 4) & 7, bl = it >> 7;
      size_t tok0 = (size_t)bl * TL + 256 + qt * 128;
      flash_item<64, 2, 0>(P + tok0 * NP + PA_Q + h * 64, NP, (const u16*)(p.ws + OFF_KA) + (size_t)(bl * 2 + (h >> 2)) * TL * 64, 64,
                           (const u16*)(p.ws + OFF_VTA) + (size_t)(bl * 2 + (h >> 2)) * 64 * TL, 36, DUM + tok0 * 1024 + h * 64, 1024,
                           0.125f, false, 0, ropeB, 0, nullptr, smem, otid(), 0);
    } else if (kind == 2) {
      int qt = it & 15, h = (it >> 4) & 7, bl = it >> 7;
      size_t tok0 = (size_t)bl * TL + 256 + qt * 128;
      flash_item<96, 2, 0>((const u16*)(p.ws + OFF_QB) + tok0 * 768 + h * 96, 768, (const u16*)(p.ws + OFF_KB) + (size_t)(bl * 8 + h) * TL * 96,
                           96, (const u16*)(p.ws + OFF_VTB) + (size_t)(bl * 8 + h) * 64 * TL, 36, P + tok0 * NP + O_B + h * 64, NP,
                           0.10206207261596575f, true, qt * 128, ropeB, 0, nullptr, smem, otid(), 0);
    } else {
      int r = it & 31, h = (it >> 5) & 7, bl = it >> 8;
      size_t tok0 = (size_t)bl * TL + 256 + r * 64;
      flash_item<64, 1, 1>(P + tok0 * NP + PD_Q + h * 64, NP, P + (size_t)bl * TL * NP + PD_K + h * 64, NP,
                           (const u16*)(p.ws + OFF_VTD) + (size_t)(bl * 8 + h) * 64 * TL, 12, DUM + tok0 * 1024 + h * 64, 1024, 0.125f,
                           false, 0, ropeB, r, p.in[26] + (size_t)(l * 8 + h) * 15 * 31, smem, otid(), 0);
    }
  }
}

#define XB_TMO      128
#define XB_XCNT(j)  (256  + 64 * (j))
#define XB_XSUB(j)  (1280 + 64 * (j))
#define XB_XGEN(j)  (2304 + 64 * (j))
#define XB_TOP      3328
#define XB_TOPGEN   3392
#define XCD_BAR_WORDS 3456
#define XB_SPIN_CAP (1u << 18)
#define LAS __attribute__((address_space(3)))
DI unsigned xb_ld(unsigned* p) { return __hip_atomic_load(p, __ATOMIC_RELAXED, __HIP_MEMORY_SCOPE_AGENT); }
DI unsigned xb_add(unsigned* p, unsigned v) { return __hip_atomic_fetch_add(p, v, __ATOMIC_RELAXED, __HIP_MEMORY_SCOPE_AGENT); }
DI unsigned xb_xcc_id() { return (unsigned)__builtin_amdgcn_s_getreg((3 << 11) | 20) & 0xFu; }
#define XB_SPIN(cond, bar) do { unsigned _sp = 0; while (cond) { __builtin_amdgcn_s_sleep(1); \
    if ((++_sp & 255u) == 0u) { if (xb_ld(&(bar)[XB_TMO])) break; if (_sp > XB_SPIN_CAP) { atomicAdd(&(bar)[XB_TMO], 1u); break; } } } } while (0)
struct XcdBarrier { unsigned* bar; unsigned x; volatile LAS unsigned* st; };
DI XcdBarrier xcd_barrier_post(unsigned* bar, volatile LAS unsigned* st) {
  XcdBarrier b; b.bar = bar; b.x = xb_xcc_id(); b.st = st;
  if (threadIdx.x == 0) (void)xb_add(&bar[XB_XCNT(b.x)], 1u);
  return b;
}
DI void xcd_barrier_complete(unsigned* bar, unsigned x, unsigned& nloc, unsigned& nx) {
  const unsigned G = gridDim.x * gridDim.y * gridDim.z;
  unsigned sum, cnt, mine, sp = 0u;
  for (;;) {
    sum = 0u; cnt = 0u; mine = 0u;
#pragma unroll
    for (unsigned j = 0; j < 16; ++j) { const unsigned c = xb_ld(&bar[XB_XCNT(j)]); sum += c; cnt += (c > 0u) ? 1u : 0u; mine = (j == x) ? c : mine; }
    if (sum == G) break;
    __builtin_amdgcn_s_sleep(1);
    if ((++sp & 255u) == 0u) { if (xb_ld(&bar[XB_TMO])) break; if (sp > XB_SPIN_CAP) { atomicAdd(&bar[XB_TMO], 1u); break; } }
  }
  nloc = mine > 0u ? mine : 1u; nx = cnt > 0u ? cnt : 1u;
}
DI void xcd_barrier(const XcdBarrier& b) {
  asm volatile("s_waitcnt vmcnt(0)" ::: "memory");
  __syncthreads();
  if (threadIdx.x == 0) {
    unsigned* bar = b.bar;
    __builtin_amdgcn_s_waitcnt(0);
    unsigned nloc = b.st[0], nx = b.st[1];
    if (nloc == 0u) { xcd_barrier_complete(bar, b.x, nloc, nx); b.st[0] = nloc; b.st[1] = nx; }
    const unsigned old = xb_add(&bar[XB_XSUB(b.x)], 1u);
    const unsigned gen = old / nloc;
    if (old + 1u == (gen + 1u) * nloc) {
      __builtin_amdgcn_fence(__ATOMIC_RELEASE, "agent");
      asm volatile("s_waitcnt vmcnt(0)" ::: "memory");
      const unsigned og = xb_add(&bar[XB_TOP], 1u);
      const unsigned tg = og / nx;
      if (og + 1u == (tg + 1u) * nx) xb_add(&bar[XB_TOPGEN], 1u);
      else XB_SPIN(xb_ld(&bar[XB_TOPGEN]) == tg, bar);
      __builtin_amdgcn_fence(__ATOMIC_ACQUIRE, "agent");
      xb_add(&bar[XB_XGEN(b.x)], 1u);
      asm volatile("s_waitcnt vmcnt(0)" ::: "memory");
    } else {
      XB_SPIN(xb_ld(&bar[XB_XGEN(b.x)]) == gen, bar);
      __builtin_amdgcn_fence(__ATOMIC_ACQUIRE, "agent");
      asm volatile("s_waitcnt vmcnt(0)" ::: "memory");
    }
  }
  __syncthreads();
}

__global__ void __launch_bounds__(256, 2) fwd_megakernel(Params p) {
  extern __shared__ __attribute__((aligned(16))) unsigned char smem[];
  cg::grid_group grid = cg::this_grid();
  u16* sm = (u16*)smem;
  unsigned* xb_words = (unsigned*)(smem + SMEM_BYTES);
  if (threadIdx.x < 4) xb_words[threadIdx.x] = 0u;
  __syncthreads();
  const XcdBarrier xb = xcd_barrier_post((unsigned*)(p.ws + OFF_BAR), (volatile LAS unsigned*)xb_words);
  phase0(p, smem);
  grid.sync();
  u16* H = (u16*)(p.ws + OFF_H);
  u16* P = (u16*)(p.ws + OFF_P);
  int* ctr = (int*)(p.ws + OFF_CTR);
  for (int chunk = 0; chunk < NCHUNK; ++chunk) {
    for (int l = 0; l < 2; ++l) {
      const bool last = (l == 1);
      const u16* W = (const u16*)(p.ws + OFF_W) + (size_t)l * W_TOTAL;
      const float* mod = (const float*)(p.ws + OFF_MOD) + (size_t)l * 17 * 6144;
      phase_norm(p, chunk, l, 0, false);
      xcd_barrier(xb);
      for (int rep = 0; rep <= PR_GEMM1; ++rep) {
        gemm_phase<8, 4, true>(H, 1024, W + W_IN, 1024, NP, false, EpiStore{P, NP}, smem);
        xcd_barrier(xb);
      }
      phase_prep(p, l, sm);
      xcd_barrier(xb);
      gemm_phase<4, 4, true>(P + PB_CQ, NP, W + W_QUP, 384, 768, false, EpiStore{(u16*)(p.ws + OFF_QB), 768}, smem);
      gemm_phase<4, 4, false>(P + PB_CKV, NP, W + W_KVUP, 256, 1024, false, EpiKV{(u16*)(p.ws + OFF_KB), (u16*)(p.ws + OFF_VTB)}, smem);
      gemm_phase<4, 4, true>((const u16*)(p.ws + OFF_GL), 128, W + W_GATE, 128, 512, false, EpiStore{(u16*)(p.ws + OFF_G), 512}, smem);
      xcd_barrier(xb);
      if (PR_KIND >= 0) {
        phase_probe(p, l, PR_KIND, smem);
        xcd_barrier(xb);
      }
#ifdef PR_MIX
      if (chunk == 0) { phase_mixers(p, chunk, l, !last, ctr + (4 + l) * 512, smem, (u16*)(p.out + (size_t)BC * 2048 * 1024), PR_MIX); xcd_barrier(xb); }
#endif
      phase_mixers(p, chunk, l, !last, ctr + (chunk * 2 + l) * 512, smem, nullptr, 31);
      xcd_barrier(xb);
      phase_cout(p, l, last);
      xcd_barrier(xb);
      for (int rep = 0; rep <= PR_MERGE; ++rep) {
        phase_merge(p, l, last, smem);
        xcd_barrier(xb);
      }
      if (last) gemm_phase<8, 4, true>((const u16*)(p.ws + OFF_YM), 1024, W + W_OUT, 1024, 1024, true, EpiResid{p, chunk, mod, 2048, false}, smem);
      else gemm_phase<4, 4, true>((const u16*)(p.ws + OFF_YM), 1024, W + W_OUT, 1024, 1024, false, EpiResid{p, chunk, mod, 2048, true}, smem);
      xcd_barrier(xb);
      phase_norm(p, chunk, l, 1, last);
      xcd_barrier(xb);
      gemm_phase<8, 4, true>(H, 1024, W + W_1, 1024, 4096, last, EpiRelu2{P}, smem);
      xcd_barrier(xb);
      if (last) gemm_phase<8, 4, true>(P, 4096, W + W_2, 4096, 1024, true, EpiResid{p, chunk, mod, 5120, false}, smem);
      else gemm_phase<4, 4, true>(P, 4096, W + W_2, 4096, 1024, false, EpiResid{p, chunk, mod, 5120, false}, smem);
      xcd_barrier(xb);
    }
    phase_final(p, chunk);
    xcd_barrier(xb);
  }
}

extern "C" void kernel_launch(void* const* d_in, const int* in_sizes, int n_in, void* d_out, int out_size, void* d_ws,
                              size_t ws_size, hipStream_t stream) {
  static int grid_blocks = 0;
  if (!grid_blocks) {
    int dev = 0, cus = 0, per_cu = 0;
    hipGetDevice(&dev);
    hipDeviceGetAttribute(&cus, hipDeviceAttributeMultiprocessorCount, dev);
    hipFuncSetAttribute((const void*)fwd_megakernel, hipFuncAttributeMaxDynamicSharedMemorySize, SMEM_DYN);
    hipOccupancyMaxActiveBlocksPerMultiprocessor(&per_cu, fwd_megakernel, 256, SMEM_DYN);
    if (per_cu > 2) per_cu = 2;
    if (per_cu < 1) per_cu = 1;
    grid_blocks = cus * per_cu;
  }
  if (ws_size < OFF_END) fprintf(stderr, "workspace too small: %zu < %zu\n", ws_size, (size_t)OFF_END);
  Params p{};
  for (int i = 0; i < 32; ++i) p.in[i] = (const float*)d_in[i];
  p.out = (float*)d_out;
  p.ws = (unsigned char*)d_ws;
  hipMemsetAsync(d_ws, 0, 1048576, stream);
  void* args[] = {&p};
  hipError_t e = hipLaunchCooperativeKernel((void*)fwd_megakernel, dim3(grid_blocks), dim3(256), args, SMEM_DYN, stream);
  if (e != hipSuccess) fprintf(stderr, "cooperative launch failed: %s (grid %d)\n", hipGetErrorString(e), grid_blocks);
}
```
